# Optimizing an MI355X kernel written in HIP

```python
import math
import jax, jax.numpy as jnp
from jax import lax
import numpy as np

D_MODEL = 1024
BATCH = 8
SEQ = 2048
DEPTH = 2
DEC_BATCH = 128
DEC_SEQ = 4
PAST_LEN = 16384
PAGE_SIZE = 128

N_MIXERS = 2
N_A_LAYERS = (DEPTH + N_MIXERS - 1) // N_MIXERS
N_B_LAYERS = DEPTH // N_MIXERS
BRANCH = 3 * D_MODEL // 2
N_XHEADS = 4
XHEAD_DIM = 128
XATT = N_XHEADS * XHEAD_DIM
MIX_WIDTH = BRANCH + XATT
N_MEM = 256
CHUNK = 128
A_GROUPS = 8
A_GDIM = BRANCH // A_GROUPS
SSM_GCH = 16
SSM_GROUPS = BRANCH // SSM_GCH
SSM_STATE = 64
DT_MIN = 1e-3
DT_MAX = 1e-1
EPS = 1e-6

kernel_name = "hybrid_gmlp_s5_memxattn_step"


def rms_norm(x, g):
    xf = x.astype(jnp.float32)
    y = xf * lax.rsqrt(jnp.mean(xf * xf, axis=-1, keepdims=True) + EPS)
    return (y * g.astype(jnp.float32)).astype(x.dtype)


def layer_norm(x, g, b):
    xf = x.astype(jnp.float32)
    mu = jnp.mean(xf, axis=-1, keepdims=True)
    var = jnp.mean(jnp.square(xf - mu), axis=-1, keepdims=True)
    y = (xf - mu) * lax.rsqrt(var + EPS) * g.astype(jnp.float32) + b.astype(jnp.float32)
    return y.astype(x.dtype)


def memory_kv(mem, g, w_k, w_v):
    m = rms_norm(mem, g)
    k = (m @ w_k).reshape(mem.shape[0], mem.shape[1], N_XHEADS, XHEAD_DIM)
    v = (m @ w_v).reshape(mem.shape[0], mem.shape[1], N_XHEADS, XHEAD_DIM)
    return k, v


def cross_attend(q, k, v):
    s = jnp.einsum("blhd,bmhd->bhlm", q.astype(jnp.float32), k.astype(jnp.float32)) * (XHEAD_DIM ** -0.5)
    p = jax.nn.softmax(s, axis=-1)
    o = jnp.einsum("bhlm,bmhd->blhd", p, v.astype(jnp.float32))
    return o.reshape(q.shape[0], q.shape[1], XATT).astype(q.dtype)


def chunk_gating(z_uv, ln_g, ln_b, w_s, b_s):
    uv = jax.nn.gelu(z_uv)
    u, v = uv[..., :BRANCH], uv[..., BRANCH:]
    v = layer_norm(v, ln_g, ln_b)
    bsz, l, _ = v.shape
    n = min(l, CHUNK)
    nc = l // n
    mask = jnp.tril(jnp.ones((n, n), dtype=bool))
    w = jnp.where(mask, w_s[:, :n, :n], jnp.zeros((), w_s.dtype))
    vc = v.reshape(bsz, nc, n, A_GROUPS, A_GDIM)
    mixed = jnp.einsum("gts,bcsgd->bctgd", w, vc) + jnp.transpose(b_s[:, :n])[:, :, None]
    return u * mixed.reshape(bsz, l, BRANCH), v


def _combine(e1, e2):
    a1, b1 = e1
    a2, b2 = e2
    return a1 * a2, a2 * b1 + b2


def s5_branch(u, h0, lam_re, lam_im, log_dt, b_re, b_im, c_re, c_im, d, w_glu, b_glu):
    f32 = jnp.float32
    lam = lax.complex(lam_re.astype(f32), lam_im.astype(f32))
    dt = jnp.exp(log_dt.astype(f32))[:, None]
    lam_bar = jnp.exp(lam * dt)
    b_bar = ((lam_bar - 1.0) / lam)[..., None] * lax.complex(b_re.astype(f32), b_im.astype(f32))
    cr, ci = c_re.astype(f32), c_im.astype(f32)
    dg = d.astype(f32).reshape(SSM_GROUPS, SSM_GCH)
    bsz, l, _ = u.shape
    n = min(l, CHUNK)
    nc = l // n
    u_blocks = u.astype(f32).reshape(bsz, nc, n, SSM_GROUPS, SSM_GCH).transpose(1, 2, 0, 3, 4)
    a = jnp.broadcast_to(lam_bar, (n, 1, SSM_GROUPS, SSM_STATE))

    def step(h, uc):
        bu = jnp.einsum("tbgc,gpc->tbgp", uc.astype(jnp.complex64), b_bar)
        a_cum, hs = lax.associative_scan(_combine, (a, bu), axis=0)
        hs = hs + a_cum * h[None]
        yc = (jnp.einsum("tbgp,gcp->tbgc", hs.real, cr)
              - jnp.einsum("tbgp,gcp->tbgc", hs.imag, ci) + dg * uc)
        return hs[-1], yc

    h_last, ys = lax.scan(step, h0, u_blocks)
    y = ys.transpose(2, 0, 1, 3, 4).reshape(bsz, l, BRANCH)
    y = jax.nn.gelu(y)
    y = y * jax.nn.sigmoid(y @ w_glu.astype(f32) + b_glu.astype(f32))
    return y.astype(u.dtype), h_last


def setup_inputs(seed: int = 0) -> dict:
    key = jax.random.key(seed)
    ks = jax.random.split(key, 32)
    f32 = jnp.float32
    nrm = lambda k, s, sc: jax.random.normal(k, s, f32) * sc
    in_a = 2 * BRANCH + XATT + MIX_WIDTH
    in_b = BRANCH + XATT + MIX_WIDTH
    lam_im = jnp.broadcast_to(math.pi * jnp.arange(SSM_STATE, dtype=f32), (N_B_LAYERS, SSM_GROUPS, SSM_STATE))
    return {
        "x_prompt": nrm(ks[0], (BATCH, SEQ, D_MODEL), 1.0),
        "x_sample": nrm(ks[1], (DEC_BATCH, DEC_SEQ, D_MODEL), 1.0),
        "cache_mem_k": nrm(ks[2], (DEPTH, DEC_BATCH, N_MEM, N_XHEADS, XHEAD_DIM), 1.0),
        "cache_mem_v": nrm(ks[3], (DEPTH, DEC_BATCH, N_MEM, N_XHEADS, XHEAD_DIM), 1.0),
        "state_ssm_re": nrm(ks[4], (N_B_LAYERS, DEC_BATCH, SSM_GROUPS, SSM_STATE), 0.5),
        "state_ssm_im": nrm(ks[5], (N_B_LAYERS, DEC_BATCH, SSM_GROUPS, SSM_STATE), 0.5),
        "mem_prompt": nrm(ks[6], (BATCH, N_MEM, D_MODEL), 1.0),
        "w_in_a": nrm(ks[7], (N_A_LAYERS, D_MODEL, in_a), D_MODEL ** -0.5),
        "ln_v_g": 1.0 + nrm(ks[8], (N_A_LAYERS, BRANCH), 0.02),
        "ln_v_b": nrm(ks[9], (N_A_LAYERS, BRANCH), 0.02),
        "w_spatial": nrm(ks[10], (N_A_LAYERS, A_GROUPS, CHUNK, CHUNK), CHUNK ** -0.5),
        "b_spatial": 1.0 + nrm(ks[11], (N_A_LAYERS, A_GROUPS, CHUNK), 0.02),
        "w_in_b": nrm(ks[12], (N_B_LAYERS, D_MODEL, in_b), D_MODEL ** -0.5),
        "ssm_lambda_re": -0.5 * jnp.exp(nrm(ks[13], (N_B_LAYERS, SSM_GROUPS, SSM_STATE), 0.05)),
        "ssm_lambda_im": lam_im + nrm(ks[14], (N_B_LAYERS, SSM_GROUPS, SSM_STATE), 0.01),
        "ssm_log_dt": jax.random.uniform(ks[15], (N_B_LAYERS, SSM_GROUPS), f32, math.log(DT_MIN), math.log(DT_MAX)),
        "ssm_b_re": nrm(ks[16], (N_B_LAYERS, SSM_GROUPS, SSM_STATE, SSM_GCH), (2 * SSM_GCH) ** -0.5),
        "ssm_b_im": nrm(ks[17], (N_B_LAYERS, SSM_GROUPS, SSM_STATE, SSM_GCH), (2 * SSM_GCH) ** -0.5),
        "ssm_c_re": nrm(ks[18], (N_B_LAYERS, SSM_GROUPS, SSM_GCH, SSM_STATE), (2 * SSM_STATE) ** -0.5),
        "ssm_c_im": nrm(ks[19], (N_B_LAYERS, SSM_GROUPS, SSM_GCH, SSM_STATE), (2 * SSM_STATE) ** -0.5),
        "ssm_d": nrm(ks[20], (N_B_LAYERS, BRANCH), 1.0),
        "w_glu": nrm(ks[21], (N_B_LAYERS, BRANCH, BRANCH), BRANCH ** -0.5),
        "b_glu": nrm(ks[22], (N_B_LAYERS, BRANCH), 0.01),
        "mem_norm_g": 1.0 + nrm(ks[23], (DEPTH, D_MODEL), 0.02),
        "w_mem_k": nrm(ks[24], (DEPTH, D_MODEL, XATT), D_MODEL ** -0.5),
        "w_mem_v": nrm(ks[25], (DEPTH, D_MODEL, XATT), D_MODEL ** -0.5),
        "w_out": nrm(ks[26], (DEPTH, MIX_WIDTH, D_MODEL), MIX_WIDTH ** -0.5),
        "pre_norm_g": 1.0 + nrm(ks[27], (DEPTH, D_MODEL), 0.02),
        "post_norm_g": 1.0 + nrm(ks[28], (DEPTH, D_MODEL), 0.02),
    }


def reference(x_prompt, x_sample, cache_mem_k, cache_mem_v, state_ssm_re, state_ssm_im, mem_prompt,
              w_in_a, ln_v_g, ln_v_b, w_spatial, b_spatial,
              w_in_b, ssm_lambda_re, ssm_lambda_im, ssm_log_dt, ssm_b_re, ssm_b_im, ssm_c_re, ssm_c_im,
              ssm_d, w_glu, b_glu,
              mem_norm_g, w_mem_k, w_mem_v, w_out, pre_norm_g, post_norm_g):
    f32 = jnp.float32

    def layer(i, x, k_mem, v_mem, h0):
        j = i // N_MIXERS
        h = rms_norm(x, pre_norm_g[i])
        if i % N_MIXERS == 0:
            z = h @ w_in_a[j]
            branch, extra = chunk_gating(z[..., :2 * BRANCH], ln_v_g[j], ln_v_b[j], w_spatial[j], b_spatial[j])
            off = 2 * BRANCH
        else:
            z = h @ w_in_b[j]
            branch, extra = s5_branch(z[..., :BRANCH], h0, ssm_lambda_re[j], ssm_lambda_im[j], ssm_log_dt[j],
                                      ssm_b_re[j], ssm_b_im[j], ssm_c_re[j], ssm_c_im[j], ssm_d[j],
                                      w_glu[j], b_glu[j])
            off = BRANCH
        q = z[..., off:off + XATT].reshape(x.shape[0], x.shape[1], N_XHEADS, XHEAD_DIM)
        att = cross_attend(q, k_mem, v_mem)
        mixed = jnp.concatenate([branch, att], axis=-1) * jax.nn.silu(z[..., off + XATT:])
        return x + rms_norm(mixed @ w_out[i], post_norm_g[i]), extra

    yp, ys = x_prompt, x_sample
    mk_p, mv_p, hp_re, hp_im, hs_re, hs_im, v_s = [], [], [], [], [], [], []
    for i in range(DEPTH):
        j = i // N_MIXERS
        kp, vp = memory_kv(mem_prompt, mem_norm_g[i], w_mem_k[i], w_mem_v[i])
        mk_p.append(kp)
        mv_p.append(vp)
        if i % N_MIXERS == 0:
            yp, _ = layer(i, yp, kp, vp, None)
            ys, v_rows = layer(i, ys, cache_mem_k[i], cache_mem_v[i], None)
            v_s.append(v_rows)
        else:
            h0p = jnp.zeros((x_prompt.shape[0], SSM_GROUPS, SSM_STATE), jnp.complex64)
            h0s = lax.complex(state_ssm_re[j].astype(f32), state_ssm_im[j].astype(f32))
            yp, hlp = layer(i, yp, kp, vp, h0p)
            ys, hls = layer(i, ys, cache_mem_k[i], cache_mem_v[i], h0s)
            hp_re.append(hlp.real)
            hp_im.append(hlp.imag)
            hs_re.append(hls.real)
            hs_im.append(hls.imag)

    return (yp, ys, jnp.stack(mk_p), jnp.stack(mv_p), jnp.stack(hp_re), jnp.stack(hp_im),
            jnp.stack(hs_re), jnp.stack(hs_im), jnp.stack(v_s))
```

```cpp
#include <hip/hip_runtime.h>
#include <cstdio>
#include <cstdint>

#ifndef MK_N_LAUNCHES
#define MK_N_LAUNCHES 11
#endif

#define DI __device__ __forceinline__
#define GAS __attribute__((address_space(1)))
#define LAS __attribute__((address_space(3)))
typedef unsigned short bf16_t;
typedef short bf16x8 __attribute__((ext_vector_type(8)));
typedef float f32x4 __attribute__((ext_vector_type(4)));
typedef float f32x2 __attribute__((ext_vector_type(2)));
typedef unsigned u32x4 __attribute__((ext_vector_type(4)));
typedef unsigned u32x2 __attribute__((ext_vector_type(2)));

constexpr int D = 1024, NB_P = 8, T_P = 2048, MP = NB_P * T_P, NB_S = 128, T_S = 4, MS = NB_S * T_S, M = MP + MS;
constexpr int BR = 1536, XA = 512, MW = 2048, NA = 2 * BR + XA + MW  , NBW = BR + XA + MW  ;
constexpr int NMEM = 256, CH = 128, AG = 8, AD = 192, SG = 96, SC = 16, SP = 64, NH = 4, HD = 128;
constexpr int MMEM = NB_P * NMEM;
constexpr float EPS = 1e-6f;
constexpr size_t O_Y = 0, O_MK = (size_t)M * D, O_MV = O_MK + 2ull * MMEM * XA, O_HPR = O_MV + 2ull * MMEM * XA, O_HPI = O_HPR + (size_t)NB_P * SG * SP,
                 O_HSR = O_HPI + (size_t)NB_P * SG * SP, O_HSI = O_HSR + (size_t)NB_S * SG * SP, O_CV = O_HSI + (size_t)NB_S * SG * SP, O_END = O_CV + (size_t)MS * BR;
static_assert(O_END == 23953408ull, "output size");

constexpr size_t MiB = 1u << 20;
constexpr size_t WS_CTL = 0, CTL_ZERO_BYTES = 1 * MiB;
constexpr size_t WS_WINA = 2 * MiB;
constexpr size_t WS_WINB = 13 * MiB;
constexpr size_t WS_WGLU = 21 * MiB;
constexpr size_t WS_WOUT0 = 26 * MiB, WS_WOUT1 = 30 * MiB;
constexpr size_t WS_WMEM = 34 * MiB;
constexpr size_t WS_MEMN = 38 * MiB;
constexpr size_t WS_KVBF = 42 * MiB;
constexpr size_t WS_SMALL = 50 * MiB;
constexpr size_t WS_XN = 52 * MiB;
constexpr size_t WS_Z = 86 * MiB;
constexpr size_t WS_YG = WS_Z + (size_t)M * NBW * 2;
constexpr size_t WS_MIX = 268 * MiB;
constexpr size_t WS_OUT = 334 * MiB;
constexpr size_t WS_Y1 = 400 * MiB;
constexpr size_t WS_END = 466 * MiB;
static_assert(WS_Z + (size_t)M * NA * 2 <= WS_MIX && WS_YG + (size_t)M * BR * 2 <= WS_MIX && WS_XN + (size_t)M * D * 2 <= WS_Z, "ws map");
constexpr size_t SM_VSTAT = 0;
constexpr size_t SM_SS0 = SM_VSTAT + 2 * (size_t)M;
constexpr size_t SM_SS1 = SM_SS0 + M;
constexpr size_t SM_ZERO_END = SM_SS1 + M;
constexpr size_t SM_LB = SM_ZERO_END;
constexpr size_t SM_BB = SM_LB + (size_t)SG * SP * 2;
constexpr size_t SM_END = SM_BB + (size_t)SG * SP * SC * 2;
static_assert(SM_END * 4 <= 2 * MiB, "small region");
constexpr int CW_BAR = 4096;

DI float bf2f(bf16_t v) { return __uint_as_float(((unsigned)v) << 16); }
DI unsigned f2bf(float f) { unsigned u = __float_as_uint(f); return (u + 0x7fffu + ((u >> 16) & 1u)) >> 16; }
DI unsigned pk2(float lo, float hi) { return f2bf(lo) | (f2bf(hi) << 16); }
DI float wave_sum(float v) {
#pragma unroll
    for (int o = 1; o < 64; o <<= 1) v += __shfl_xor(v, o);
    return v;
}
DI float wave_max(float v) {
#pragma unroll
    for (int o = 1; o < 64; o <<= 1) v = fmaxf(v, __shfl_xor(v, o));
    return v;
}
DI float gelu_tanh(float x) {
    const float t = x * (1.0f + 0.044715f * x * x);
    const float e = __builtin_amdgcn_exp2f(t * (-2.0f * 0.7978845608028654f * 1.4426950408889634f));
    return x * __builtin_amdgcn_rcpf(1.0f + e);
}
DI float silu_f(float x) { return x * __builtin_amdgcn_rcpf(1.0f + __builtin_amdgcn_exp2f(x * -1.4426950408889634f)); }
DI float sigmoid_f(float x) { return __builtin_amdgcn_rcpf(1.0f + __builtin_amdgcn_exp2f(x * -1.4426950408889634f)); }
#define LDS_WAIT() asm volatile("s_waitcnt lgkmcnt(0)" ::: "memory")
#define VM_WAIT() asm volatile("s_waitcnt vmcnt(0)" ::: "memory")

namespace pg8 {
constexpr int BM = 256, BK = 64, HALF = 128, HTB = HALF * BK * 2, STAGE_BYTES = 8 * HTB, NXCD = 8, WGM = 8;
__host__ __device__ __forceinline__ int lds_byte(int r, int c) { const int st = (r >> 4) * 2 + (c >> 5), rr = r & 15, cc = c & 31, ob = rr * 64 + cc * 2; return st * 1024 + (ob ^ (((ob >> 9) & 1) << 5)); }
__host__ __device__ __forceinline__ void stage_rc(int b, int& R, int& C) { const int st = b / 1024, sb = b % 1024, swz = sb ^ (((sb >> 9) & 1) << 5); R = (st >> 1) * 16 + swz / 64; C = (st & 1) * 32 + (swz % 64) / 2; }
__host__ __device__ __forceinline__ int perm32(int rho) { const int n = rho >> 4, i = rho & 15; return 8 * (i >> 2) + 4 * n + (i & 3); }

struct Unit { int pm, pn, gi; };

struct MultiOrder {
    const bf16_t* A0; const bf16_t* B0; const bf16_t* A1; const bf16_t* B1;
    int nM0, nN0, nM1, nN1, n0, ntot, G, c; size_t tstep;
    DI void init(const bf16_t* a0, const bf16_t* b0, int M0, int N0, const bf16_t* a1, const bf16_t* b1, int M1, int N1, int K, int G_, int c_) {
        A0 = a0; B0 = b0; A1 = a1; B1 = b1; nM0 = M0 / BM; nN0 = N0 / BM; nM1 = M1 / BM; nN1 = N1 / BM; n0 = nM0 * nN0; ntot = n0 + nM1 * nN1; G = G_; c = c_; tstep = (size_t)BM * K * 2;
    }
    DI bool next(int i, Unit& u) const {
        const long L = (long)i * G + c; if (L >= ntot) return false;
        const int gi = (L >= n0) ? 1 : 0; int wgid = gi ? (int)L - n0 : (int)L; const int nM = gi ? nM1 : nM0, nN = gi ? nN1 : nN0, nwg = nM * nN;
        { const int q = nwg / NXCD, r = nwg % NXCD, xcd = wgid % NXCD, off = wgid / NXCD; wgid = (xcd < r ? xcd * (q + 1) : r * (q + 1) + (xcd - r) * q) + off; }
        const int nig = WGM * nN, gid = wgid / nig, fm = gid * WGM, gsz = (nM - fm) < WGM ? (nM - fm) : WGM;
        u.pm = fm + ((wgid % nig) % gsz); u.pn = (wgid % nig) / gsz; u.gi = gi; return true;
    }
    DI const char* baseA(const Unit& u) const { return (const char*)(u.gi ? A1 : A0) + (size_t)u.pm * tstep; }
    DI const char* baseB(const Unit& u) const { return (const char*)(u.gi ? B1 : B0) + (size_t)u.pn * tstep; }
};

DI unsigned cvt_pk_bf16(float lo, float hi) { unsigned r; asm volatile("v_cvt_pk_bf16_f32 %0, %1, %2" : "=v"(r) : "v"(lo), "v"(hi)); return r; }

template <class Epi, class Sched, bool ALIGN_EPI = false, bool SP2 = false>
DI void gemm_phase(LAS unsigned char* lds, const int K, const Sched& S, const Epi& E) {
    const int tid = threadIdx.x, wid = __builtin_amdgcn_readfirstlane(tid >> 6), lane = tid & 63, wr = wid >> 2, wc = wid & 3, fr = lane & 15, fq = lane >> 4;
    const int nt = K / BK;
    unsigned voffA[2], voffB[2];
#pragma unroll
    for (int i = 0; i < 2; ++i) { int R, C; stage_rc(tid * 16 + i * 8192, R, C); const int Rb = Epi::PERM ? ((R & ~31) + perm32(R & 31)) : R;
        voffA[i] = (unsigned)(R * K + C) * 2u; voffB[i] = (unsigned)(Rb * K + C) * 2u; }
    const size_t kstep = (size_t)(BK * 2);
    const size_t hstep = (size_t)HALF * K * 2;
    const unsigned ldsw = (unsigned)wid * 1024u;
    const int aoff = lds_byte(wr * 64 + fr, fq * 8), boff = lds_byte(wc * 32 + fr, fq * 8);
#define PG8_SA(b, h) (((b) * 2 + (h)) * HTB)
#define PG8_SB(b, h) ((4 + (b) * 2 + (h)) * HTB)
#define PG8_STAGE(bufoff, gbase, voff) do { _Pragma("unroll") for (int _i = 0; _i < 2; ++_i) \
        __builtin_amdgcn_global_load_lds((const unsigned*)((const char*)(gbase) + (voff)[_i]), (LAS unsigned*)(lds + (bufoff) + ldsw + _i * 8192), 16, 0, 0); } while (0)
#define PG8_LDA(dst, b, h) do { _Pragma("unroll") for (int m = 0; m < 4; ++m) _Pragma("unroll") for (int k = 0; k < 2; ++k) dst[m][k] = *(const LAS bf16x8*)(lds + PG8_SA(b, h) + aoff + m * 2048 + k * 1024); } while (0)
#define PG8_LDB(dst, b, h) do { _Pragma("unroll") for (int n = 0; n < 2; ++n) _Pragma("unroll") for (int k = 0; k < 2; ++k) dst[n][k] = *(const LAS bf16x8*)(lds + PG8_SB(b, h) + boff + n * 2048 + k * 1024); } while (0)
#define PG8_MMA(ai, bj, At, Bt) do { __builtin_amdgcn_s_setprio(1); _Pragma("unroll") for (int m = 0; m < 4; ++m) _Pragma("unroll") for (int n = 0; n < 2; ++n) _Pragma("unroll") for (int k = 0; k < 2; ++k) \
        acc[ai][bj][m][n] = __builtin_amdgcn_mfma_f32_16x16x32_bf16(Bt[n][k], At[m][k], acc[ai][bj][m][n], 0, 0, 0); __builtin_amdgcn_s_setprio(0); } while (0)
#define PG8_WAIT_V(n) asm volatile("s_waitcnt vmcnt(" #n ")" ::: "memory")
#define PG8_WAIT_L(n) asm volatile("s_waitcnt lgkmcnt(" #n ")" ::: "memory")
#define PG8_BAR __builtin_amdgcn_s_barrier()
#define PG8_SCHED __builtin_amdgcn_sched_barrier(0)
    Unit cur, nxt; int ui = 0;
    if (!S.next(0, cur)) return;
    f32x4 acc[2][2][4][2];
#pragma unroll
    for (int a = 0; a < 2; ++a)
#pragma unroll
        for (int b = 0; b < 2; ++b)
#pragma unroll
            for (int m = 0; m < 4; ++m)
#pragma unroll
                for (int n = 0; n < 2; ++n) acc[a][b][m][n] = (f32x4){0.f, 0.f, 0.f, 0.f};
    bf16x8 At[4][2], B0[2][2], B1[2][2];
    const char* cA = S.baseA(cur); const char* cB = S.baseB(cur);
    if constexpr (SP2) {
        PG8_STAGE(PG8_SB(0, 0), cB, voffB); PG8_STAGE(PG8_SB(0, 1), cB + hstep, voffB); PG8_STAGE(PG8_SA(0, 0), cA, voffA); PG8_STAGE(PG8_SA(0, 1), cA + hstep, voffA);
        if (wr == 1) PG8_BAR;
        PG8_WAIT_V(2); PG8_BAR;
        PG8_STAGE(PG8_SB(1, 0), cB + kstep, voffB); PG8_STAGE(PG8_SA(1, 0), cA + kstep, voffA); PG8_STAGE(PG8_SB(1, 1), cB + hstep + kstep, voffB);
        PG8_WAIT_V(6); PG8_BAR;
    } else {
        PG8_STAGE(PG8_SB(0, 0), cB, voffB); PG8_STAGE(PG8_SA(0, 0), cA, voffA); PG8_STAGE(PG8_SB(0, 1), cB + hstep, voffB); PG8_STAGE(PG8_SA(0, 1), cA + hstep, voffA);
        if (wr == 1) PG8_BAR;
        PG8_WAIT_V(4); PG8_BAR;
        PG8_STAGE(PG8_SB(1, 0), cB + kstep, voffB); PG8_STAGE(PG8_SA(1, 0), cA + kstep, voffA); PG8_STAGE(PG8_SB(1, 1), cB + hstep + kstep, voffB);
        PG8_WAIT_V(6); PG8_BAR;
    }
    for (;;) {
        const bool has_next = S.next(ui + 1, nxt);
        const char* nA = has_next ? S.baseA(nxt) : cA; const char* nB = has_next ? S.baseB(nxt) : cB;
        for (int t = 0; t < nt; t += 2) {
            const bool last = (t == nt - 2);
            const char* a1 = cA + (size_t)(t + 1) * kstep;
            const char* a2 = last ? nA : cA + (size_t)(t + 2) * kstep; const char* b2 = last ? nB : cB + (size_t)(t + 2) * kstep;
            const char* a3 = a2 + kstep; const char* b3 = b2 + kstep;
            if constexpr (SP2) {
            PG8_LDB(B0, 0, 0); PG8_LDB(B1, 0, 1); PG8_SCHED; PG8_LDA(At, 0, 0); PG8_STAGE(PG8_SA(1, 1), a1 + hstep, voffA);
            PG8_WAIT_V(8); PG8_WAIT_L(0); PG8_BAR; PG8_MMA(0, 0, At, B0); PG8_MMA(0, 1, At, B1); PG8_BAR; PG8_SCHED;
            PG8_LDA(At, 0, 1); PG8_STAGE(PG8_SB(0, 0), b2, voffB); PG8_STAGE(PG8_SB(0, 1), b2 + hstep, voffB); PG8_STAGE(PG8_SA(0, 0), a2, voffA);
            PG8_WAIT_V(8); PG8_WAIT_L(0); PG8_BAR; PG8_MMA(1, 0, At, B0); PG8_MMA(1, 1, At, B1); PG8_BAR; PG8_SCHED;
            PG8_LDB(B0, 1, 0); PG8_LDB(B1, 1, 1); PG8_SCHED; PG8_LDA(At, 1, 0); PG8_STAGE(PG8_SA(0, 1), a2 + hstep, voffA);
            PG8_WAIT_V(8); PG8_WAIT_L(0); PG8_BAR; PG8_MMA(0, 0, At, B0); PG8_MMA(0, 1, At, B1); PG8_BAR; PG8_SCHED;
            PG8_LDA(At, 1, 1); PG8_STAGE(PG8_SB(1, 0), b3, voffB); PG8_STAGE(PG8_SB(1, 1), b3 + hstep, voffB); PG8_STAGE(PG8_SA(1, 0), a3, voffA);
            PG8_WAIT_V(8); PG8_WAIT_L(0); PG8_BAR; PG8_MMA(1, 0, At, B0); PG8_MMA(1, 1, At, B1); PG8_BAR; PG8_SCHED;
            } else {
            PG8_LDB(B0, 0, 0); PG8_SCHED; PG8_LDA(At, 0, 0); PG8_STAGE(PG8_SA(1, 1), a1 + hstep, voffA);
            PG8_WAIT_L(8); PG8_BAR; PG8_WAIT_L(0); PG8_MMA(0, 0, At, B0); PG8_BAR; PG8_SCHED;
            PG8_LDB(B1, 0, 1); PG8_STAGE(PG8_SB(0, 0), b2, voffB);
            PG8_BAR; PG8_WAIT_L(0); PG8_MMA(0, 1, At, B1); PG8_BAR;
            PG8_LDA(At, 0, 1); PG8_STAGE(PG8_SA(0, 0), a2, voffA);
            PG8_BAR; PG8_WAIT_L(0); PG8_MMA(1, 0, At, B0); PG8_BAR; PG8_SCHED;
            PG8_STAGE(PG8_SB(0, 1), b2 + hstep, voffB);
            PG8_WAIT_V(6); PG8_BAR; PG8_MMA(1, 1, At, B1); PG8_BAR;
            PG8_LDB(B0, 1, 0); PG8_SCHED; PG8_LDA(At, 1, 0); PG8_STAGE(PG8_SA(0, 1), a2 + hstep, voffA);
            PG8_WAIT_L(8); PG8_BAR; PG8_WAIT_L(0); PG8_MMA(0, 0, At, B0); PG8_BAR; PG8_SCHED;
            PG8_LDB(B1, 1, 1); PG8_STAGE(PG8_SB(1, 0), b3, voffB);
            PG8_BAR; PG8_WAIT_L(0); PG8_MMA(0, 1, At, B1); PG8_BAR;
            PG8_LDA(At, 1, 1); PG8_STAGE(PG8_SA(1, 0), a3, voffA);
            PG8_BAR; PG8_WAIT_L(0); PG8_MMA(1, 0, At, B0); PG8_BAR; PG8_SCHED;
            PG8_STAGE(PG8_SB(1, 1), b3 + hstep, voffB);
            PG8_WAIT_V(6); PG8_BAR; PG8_MMA(1, 1, At, B1); PG8_BAR;
            }
        }
        if constexpr (ALIGN_EPI) { if (wr == 0) PG8_BAR; }
        { int fr_ = fr, fq_ = fq; asm volatile("" : "+v"(fr_), "+v"(fq_)); E(acc, cur, wr, wc, fr_, fq_); }
        if (!has_next) break;
#pragma unroll
        for (int a = 0; a < 2; ++a)
#pragma unroll
            for (int b = 0; b < 2; ++b)
#pragma unroll
                for (int m = 0; m < 4; ++m)
#pragma unroll
                    for (int n = 0; n < 2; ++n) acc[a][b][m][n] = (f32x4){0.f, 0.f, 0.f, 0.f};
        cur = nxt; cA = nA; cB = nB; ++ui;
        if constexpr (ALIGN_EPI) { if (wr == 1) PG8_BAR; }
    }
    PG8_WAIT_V(0);
    if constexpr (!ALIGN_EPI) { if (wr == 0) PG8_BAR; }
    PG8_BAR;
#undef PG8_SA
#undef PG8_SB
#undef PG8_STAGE
#undef PG8_LDA
#undef PG8_LDB
#undef PG8_MMA
#undef PG8_WAIT_V
#undef PG8_WAIT_L
#undef PG8_BAR
#undef PG8_SCHED
}
}
#ifndef PG8_SP2
#define PG8_SP2 true
#endif
#ifndef PG8_ALIGN
#define PG8_ALIGN true
#endif

struct EpiInProj {
    static constexpr bool PERM = true;
    bf16_t* Z; int ldz; float* vstat;
    int e_gelu, e_stat, e_q, q_is_raw;
    float qscale;
    float* out_mk; float* out_mv; bf16_t* kvbf;
    DI void operator()(const f32x4 (&acc)[2][2][4][2], const pg8::Unit& u, int wr, int wc, int fr, int fq) const {
        const int row0 = u.pm * 256 + wr * 64 + fr, col0 = u.pn * 256 + wc * 32 + 8 * fq;
        if (u.gi == 1) {
            const int n0 = u.pn * 256; const int layer = n0 >> 10, kv = (n0 >> 9) & 1, cb = (n0 & 511) + wc * 32 + 8 * fq;
            float* ob = (kv ? out_mv : out_mk) + (size_t)layer * MMEM * XA; bf16_t* kb = kvbf + (size_t)(layer * 2 + kv) * MMEM * XA;
#pragma unroll
            for (int ai = 0; ai < 2; ++ai)
#pragma unroll
                for (int m = 0; m < 4; ++m) { const size_t ro = (size_t)(row0 + ai * 128 + m * 16) * XA + cb;
#pragma unroll
                    for (int bj = 0; bj < 2; ++bj) { const f32x4 v0 = acc[ai][bj][m][0], v1 = acc[ai][bj][m][1];
                        *(f32x4*)(ob + ro + bj * 128) = v0; *(f32x4*)(ob + ro + bj * 128 + 4) = v1;
                        u32x4 w; w.x = pg8::cvt_pk_bf16(v0[0], v0[1]); w.y = pg8::cvt_pk_bf16(v0[2], v0[3]); w.z = pg8::cvt_pk_bf16(v1[0], v1[1]); w.w = pg8::cvt_pk_bf16(v1[2], v1[3]);
                        *(u32x4*)(kb + ro + bj * 128) = w; } }
            return;
        }
        const int kind = (u.pn < e_gelu) ? (q_is_raw ? 0 : 1) : (u.pn < e_stat) ? 2 : (u.pn < e_q) ? 3 : 4;
#pragma unroll
        for (int ai = 0; ai < 2; ++ai)
#pragma unroll
            for (int m = 0; m < 4; ++m) { const int row = row0 + ai * 128 + m * 16; bf16_t* rowp = Z + (size_t)row * ldz + col0; float s1 = 0.f, s2 = 0.f;
#pragma unroll
                for (int bj = 0; bj < 2; ++bj) { f32x4 v0 = acc[ai][bj][m][0], v1 = acc[ai][bj][m][1];
                    if (kind == 1 || kind == 2) {
#pragma unroll
                        for (int e = 0; e < 4; ++e) { v0[e] = gelu_tanh(v0[e]); v1[e] = gelu_tanh(v1[e]); }
                    } else if (kind == 3) { v0 = v0 * qscale; v1 = v1 * qscale; }
                    else if (kind == 4) {
#pragma unroll
                        for (int e = 0; e < 4; ++e) { v0[e] = silu_f(v0[e]); v1[e] = silu_f(v1[e]); }
                    }
                    if (kind == 2) {
#pragma unroll
                        for (int e = 0; e < 4; ++e) { s1 += v0[e] + v1[e]; s2 += v0[e] * v0[e] + v1[e] * v1[e]; }
                    }
                    u32x4 w; w.x = pg8::cvt_pk_bf16(v0[0], v0[1]); w.y = pg8::cvt_pk_bf16(v0[2], v0[3]); w.z = pg8::cvt_pk_bf16(v1[0], v1[1]); w.w = pg8::cvt_pk_bf16(v1[2], v1[3]);
                    *(u32x4*)(rowp + bj * 128) = w; }
                if (kind == 2) { s1 += __shfl_xor(s1, 16); s1 += __shfl_xor(s1, 32); s2 += __shfl_xor(s2, 16); s2 += __shfl_xor(s2, 32);
                    if (fq == 0) { atomicAdd(vstat + 2 * (size_t)row, s1); atomicAdd(vstat + 2 * (size_t)row + 1, s2); } }
            }
    }
};
struct EpiOut {
    static constexpr bool PERM = true;
    float* O; float* ss;
    DI void operator()(const f32x4 (&acc)[2][2][4][2], const pg8::Unit& u, int wr, int wc, int fr, int fq) const {
        const int row0 = u.pm * 256 + wr * 64 + fr, col0 = u.pn * 256 + wc * 32 + 8 * fq;
#pragma unroll
        for (int ai = 0; ai < 2; ++ai)
#pragma unroll
            for (int m = 0; m < 4; ++m) { const int row = row0 + ai * 128 + m * 16; float* rowp = O + (size_t)row * D + col0; float s2 = 0.f;
#pragma unroll
                for (int bj = 0; bj < 2; ++bj) { const f32x4 v0 = acc[ai][bj][m][0], v1 = acc[ai][bj][m][1];
                    *(f32x4*)(rowp + bj * 128) = v0; *(f32x4*)(rowp + bj * 128 + 4) = v1;
#pragma unroll
                    for (int e = 0; e < 4; ++e) s2 += v0[e] * v0[e] + v1[e] * v1[e]; }
                s2 += __shfl_xor(s2, 16); s2 += __shfl_xor(s2, 32);
                if (fq == 0) atomicAdd(ss + row, s2);
            }
    }
};
struct EpiGlu {
    static constexpr bool PERM = true;
    const bf16_t* YG; const bf16_t* Z1; const float* bglu; bf16_t* MIX;
    DI void operator()(const f32x4 (&acc)[2][2][4][2], const pg8::Unit& u, int wr, int wc, int fr, int fq) const {
        const int row0 = u.pm * 256 + wr * 64 + fr, col0 = u.pn * 256 + wc * 32 + 8 * fq;
        f32x4 bv[2][2];
#pragma unroll
        for (int bj = 0; bj < 2; ++bj)
#pragma unroll
            for (int n = 0; n < 2; ++n) bv[bj][n] = *(const f32x4*)(bglu + col0 + bj * 128 + 4 * n);
#pragma unroll
        for (int ai = 0; ai < 2; ++ai)
#pragma unroll
            for (int m = 0; m < 4; ++m) { const int row = row0 + ai * 128 + m * 16;
#pragma unroll
                for (int bj = 0; bj < 2; ++bj) { const int col = col0 + bj * 128;
                    const u32x4 yg = *(const u32x4*)(YG + (size_t)row * BR + col); const u32x4 sg = *(const u32x4*)(Z1 + (size_t)row * NBW + (BR + XA) + col);
                    const f32x4 v0 = acc[ai][bj][m][0] + bv[bj][0], v1 = acc[ai][bj][m][1] + bv[bj][1];
                    float o[8]; const float a8[8] = {v0[0], v0[1], v0[2], v0[3], v1[0], v1[1], v1[2], v1[3]};
#pragma unroll
                    for (int e = 0; e < 4; ++e) { const unsigned yw = yg[e], sw = sg[e];
                        const float y0 = __uint_as_float(yw << 16), y1 = __uint_as_float(yw & 0xffff0000u), g0 = __uint_as_float(sw << 16), g1 = __uint_as_float(sw & 0xffff0000u);
                        o[2 * e] = y0 * sigmoid_f(a8[2 * e]) * g0; o[2 * e + 1] = y1 * sigmoid_f(a8[2 * e + 1]) * g1; }
                    u32x4 w; w.x = pg8::cvt_pk_bf16(o[0], o[1]); w.y = pg8::cvt_pk_bf16(o[2], o[3]); w.z = pg8::cvt_pk_bf16(o[4], o[5]); w.w = pg8::cvt_pk_bf16(o[6], o[7]);
                    *(u32x4*)(MIX + (size_t)row * MW + col) = w; } }
    }
};

#define XB_TMO      128
#define XB_XCNT(j)  (256  + 64 * (j))
#define XB_XSUB(j)  (1280 + 64 * (j))
#define XB_XGEN(j)  (2304 + 64 * (j))
#define XB_TOP      3328
#define XB_TOPGEN   3392
#define XCD_BAR_WORDS 3456
#define XB_SPIN_CAP (1u << 18)
DI unsigned xb_ld(unsigned* p)              { return __hip_atomic_load(p, __ATOMIC_RELAXED, __HIP_MEMORY_SCOPE_AGENT); }
DI unsigned xb_add(unsigned* p, unsigned v) { return __hip_atomic_fetch_add(p, v, __ATOMIC_RELAXED, __HIP_MEMORY_SCOPE_AGENT); }
DI unsigned xb_xcc_id() { return (unsigned)__builtin_amdgcn_s_getreg((3 << 11) | 20) & 0xFu; }
#define XB_SPIN(cond, bar) do { unsigned _sp = 0; while (cond) { __builtin_amdgcn_s_sleep(1); \
    if ((++_sp & 255u) == 0u) { if (xb_ld(&(bar)[XB_TMO])) break; if (_sp > XB_SPIN_CAP) { atomicAdd(&(bar)[XB_TMO], 1u); break; } } } } while (0)
struct XcdBarrier { unsigned* bar; unsigned x; volatile LAS unsigned* st; };
DI XcdBarrier xcd_barrier_post(unsigned* bar, volatile LAS unsigned* st) {
    XcdBarrier b; b.bar = bar; b.x = xb_xcc_id(); b.st = st;
    if (threadIdx.x == 0) (void)xb_add(&bar[XB_XCNT(b.x)], 1u);
    return b;
}
DI void xcd_barrier_complete(unsigned* bar, unsigned x, unsigned& nloc, unsigned& nx) {
    const unsigned G = gridDim.x * gridDim.y * gridDim.z;
    unsigned sum, cnt, mine, sp = 0u;
    for (;;) {
        sum = 0u; cnt = 0u; mine = 0u;
#pragma unroll
        for (unsigned j = 0; j < 16; ++j) { const unsigned c = xb_ld(&bar[XB_XCNT(j)]); sum += c; cnt += (c > 0u) ? 1u : 0u; mine = (j == x) ? c : mine; }
        if (sum == G) break;
        __builtin_amdgcn_s_sleep(1);
        if ((++sp & 255u) == 0u) { if (xb_ld(&bar[XB_TMO])) break; if (sp > XB_SPIN_CAP) { atomicAdd(&bar[XB_TMO], 1u); break; } }
    }
    nloc = mine > 0u ? mine : 1u; nx = cnt > 0u ? cnt : 1u;
}
DI void xcd_barrier(const XcdBarrier& b) {
    asm volatile("s_waitcnt vmcnt(0)" ::: "memory");
    __syncthreads();
    if (threadIdx.x == 0) {
        unsigned* bar = b.bar;
        __builtin_amdgcn_s_waitcnt(0);
        unsigned nloc = b.st[0], nx = b.st[1];
        if (nloc == 0u) { xcd_barrier_complete(bar, b.x, nloc, nx); b.st[0] = nloc; b.st[1] = nx; }
        const unsigned old = xb_add(&bar[XB_XSUB(b.x)], 1u);
        const unsigned gen = old / nloc;
        if (old + 1u == (gen + 1u) * nloc) {
            __builtin_amdgcn_fence(__ATOMIC_RELEASE, "agent");
            asm volatile("s_waitcnt vmcnt(0)" ::: "memory");
            const unsigned og = xb_add(&bar[XB_TOP], 1u);
            const unsigned tg = og / nx;
            if (og + 1u == (tg + 1u) * nx) xb_add(&bar[XB_TOPGEN], 1u);
            else XB_SPIN(xb_ld(&bar[XB_TOPGEN]) == tg, bar);
            __builtin_amdgcn_fence(__ATOMIC_ACQUIRE, "agent");
            xb_add(&bar[XB_XGEN(b.x)], 1u);
            asm volatile("s_waitcnt vmcnt(0)" ::: "memory");
        } else {
            XB_SPIN(xb_ld(&bar[XB_XGEN(b.x)]) == gen, bar);
            __builtin_amdgcn_fence(__ATOMIC_ACQUIRE, "agent");
            asm volatile("s_waitcnt vmcnt(0)" ::: "memory");
        }
    }
    __syncthreads();
}

struct Args {
    const float* in[29]; float* out; unsigned char* ws; int ph_lo, ph_hi, li, pad;
};
constexpr int NWAVES = 8, NTHR = NWAVES * 64;
constexpr int RING_BYTES = 131072, MISC_OFF = RING_BYTES + 320, LDS_BYTES = 147456;

DI void p0_transpose_item(const float* W, const float* gk, int K, int N, bf16_t* WT, int row_off, LAS float* scr, int item, int lane) {
    const int nblk = N / 32, kb = item / nblk, nb = item % nblk, k0 = 64 * kb, n0 = 32 * nb;
#pragma unroll 8
    for (int i = 0; i < 32; ++i) { const int kk = 2 * i + (lane >> 5); float w = W[(size_t)(k0 + kk) * N + n0 + (lane & 31)]; if (gk) w *= gk[k0 + kk]; scr[kk * 33 + (lane & 31)] = w; }
    LDS_WAIT();
    const int c = lane & 7;
#pragma unroll
    for (int j = 0; j < 4; ++j) { const int n = (lane >> 3) + 8 * j; const LAS float* s = scr + (8 * c) * 33 + n;
        u32x4 o; o.x = pk2(s[0 * 33], s[1 * 33]); o.y = pk2(s[2 * 33], s[3 * 33]); o.z = pk2(s[4 * 33], s[5 * 33]); o.w = pk2(s[6 * 33], s[7 * 33]);
        *(u32x4*)(WT + (size_t)(row_off + n0 + n) * K + k0 + 8 * c) = o; }
    LDS_WAIT();
}
DI void rms_row_to_bf16(const float* xrow, bf16_t* orow, int lane) {
    const f32x4* xr = (const f32x4*)xrow + lane;
    f32x4 v[4]; float s = 0.f;
#pragma unroll
    for (int j = 0; j < 4; ++j) { v[j] = xr[64 * j]; s += (v[j].x * v[j].x + v[j].y * v[j].y) + (v[j].z * v[j].z + v[j].w * v[j].w); }
    const float rs = 1.0f / sqrtf(wave_sum(s) * (1.f / D) + EPS);
    unsigned long long* o8 = (unsigned long long*)orow + lane;
#pragma unroll
    for (int j = 0; j < 4; ++j) o8[64 * j] = (unsigned long long)pk2(v[j].x * rs, v[j].y * rs) | ((unsigned long long)pk2(v[j].z * rs, v[j].w * rs) << 32);
}

DI void attn_naive(const bf16_t* Zb, int ldz, int qoff, int goff, const bf16_t* kbf, const bf16_t* vbf, const float* ck, const float* cv, bf16_t* MIX, LAS float* wscr, int gw, int NGW, int lane) {
    LAS float* qs = wscr; LAS float* ps = wscr + 128;
    for (int item = gw; item < M * NH; item += NGW) {
        const int row = item >> 2, h = item & 3;
        const bf16_t* zr = Zb + (size_t)row * ldz;
        { const unsigned qw = *(const unsigned*)(zr + qoff + h * HD + 2 * lane); qs[2 * lane] = __uint_as_float(qw << 16); qs[2 * lane + 1] = __uint_as_float(qw & 0xffff0000u); }
        LDS_WAIT();
        float sc[4];
        if (row < MP) {
            const int b = row >> 11; const bf16_t* kb = kbf + (size_t)(b * NMEM) * XA + h * HD;
#pragma unroll
            for (int kk = 0; kk < 4; ++kk) { const bf16_t* kr = kb + (size_t)(lane + 64 * kk) * XA; float a = 0.f;
#pragma unroll 2
                for (int d8 = 0; d8 < 16; ++d8) { const u32x4 kw = *(const u32x4*)(kr + 8 * d8); const LAS float* q = qs + 8 * d8;
#pragma unroll
                    for (int e = 0; e < 4; ++e) { a += q[2 * e] * __uint_as_float(kw[e] << 16); a += q[2 * e + 1] * __uint_as_float(kw[e] & 0xffff0000u); } }
                sc[kk] = a; }
        } else {
            const int b = (row - MP) >> 2; const float* kb = ck + (size_t)(b * NMEM) * XA + h * HD;
#pragma unroll
            for (int kk = 0; kk < 4; ++kk) { const float* kr = kb + (size_t)(lane + 64 * kk) * XA; float a = 0.f;
#pragma unroll 4
                for (int d4 = 0; d4 < 32; ++d4) { const f32x4 kw = *(const f32x4*)(kr + 4 * d4); const LAS float* q = qs + 4 * d4;
                    a += q[0] * kw.x + q[1] * kw.y + q[2] * kw.z + q[3] * kw.w; }
                sc[kk] = a; }
        }
        const float mx = wave_max(fmaxf(fmaxf(sc[0], sc[1]), fmaxf(sc[2], sc[3])));
        float sum = 0.f;
#pragma unroll
        for (int kk = 0; kk < 4; ++kk) { const float p = __builtin_amdgcn_exp2f((sc[kk] - mx) * 1.4426950408889634f); sum += p; ps[lane + 64 * kk] = p; }
        sum = wave_sum(sum);
        LDS_WAIT();
        float o0 = 0.f, o1 = 0.f;
        if (row < MP) {
            const int b = row >> 11; const bf16_t* vb = vbf + (size_t)(b * NMEM) * XA + h * HD + 2 * lane;
#pragma unroll 8
            for (int m = 0; m < NMEM; ++m) { const unsigned vw = *(const unsigned*)(vb + (size_t)m * XA); const float p = ps[m]; o0 += p * __uint_as_float(vw << 16); o1 += p * __uint_as_float(vw & 0xffff0000u); }
        } else {
            const int b = (row - MP) >> 2; const float* vb = cv + (size_t)(b * NMEM) * XA + h * HD + 2 * lane;
#pragma unroll 8
            for (int m = 0; m < NMEM; ++m) { const f32x2 vw = *(const f32x2*)(vb + (size_t)m * XA); const float p = ps[m]; o0 += p * vw.x; o1 += p * vw.y; }
        }
        const float inv = 1.0f / sum;
        const unsigned gwd = *(const unsigned*)(zr + goff + h * HD + 2 * lane);
        o0 *= inv * __uint_as_float(gwd << 16); o1 *= inv * __uint_as_float(gwd & 0xffff0000u);
        *(unsigned*)(MIX + (size_t)row * MW + BR + h * HD + 2 * lane) = pk2(o0, o1);
        LDS_WAIT();
    }
}

template <int LO, int HI> __global__ void __launch_bounds__(NTHR, 2) mega(Args args) {
    extern __shared__ __attribute__((aligned(16))) unsigned char lds_raw[];
    LAS unsigned char* lds = (LAS unsigned char*)lds_raw;
    const int tid = threadIdx.x, lane = tid & 63, wave = __builtin_amdgcn_readfirstlane(tid >> 6);
    const int G = gridDim.x, bx = blockIdx.x;
    const int vcu = (G % 8 == 0) ? (bx % 8) * (G / 8) + bx / 8 : bx;
    const int gw = vcu * NWAVES + wave, NGW = G * NWAVES;
    unsigned char* ws = args.ws;
    unsigned* ctl = (unsigned*)(ws + WS_CTL);
    volatile LAS unsigned* MISC = (volatile LAS unsigned*)(lds + MISC_OFF);
    for (int u = tid; u < (LDS_BYTES - RING_BYTES) / 4; u += NTHR) ((LAS unsigned*)(lds + RING_BYTES))[u] = 0u;
    __syncthreads();
    XcdBarrier bar; bar.bar = ctl + CW_BAR; bar.x = 0; bar.st = nullptr;
    if constexpr (HI - LO > 1) bar = xcd_barrier_post(ctl + CW_BAR, MISC + 8);
#define IN(k) (LO <= (k) && (k) < HI)
#define SEAM(k) do { if constexpr (IN(k) && IN((k) + 1)) xcd_barrier(bar); } while (0)

#define x_prompt (args.in[0])
#define x_sample (args.in[1])
#define cache_k (args.in[2])
#define cache_v (args.in[3])
#define st_re (args.in[4])
#define st_im (args.in[5])
#define mem_prompt (args.in[6])
#define w_in_a (args.in[7])
#define ln_v_g (args.in[8])
#define ln_v_b (args.in[9])
#define w_spatial (args.in[10])
#define b_spatial (args.in[11])
#define w_in_b (args.in[12])
#define lam_re (args.in[13])
#define lam_im (args.in[14])
#define log_dt (args.in[15])
#define sb_re (args.in[16])
#define sb_im (args.in[17])
#define sc_re (args.in[18])
#define sc_im (args.in[19])
#define ssm_d (args.in[20])
#define w_glu (args.in[21])
#define b_glu (args.in[22])
#define mem_norm_g (args.in[23])
#define w_mem_k (args.in[24])
#define w_mem_v (args.in[25])
#define w_out (args.in[26])
#define pre_g (args.in[27])
#define post_g (args.in[28])
#define out (args.out)
#define WinA ((bf16_t*)(ws + WS_WINA))
#define WinB ((bf16_t*)(ws + WS_WINB))
#define Wglu ((bf16_t*)(ws + WS_WGLU))
#define Wout0 ((bf16_t*)(ws + WS_WOUT0))
#define Wout1 ((bf16_t*)(ws + WS_WOUT1))
#define Wmem ((bf16_t*)(ws + WS_WMEM))
#define MEMN ((bf16_t*)(ws + WS_MEMN))
#define KVBF ((bf16_t*)(ws + WS_KVBF))
#define SMALL ((float*)(ws + WS_SMALL))
#define XN ((bf16_t*)(ws + WS_XN))
#define Z ((bf16_t*)(ws + WS_Z))
#define YG ((bf16_t*)(ws + WS_YG))
#define MIX ((bf16_t*)(ws + WS_MIX))
#define OUT ((float*)(ws + WS_OUT))
#define Y1 ((float*)(ws + WS_Y1))
#define VSTAT (SMALL + SM_VSTAT)
#define SS0 (SMALL + SM_SS0)
#define SS1 (SMALL + SM_SS1)
#define LB (SMALL + SM_LB)
#define BB (SMALL + SM_BB)

    if constexpr (IN(0)) {
        LAS float* scr = (LAS float*)(lds + wave * 16384);
        constexpr int I_A = (D / 64) * (NA / 32), I_B = (D / 64) * (NBW / 32), I_G = (BR / 64) * (BR / 32), I_O = (MW / 64) * (D / 32), I_M = (D / 64) * (XA / 32);
        constexpr int NITEMS = I_A + I_B + I_G + 2 * I_O + 4 * I_M;
        for (int it = gw; it < NITEMS; it += NGW) {
            int r = it;
            if (r < I_A) { p0_transpose_item(w_in_a, pre_g, D, NA, WinA, 0, scr, r, lane); continue; } r -= I_A;
            if (r < I_B) { p0_transpose_item(w_in_b, pre_g + D, D, NBW, WinB, 0, scr, r, lane); continue; } r -= I_B;
            if (r < I_G) { p0_transpose_item(w_glu, nullptr, BR, BR, Wglu, 0, scr, r, lane); continue; } r -= I_G;
            if (r < I_O) { p0_transpose_item(w_out, nullptr, MW, D, Wout0, 0, scr, r, lane); continue; } r -= I_O;
            if (r < I_O) { p0_transpose_item(w_out + (size_t)MW * D, nullptr, MW, D, Wout1, 0, scr, r, lane); continue; } r -= I_O;
            const int which = r / I_M; r -= which * I_M;
            const int layer = which >> 1; const float* wsrc = ((which & 1) ? w_mem_v : w_mem_k) + (size_t)layer * D * XA;
            p0_transpose_item(wsrc, mem_norm_g + layer * D, D, XA, Wmem, which * XA, scr, r, lane);
        }
        for (int m = gw; m < M + MMEM; m += NGW) {
            if (m < MP) rms_row_to_bf16(x_prompt + (size_t)m * D, XN + (size_t)m * D, lane);
            else if (m < M) rms_row_to_bf16(x_sample + (size_t)(m - MP) * D, XN + (size_t)m * D, lane);
            else rms_row_to_bf16(mem_prompt + (size_t)(m - M) * D, MEMN + (size_t)(m - M) * D, lane);
        }
        for (size_t i = (size_t)bx * NTHR + tid; i < SM_ZERO_END; i += (size_t)G * NTHR) SMALL[i] = 0.f;
        for (int i = bx * NTHR + tid; i < SG * SP; i += G * NTHR) {
            const int g = i / SP; const float dt = expf(log_dt[g]); const float lr = lam_re[i], li = lam_im[i];
            const float ar = lr * dt, ai = li * dt; const float e = expf(ar), cs = cosf(ai), sn = sinf(ai);
            const float lbr = e * cs, lbi = e * sn; LB[2 * i] = lbr; LB[2 * i + 1] = lbi;
            const float sh = sinf(0.5f * ai); const float nr = expm1f(ar) * cs - 2.0f * sh * sh, ni = lbi;
            const float den = lr * lr + li * li; const float qr = (nr * lr + ni * li) / den, qi = (ni * lr - nr * li) / den;
            for (int c = 0; c < SC; ++c) { const float br = sb_re[(size_t)i * SC + c], bi = sb_im[(size_t)i * SC + c];
                BB[((size_t)i * SC + c) * 2] = qr * br - qi * bi; BB[((size_t)i * SC + c) * 2 + 1] = qr * bi + qi * br; }
        }
    }
    SEAM(0);

    if constexpr (IN(1)) {
        pg8::MultiOrder S; S.init(XN, WinA, M, NA, MEMN, Wmem, MMEM, 2 * 2 * XA, D, G, bx);
        EpiInProj E{Z, NA, VSTAT, BR / 256, 2 * BR / 256, (2 * BR + XA) / 256, 0, 0.08838834764831845f, out + O_MK, out + O_MV, KVBF};
        pg8::gemm_phase<EpiInProj, pg8::MultiOrder, PG8_ALIGN, PG8_SP2>(lds, D, S, E);
    }
    SEAM(1);

    if constexpr (IN(2)) {
        LAS float* Wl = (LAS float*)lds;
        LAS float* vl = (LAS float*)(lds + 128 * 129 * 4);
        for (int item = vcu; item < (MP / CH) * AG * 3; item += G) {
            const int ds = item % 3, g = (item / 3) % AG, c = item / (3 * AG);
            __syncthreads();
            for (int i = tid; i < CH * CH; i += NTHR) { const int t = i >> 7, s = i & 127; Wl[t * 129 + s] = (s <= t) ? w_spatial[(size_t)g * CH * CH + i] : 0.f; }
            for (int i = tid; i < CH * 64; i += NTHR) { const int s = i >> 6, cc = i & 63; const int row = c * CH + s, vcol = g * AD + ds * 64 + cc;
                const float v = bf2f(Z[(size_t)row * NA + BR + vcol]); const float mean = VSTAT[2 * row] * (1.f / BR); const float var = VSTAT[2 * row + 1] * (1.f / BR) - mean * mean;
                vl[i] = (v - mean) * (1.0f / sqrtf(var + EPS)) * ln_v_g[vcol] + ln_v_b[vcol]; }
            __syncthreads();
            const int t = tid >> 2, dq = tid & 3; float a[16];
#pragma unroll
            for (int j = 0; j < 16; ++j) a[j] = 0.f;
            for (int s = 0; s <= t; ++s) { const float w = Wl[t * 129 + s]; const LAS f32x4* vv = (const LAS f32x4*)(vl + s * 64 + dq * 16);
#pragma unroll
                for (int j4 = 0; j4 < 4; ++j4) { const f32x4 x = vv[j4]; a[4 * j4] += w * x.x; a[4 * j4 + 1] += w * x.y; a[4 * j4 + 2] += w * x.z; a[4 * j4 + 3] += w * x.w; } }
            const int row = c * CH + t, col = g * AD + ds * 64 + dq * 16; const float bs = b_spatial[g * CH + t];
            const bf16_t* zr = Z + (size_t)row * NA;
#pragma unroll
            for (int j = 0; j < 16; j += 2) { const unsigned uw = *(const unsigned*)(zr + col + j), gwd = *(const unsigned*)(zr + (2 * BR + XA) + col + j);
                const float o0 = __uint_as_float(uw << 16) * (a[j] + bs) * __uint_as_float(gwd << 16), o1 = __uint_as_float(uw & 0xffff0000u) * (a[j + 1] + bs) * __uint_as_float(gwd & 0xffff0000u);
                *(unsigned*)(MIX + (size_t)row * MW + col + j) = pk2(o0, o1); }
        }
        __syncthreads();
        for (int i = bx * NTHR + tid; i < NB_S * BR; i += G * NTHR) {
            const int b = i / BR, col = i % BR, g = col / AD; float vn[4];
#pragma unroll
            for (int t = 0; t < 4; ++t) { const int row = MP + b * 4 + t; const float v = bf2f(Z[(size_t)row * NA + BR + col]); const float mean = VSTAT[2 * row] * (1.f / BR); const float var = VSTAT[2 * row + 1] * (1.f / BR) - mean * mean;
                vn[t] = (v - mean) * (1.0f / sqrtf(var + EPS)) * ln_v_g[col] + ln_v_b[col]; out[O_CV + (size_t)(b * 4 + t) * BR + col] = vn[t]; }
#pragma unroll
            for (int t = 0; t < 4; ++t) { float mx = b_spatial[g * CH + t];
#pragma unroll
                for (int s = 0; s < 4; ++s) if (s <= t) mx += w_spatial[(size_t)g * CH * CH + t * CH + s] * vn[s];
                const int row = MP + b * 4 + t; const bf16_t* zr = Z + (size_t)row * NA;
                MIX[(size_t)row * MW + col] = (bf16_t)f2bf(bf2f(zr[col]) * mx * bf2f(zr[2 * BR + XA + col])); }
        }
        attn_naive(Z, NA, 2 * BR, 2 * BR + XA + BR, KVBF, KVBF + (size_t)MMEM * XA, cache_k, cache_v, MIX, (LAS float*)(lds + 100352 + wave * 2048), gw, NGW, lane);
    }
    SEAM(2);

    if constexpr (IN(3)) {
        pg8::MultiOrder S; S.init(MIX, Wout0, M, D, MIX, Wout0, 0, 0, MW, G, bx);
        EpiOut E{OUT, SS0};
        pg8::gemm_phase<EpiOut, pg8::MultiOrder, PG8_ALIGN, PG8_SP2>(lds, MW, S, E);
    }
    SEAM(3);

    if constexpr (IN(4)) {
        for (int m = gw; m < M; m += NGW) {
            const float* xr = (m < MP) ? x_prompt + (size_t)m * D : x_sample + (size_t)(m - MP) * D;
            const float rs = 1.0f / sqrtf(SS0[m] * (1.f / D) + EPS);
            f32x4 v[4]; float s = 0.f;
#pragma unroll
            for (int j = 0; j < 4; ++j) { const f32x4 xv = ((const f32x4*)xr)[lane + 64 * j], ov = ((const f32x4*)(OUT + (size_t)m * D))[lane + 64 * j], gv = ((const f32x4*)post_g)[lane + 64 * j];
                v[j] = xv + ov * rs * gv; ((f32x4*)(Y1 + (size_t)m * D))[lane + 64 * j] = v[j];
                s += (v[j].x * v[j].x + v[j].y * v[j].y) + (v[j].z * v[j].z + v[j].w * v[j].w); }
            const float rs1 = 1.0f / sqrtf(wave_sum(s) * (1.f / D) + EPS);
            unsigned long long* o8 = (unsigned long long*)(XN + (size_t)m * D) + lane;
#pragma unroll
            for (int j = 0; j < 4; ++j) o8[64 * j] = (unsigned long long)pk2(v[j].x * rs1, v[j].y * rs1) | ((unsigned long long)pk2(v[j].z * rs1, v[j].w * rs1) << 32);
        }
    }
    SEAM(4);

    if constexpr (IN(5)) {
        pg8::MultiOrder S; S.init(XN, WinB, M, NBW, XN, WinB, 0, 0, D, G, bx);
        EpiInProj E{Z, NBW, VSTAT, BR / 256, BR / 256, (BR + XA) / 256, 1, 0.08838834764831845f, out + O_MK, out + O_MV, KVBF};
        pg8::gemm_phase<EpiInProj, pg8::MultiOrder, PG8_ALIGN, PG8_SP2>(lds, D, S, E);
    }
    SEAM(5);

    if constexpr (IN(6)) {
        constexpr int NSEQ_P = NB_P * SG, NSEQ_S = NB_S * SG;
        for (int item = gw; item < NSEQ_P + NSEQ_S; item += NGW) {
            const bool isp = item < NSEQ_P; const int sidx = isp ? item : item - NSEQ_P; const int b = sidx / SG, g = sidx % SG; const int L = isp ? T_P : T_S;
            const int row0 = isp ? b * T_P : MP + b * T_S; const int p = lane;
            const float lbr = LB[2 * (g * SP + p)], lbi = LB[2 * (g * SP + p) + 1];
            float bbr[16], bbi[16], cr[16], ci[16], dg[16];
#pragma unroll
            for (int c = 0; c < 16; ++c) { bbr[c] = BB[((size_t)(g * SP + p) * SC + c) * 2]; bbi[c] = BB[((size_t)(g * SP + p) * SC + c) * 2 + 1];
                cr[c] = sc_re[((size_t)g * SC + c) * SP + p]; ci[c] = sc_im[((size_t)g * SC + c) * SP + p]; dg[c] = ssm_d[g * SC + c]; }
            float hr = 0.f, hi2 = 0.f;
            if (!isp) { hr = st_re[((size_t)b * SG + g) * SP + p]; hi2 = st_im[((size_t)b * SG + g) * SP + p]; }
            for (int t0 = 0; t0 < L; t0 += 4) {
                u32x4 uw[4][2];
#pragma unroll
                for (int tt = 0; tt < 4; ++tt) { const bf16_t* ur = Z + (size_t)(row0 + t0 + tt) * NBW + g * SC; uw[tt][0] = *(const u32x4*)ur; uw[tt][1] = *(const u32x4*)(ur + 8); }
#pragma unroll
                for (int tt = 0; tt < 4; ++tt) {
                    float u[16];
#pragma unroll
                    for (int e = 0; e < 4; ++e) { u[2 * e] = __uint_as_float(uw[tt][0][e] << 16); u[2 * e + 1] = __uint_as_float(uw[tt][0][e] & 0xffff0000u);
                        u[8 + 2 * e] = __uint_as_float(uw[tt][1][e] << 16); u[8 + 2 * e + 1] = __uint_as_float(uw[tt][1][e] & 0xffff0000u); }
                    float bur = 0.f, bui = 0.f;
#pragma unroll
                    for (int c = 0; c < 16; ++c) { bur += bbr[c] * u[c]; bui += bbi[c] * u[c]; }
                    const float nhr = lbr * hr - lbi * hi2 + bur, nhi = lbr * hi2 + lbi * hr + bui; hr = nhr; hi2 = nhi;
                    float y[16];
#pragma unroll
                    for (int c = 0; c < 16; ++c) y[c] = cr[c] * hr - ci[c] * hi2;
#pragma unroll
                    for (int i = 0; i < 8; ++i) { const bool up = (lane & 32) != 0; const float keep = up ? y[i + 8] : y[i], send = up ? y[i] : y[i + 8]; y[i] = keep + __shfl_xor(send, 32); }
#pragma unroll
                    for (int i = 0; i < 4; ++i) { const bool up = (lane & 16) != 0; const float keep = up ? y[i + 4] : y[i], send = up ? y[i] : y[i + 4]; y[i] = keep + __shfl_xor(send, 16); }
#pragma unroll
                    for (int i = 0; i < 2; ++i) { const bool up = (lane & 8) != 0; const float keep = up ? y[i + 2] : y[i], send = up ? y[i] : y[i + 2]; y[i] = keep + __shfl_xor(send, 8); }
                    { const bool up = (lane & 4) != 0; const float keep = up ? y[1] : y[0], send = up ? y[0] : y[1]; y[0] = keep + __shfl_xor(send, 4); }
                    y[0] += __shfl_xor(y[0], 1); y[0] += __shfl_xor(y[0], 2);
                    const int cidx = ((lane >> 5) & 1) * 8 + ((lane >> 4) & 1) * 4 + ((lane >> 3) & 1) * 2 + ((lane >> 2) & 1);
                    float uc = 0.f, dc = 0.f;
#pragma unroll
                    for (int c = 0; c < 16; ++c) { uc = (c == cidx) ? u[c] : uc; dc = (c == cidx) ? dg[c] : dc; }
                    const float yv = gelu_tanh(y[0] + dc * uc);
                    if ((lane & 3) == 0) YG[(size_t)(row0 + t0 + tt) * BR + g * SC + cidx] = (bf16_t)f2bf(yv);
                }
            }
            if (isp) { out[O_HPR + ((size_t)b * SG + g) * SP + p] = hr; out[O_HPI + ((size_t)b * SG + g) * SP + p] = hi2; }
            else { out[O_HSR + ((size_t)b * SG + g) * SP + p] = hr; out[O_HSI + ((size_t)b * SG + g) * SP + p] = hi2; }
        }
    }
    SEAM(6);
    if constexpr (IN(7)) {
        attn_naive(Z, NBW, BR, BR + XA + BR, KVBF + 2ull * MMEM * XA, KVBF + 3ull * MMEM * XA, cache_k + (size_t)NB_S * NMEM * XA, cache_v + (size_t)NB_S * NMEM * XA, MIX,
                   (LAS float*)(lds + 100352 + wave * 2048), gw, NGW, lane);
    }
    SEAM(7);

    if constexpr (IN(8)) {
        pg8::MultiOrder S; S.init(YG, Wglu, M, BR, YG, Wglu, 0, 0, BR, G, bx);
        EpiGlu E{YG, Z, b_glu, MIX};
        pg8::gemm_phase<EpiGlu, pg8::MultiOrder, PG8_ALIGN, PG8_SP2>(lds, BR, S, E);
    }
    SEAM(8);

    if constexpr (IN(9)) {
        pg8::MultiOrder S; S.init(MIX, Wout1, M, D, MIX, Wout1, 0, 0, MW, G, bx);
        EpiOut E{OUT, SS1};
        pg8::gemm_phase<EpiOut, pg8::MultiOrder, PG8_ALIGN, PG8_SP2>(lds, MW, S, E);
    }
    SEAM(9);

    if constexpr (IN(10)) {
        for (int m = gw; m < M; m += NGW) {
            const float rs = 1.0f / sqrtf(SS1[m] * (1.f / D) + EPS);
#pragma unroll
            for (int j = 0; j < 4; ++j) { const f32x4 yv = ((const f32x4*)(Y1 + (size_t)m * D))[lane + 64 * j], ov = ((const f32x4*)(OUT + (size_t)m * D))[lane + 64 * j], gv = ((const f32x4*)(post_g + D))[lane + 64 * j];
                ((f32x4*)(out + O_Y + (size_t)m * D))[lane + 64 * j] = yv + ov * rs * gv; }
        }
    }
#undef IN
#undef SEAM
}
#undef x_prompt
#undef x_sample
#undef cache_k
#undef cache_v
#undef st_re
#undef st_im
#undef mem_prompt
#undef w_in_a
#undef ln_v_g
#undef ln_v_b
#undef w_spatial
#undef b_spatial
#undef w_in_b
#undef lam_re
#undef lam_im
#undef log_dt
#undef sb_re
#undef sb_im
#undef sc_re
#undef sc_im
#undef ssm_d
#undef w_glu
#undef b_glu
#undef mem_norm_g
#undef w_mem_k
#undef w_mem_v
#undef w_out
#undef pre_g
#undef post_g
#undef out
#undef WinA
#undef WinB
#undef Wglu
#undef Wout0
#undef Wout1
#undef Wmem
#undef MEMN
#undef KVBF
#undef SMALL
#undef XN
#undef Z
#undef YG
#undef MIX
#undef OUT
#undef Y1
#undef VSTAT
#undef SS0
#undef SS1
#undef LB
#undef BB

template <int LO, int HI> static bool prep_kernel() {
    return hipFuncSetAttribute((const void*)mega<LO, HI>, hipFuncAttributeMaxDynamicSharedMemorySize, LDS_BYTES) == hipSuccess;
}
template <int LO, int HI> static void launch_ph(int grid, hipStream_t stream, const Args& a) { hipLaunchKernelGGL((mega<LO, HI>), dim3(grid), dim3(NTHR), LDS_BYTES, stream, a); }
extern "C" void kernel_launch(void* const* d_in, const int* in_sizes, int n_in, void* d_out, int out_size, void* d_ws, size_t ws_size, hipStream_t stream) {
    static int grid = 0;
    if (grid == 0) {
        if (n_in != 29 || (size_t)out_size != O_END || ws_size < WS_END) { fprintf(stderr, "kernel_launch: unexpected shapes (n_in %d out %d ws %zu)\n", n_in, out_size, ws_size); grid = -1; return; }
        int dev = 0, cus = 0;
        if (hipGetDevice(&dev) != hipSuccess || hipDeviceGetAttribute(&cus, hipDeviceAttributeMultiprocessorCount, dev) != hipSuccess) { grid = -1; return; }
        bool ok = true;
#if MK_N_LAUNCHES == 1
        ok = prep_kernel<0, 11>();
        int per_cu = 0;
        if (hipOccupancyMaxActiveBlocksPerMultiprocessor(&per_cu, (const void*)mega<0, 11>, NTHR, LDS_BYTES) != hipSuccess || per_cu < 1) { fprintf(stderr, "kernel_launch: occupancy query says %d blocks per CU\n", per_cu); }
#else
        ok = prep_kernel<0, 1>() && prep_kernel<1, 2>() && prep_kernel<2, 3>() && prep_kernel<3, 4>() && prep_kernel<4, 5>() && prep_kernel<5, 6>() && prep_kernel<6, 7>() && prep_kernel<7, 8>() && prep_kernel<8, 9>() && prep_kernel<9, 10>() && prep_kernel<10, 11>();
#endif
        if (!ok) { fprintf(stderr, "kernel_launch: hipFuncSetAttribute failed\n"); grid = -1; return; }
        (void)hipGetLastError();
        grid = cus;
    }
    if (grid < 0) return;
    (void)hipMemsetAsync((char*)d_ws + WS_CTL, 0, CTL_ZERO_BYTES, stream);
    Args a{};
    for (int i = 0; i < 29; ++i) a.in[i] = (const float*)d_in[i];
    a.out = (float*)d_out; a.ws = (unsigned char*)d_ws;
#if MK_N_LAUNCHES == 1
    launch_ph<0, 11>(grid, stream, a);
#else
    launch_ph<0, 1>(grid, stream, a); launch_ph<1, 2>(grid, stream, a); launch_ph<2, 3>(grid, stream, a); launch_ph<3, 4>(grid, stream, a); launch_ph<4, 5>(grid, stream, a);
    launch_ph<5, 6>(grid, stream, a); launch_ph<6, 7>(grid, stream, a); launch_ph<7, 8>(grid, stream, a); launch_ph<8, 9>(grid, stream, a); launch_ph<9, 10>(grid, stream, a); launch_ph<10, 11>(grid, stream, a);
#endif
}
```

```cpp
#include <hip/hip_runtime.h>
#include <cstdio>
#include <cstdint>

#ifndef MK_N_LAUNCHES
#define MK_N_LAUNCHES 1
#endif

#define DI __device__ __forceinline__
#define GAS __attribute__((address_space(1)))
#define LAS __attribute__((address_space(3)))
typedef unsigned short bf16_t;
typedef short bf16x8 __attribute__((ext_vector_type(8)));
typedef float f32x4 __attribute__((ext_vector_type(4)));
typedef float f32x2 __attribute__((ext_vector_type(2)));
typedef unsigned u32x4 __attribute__((ext_vector_type(4)));
typedef unsigned u32x2 __attribute__((ext_vector_type(2)));

constexpr int D = 1024, NB_P = 8, T_P = 2048, MP = NB_P * T_P, NB_S = 128, T_S = 4, MS = NB_S * T_S, M = MP + MS;
constexpr int BR = 1536, XA = 512, MW = 2048, NA = 2 * BR + XA + MW  , NBW = BR + XA + MW  ;
constexpr int ZA = 2 * BR + 2 * XA;
constexpr int NMEM = 256, CH = 128, AG = 8, AD = 192, SG = 96, SC = 16, SP = 64, NH = 4, HD = 128;
constexpr int MMEM = NB_P * NMEM;
constexpr float EPS = 1e-6f;
constexpr size_t O_Y = 0, O_MK = (size_t)M * D, O_MV = O_MK + 2ull * MMEM * XA, O_HPR = O_MV + 2ull * MMEM * XA, O_HPI = O_HPR + (size_t)NB_P * SG * SP,
                 O_HSR = O_HPI + (size_t)NB_P * SG * SP, O_HSI = O_HSR + (size_t)NB_S * SG * SP, O_CV = O_HSI + (size_t)NB_S * SG * SP, O_END = O_CV + (size_t)MS * BR;
static_assert(O_END == 23953408ull, "output size");

constexpr size_t MiB = 1u << 20;
constexpr size_t WS_CTL = 0, CTL_ZERO_BYTES = 1 * MiB;
constexpr size_t WS_WINA = 2 * MiB;
constexpr size_t WS_WINB = 13 * MiB;
constexpr size_t WS_WGLU = 21 * MiB;
constexpr size_t WS_WOUT0 = 26 * MiB, WS_WOUT1 = 30 * MiB;
constexpr size_t WS_WMEM = 34 * MiB;
constexpr size_t WS_MEMN = 38 * MiB;
constexpr size_t WS_KVBF = 42 * MiB;
constexpr size_t WS_SMALL = 50 * MiB;
constexpr size_t WS_XN = 52 * MiB;
constexpr size_t WS_Z = 86 * MiB;
constexpr size_t WS_YG = WS_Z + (size_t)M * NBW * 2;
constexpr size_t WS_MIX = 268 * MiB;
constexpr size_t WS_OUT = 334 * MiB;
constexpr size_t WS_Y1 = 400 * MiB;
constexpr size_t WS_VT = 466 * MiB;
constexpr size_t WS_PART = 470 * MiB;
constexpr size_t WS_END = 486 * MiB;
static_assert(WS_Z + (size_t)M * NA * 2 <= WS_MIX && WS_YG + (size_t)M * BR * 2 <= WS_MIX && WS_XN + (size_t)M * D * 2 <= WS_Z, "ws map");
constexpr size_t SM_VSTAT = 0;
constexpr size_t SM_SS0 = SM_VSTAT + 2 * (size_t)M;
constexpr size_t SM_SS1 = SM_SS0 + M;
constexpr size_t SM_SS2 = SM_SS1 + M;
constexpr size_t SM_ZERO_END = SM_SS2 + M;
constexpr size_t SM_LB = SM_ZERO_END;
constexpr size_t SM_BB = SM_LB + (size_t)SG * SP * 2;
constexpr size_t SM_BBT = SM_BB + (size_t)SG * SP * SC * 2;
constexpr size_t SM_CT = SM_BBT + (size_t)SG * 128 * SC / 2;
constexpr size_t SM_END = SM_CT + (size_t)SG * 128 * SC / 2;
static_assert(SM_END * 4 <= 2 * MiB, "small region");
constexpr int CW_BAR = 4096;
constexpr int CW_SUB = 30720;
constexpr int CW_PANEL = 16384;
constexpr int KSPLIT = 8;

DI float bf2f(bf16_t v) { return __uint_as_float(((unsigned)v) << 16); }
DI unsigned f2bf(float f) { unsigned u = __float_as_uint(f); return (u + 0x7fffu + ((u >> 16) & 1u)) >> 16; }
DI unsigned pk2(float lo, float hi) { return f2bf(lo) | (f2bf(hi) << 16); }
DI float wave_sum(float v) {
#pragma unroll
    for (int o = 1; o < 64; o <<= 1) v += __shfl_xor(v, o);
    return v;
}
DI float wave_max(float v) {
#pragma unroll
    for (int o = 1; o < 64; o <<= 1) v = fmaxf(v, __shfl_xor(v, o));
    return v;
}
DI float gelu_tanh(float x) {
    const float t = x * (1.0f + 0.044715f * x * x);
    const float e = __builtin_amdgcn_exp2f(t * (-2.0f * 0.7978845608028654f * 1.4426950408889634f));
    return x * __builtin_amdgcn_rcpf(1.0f + e);
}
DI float silu_f(float x) { return x * __builtin_amdgcn_rcpf(1.0f + __builtin_amdgcn_exp2f(x * -1.4426950408889634f)); }
DI float sigmoid_f(float x) { return __builtin_amdgcn_rcpf(1.0f + __builtin_amdgcn_exp2f(x * -1.4426950408889634f)); }
#define LDS_WAIT() asm volatile("s_waitcnt lgkmcnt(0)" ::: "memory")
#define VM_WAIT() asm volatile("s_waitcnt vmcnt(0)" ::: "memory")

namespace pg8 {
constexpr int BM = 256, BK = 64, HALF = 128, HTB = HALF * BK * 2, STAGE_BYTES = 8 * HTB, NXCD = 8, WGM = 8;
__host__ __device__ __forceinline__ int lds_byte(int r, int c) { const int st = (r >> 4) * 2 + (c >> 5), rr = r & 15, cc = c & 31, ob = rr * 64 + cc * 2; return st * 1024 + (ob ^ (((ob >> 9) & 1) << 5)); }
__host__ __device__ __forceinline__ void stage_rc(int b, int& R, int& C) { const int st = b / 1024, sb = b % 1024, swz = sb ^ (((sb >> 9) & 1) << 5); R = (st >> 1) * 16 + swz / 64; C = (st & 1) * 32 + (swz % 64) / 2; }
__host__ __device__ __forceinline__ int perm32(int rho) { const int n = rho >> 4, i = rho & 15; return 8 * (i >> 2) + 4 * n + (i & 3); }

struct Unit { int pm, pn, gi, ks; };

struct MultiOrder {
    const bf16_t* A0; const bf16_t* B0; const bf16_t* A1; const bf16_t* B1;
    int nM0, nN0, nM1, nN1, n0, n1, ntot, G, c, KS, nt0, nt1, sf; size_t tstep, tstep1;
    DI void init(const bf16_t* a0, const bf16_t* b0, int M0, int N0, const bf16_t* a1, const bf16_t* b1, int M1, int N1, int K, int G_, int c_, int KS1 = 1) {
        A0 = a0; B0 = b0; A1 = a1; B1 = b1; nM0 = M0 / BM; nN0 = N0 / BM; nM1 = M1 / BM; nN1 = N1 / BM; n0 = nM0 * nN0; KS = KS1; n1 = nM1 * nN1 * KS1; ntot = n0 + n1; G = G_; c = c_; tstep = (size_t)BM * K * 2; tstep1 = tstep;
        nt0 = K / BK; nt1 = K / BK / KS1; sf = 0;
    }
    DI void init2k(const bf16_t* a0, const bf16_t* b0, int M0, int N0, int K0, const bf16_t* a1, const bf16_t* b1, int M1, int N1, int K1, int G_, int c_) {
        A0 = a0; B0 = b0; A1 = a1; B1 = b1; nM0 = M0 / BM; nN0 = N0 / BM; nM1 = M1 / BM; nN1 = N1 / BM; n0 = nM0 * nN0; KS = 1; n1 = nM1 * nN1; ntot = n0 + n1; G = G_; c = c_;
        tstep = (size_t)BM * K0 * 2; tstep1 = (size_t)BM * K1 * 2; nt0 = K0 / BK; nt1 = K1 / BK; sf = 1;
    }
    DI bool next(int i, Unit& u) const {
        const long L = (long)i * G + c; if (L >= ntot) return false;
        const int gi = sf ? ((L < n1) ? 1 : 0) : ((L >= n0) ? 1 : 0);
        const int w = gi ? (sf ? (int)L : (int)L - n0) : 0; const int ks1 = w % KS, t1 = w / KS, pn1 = t1 % (nN1 > 0 ? nN1 : 1), pm1 = t1 / (nN1 > 0 ? nN1 : 1);
        int wgid = gi ? 0 : (sf ? (int)L - n1 : (int)L); const int nM = nM0, nN = nN0, nwg = n0;
        { const int q = nwg / NXCD, r = nwg % NXCD, xcd = wgid % NXCD, off = wgid / NXCD; wgid = (xcd < r ? xcd * (q + 1) : r * (q + 1) + (xcd - r) * q) + off; }
        const int nig = WGM * nN, gid = wgid / nig, fm = gid * WGM, gsz = (nM - fm) < WGM ? (nM - fm) : WGM;
        const int pm0 = fm + ((wgid % nig) % gsz), pn0 = (wgid % nig) / gsz;
        u.pm = gi ? pm1 : pm0; u.pn = gi ? pn1 : pn0; u.gi = gi; u.ks = gi ? ks1 : 0; return true;
    }
    DI const char* baseA(const Unit& u) const { return (const char*)(u.gi ? A1 : A0) + (size_t)u.pm * (u.gi ? tstep1 : tstep) + (size_t)(u.ks * nt1) * (BK * 2); }
    DI const char* baseB(const Unit& u) const { return (const char*)(u.gi ? B1 : B0) + (size_t)u.pn * (u.gi ? tstep1 : tstep) + (size_t)(u.ks * nt1) * (BK * 2); }
    DI int ktiles(const Unit& u) const { return u.gi ? nt1 : nt0; }
};

DI unsigned cvt_pk_bf16(float lo, float hi) { unsigned r; asm volatile("v_cvt_pk_bf16_f32 %0, %1, %2" : "=v"(r) : "v"(lo), "v"(hi)); return r; }

template <class Epi, class Sched, bool ALIGN_EPI = false, bool SP2 = false>
DI void gemm_phase(LAS unsigned char* lds, const int K, const Sched& S, const Epi& E) {
    int tid_o = threadIdx.x; asm volatile("" : "+v"(tid_o));
    const int tid = tid_o, wid = __builtin_amdgcn_readfirstlane(tid >> 6), lane = tid & 63, wr = wid >> 2, wc = wid & 3, fr = lane & 15, fq = lane >> 4;
    unsigned voffA[2], voffB[2];
#pragma unroll
    for (int i = 0; i < 2; ++i) { int R, C; stage_rc(tid * 16 + i * 8192, R, C); const int Rb = Epi::PERM ? ((R & ~31) + perm32(R & 31)) : R;
        voffA[i] = (unsigned)(R * K + C) * 2u; voffB[i] = (unsigned)(Rb * K + C) * 2u; }
    const size_t kstep = (size_t)(BK * 2);
    const size_t hstep = (size_t)HALF * K * 2;
    const unsigned ldsw = (unsigned)wid * 1024u;
    const int aoff = lds_byte(wr * 64 + fr, fq * 8), boff = lds_byte(wc * 32 + fr, fq * 8);
#define PG8_SA(b, h) (((b) * 2 + (h)) * HTB)
#define PG8_SB(b, h) ((4 + (b) * 2 + (h)) * HTB)
#define PG8_STAGE(bufoff, gbase, voff) do { _Pragma("unroll") for (int _i = 0; _i < 2; ++_i) \
        __builtin_amdgcn_global_load_lds((const unsigned*)((const char*)(gbase) + (voff)[_i]), (LAS unsigned*)(lds + (bufoff) + ldsw + _i * 8192), 16, 0, 0); } while (0)
#define PG8_LDA(dst, b, h) do { _Pragma("unroll") for (int m = 0; m < 4; ++m) _Pragma("unroll") for (int k = 0; k < 2; ++k) dst[m][k] = *(const LAS bf16x8*)(lds + PG8_SA(b, h) + aoff + m * 2048 + k * 1024); } while (0)
#define PG8_LDB(dst, b, h) do { _Pragma("unroll") for (int n = 0; n < 2; ++n) _Pragma("unroll") for (int k = 0; k < 2; ++k) dst[n][k] = *(const LAS bf16x8*)(lds + PG8_SB(b, h) + boff + n * 2048 + k * 1024); } while (0)
#define PG8_MMA(ai, bj, At, Bt) do { __builtin_amdgcn_s_setprio(1); _Pragma("unroll") for (int m = 0; m < 4; ++m) _Pragma("unroll") for (int n = 0; n < 2; ++n) _Pragma("unroll") for (int k = 0; k < 2; ++k) \
        acc[ai][bj][m][n] = __builtin_amdgcn_mfma_f32_16x16x32_bf16(Bt[n][k], At[m][k], acc[ai][bj][m][n], 0, 0, 0); __builtin_amdgcn_s_setprio(0); } while (0)
#define PG8_WAIT_V(n) asm volatile("s_waitcnt vmcnt(" #n ")" ::: "memory")
#define PG8_WAIT_L(n) asm volatile("s_waitcnt lgkmcnt(" #n ")" ::: "memory")
#define PG8_BAR __builtin_amdgcn_s_barrier()
#define PG8_SCHED __builtin_amdgcn_sched_barrier(0)
    Unit cur, nxt; int ui = 0;
    if (!S.next(0, cur)) return;
    int nt = S.ktiles(cur);
    f32x4 acc[2][2][4][2];
#pragma unroll
    for (int a = 0; a < 2; ++a)
#pragma unroll
        for (int b = 0; b < 2; ++b)
#pragma unroll
            for (int m = 0; m < 4; ++m)
#pragma unroll
                for (int n = 0; n < 2; ++n) acc[a][b][m][n] = (f32x4){0.f, 0.f, 0.f, 0.f};
    bf16x8 At[4][2], B0[2][2], B1[2][2];
    const char* cA = S.baseA(cur); const char* cB = S.baseB(cur);
    if constexpr (SP2) {
        PG8_STAGE(PG8_SB(0, 0), cB, voffB); PG8_STAGE(PG8_SB(0, 1), cB + hstep, voffB); PG8_STAGE(PG8_SA(0, 0), cA, voffA); PG8_STAGE(PG8_SA(0, 1), cA + hstep, voffA);
        if (wr == 1) PG8_BAR;
        PG8_WAIT_V(2); PG8_BAR;
        PG8_STAGE(PG8_SB(1, 0), cB + kstep, voffB); PG8_STAGE(PG8_SA(1, 0), cA + kstep, voffA); PG8_STAGE(PG8_SB(1, 1), cB + hstep + kstep, voffB);
        PG8_WAIT_V(6); PG8_BAR;
    } else {
        PG8_STAGE(PG8_SB(0, 0), cB, voffB); PG8_STAGE(PG8_SA(0, 0), cA, voffA); PG8_STAGE(PG8_SB(0, 1), cB + hstep, voffB); PG8_STAGE(PG8_SA(0, 1), cA + hstep, voffA);
        if (wr == 1) PG8_BAR;
        PG8_WAIT_V(4); PG8_BAR;
        PG8_STAGE(PG8_SB(1, 0), cB + kstep, voffB); PG8_STAGE(PG8_SA(1, 0), cA + kstep, voffA); PG8_STAGE(PG8_SB(1, 1), cB + hstep + kstep, voffB);
        PG8_WAIT_V(6); PG8_BAR;
    }
    for (;;) {
        const bool has_next = S.next(ui + 1, nxt);
        const char* nA = has_next ? S.baseA(nxt) : cA; const char* nB = has_next ? S.baseB(nxt) : cB;
        for (int t = 0; t < nt; t += 2) {
            const bool last = (t == nt - 2);
            const char* a1 = cA + (size_t)(t + 1) * kstep;
            const char* a2 = last ? nA : cA + (size_t)(t + 2) * kstep; const char* b2 = last ? nB : cB + (size_t)(t + 2) * kstep;
            const char* a3 = a2 + kstep; const char* b3 = b2 + kstep;
            if constexpr (SP2) {
            PG8_LDB(B0, 0, 0); PG8_LDB(B1, 0, 1); PG8_SCHED; PG8_LDA(At, 0, 0); PG8_STAGE(PG8_SA(1, 1), a1 + hstep, voffA);
            PG8_WAIT_V(8); PG8_WAIT_L(0); PG8_BAR; PG8_MMA(0, 0, At, B0); PG8_MMA(0, 1, At, B1); PG8_BAR; PG8_SCHED;
            PG8_LDA(At, 0, 1); PG8_STAGE(PG8_SB(0, 0), b2, voffB); PG8_STAGE(PG8_SB(0, 1), b2 + hstep, voffB); PG8_STAGE(PG8_SA(0, 0), a2, voffA);
            PG8_WAIT_V(8); PG8_WAIT_L(0); PG8_BAR; PG8_MMA(1, 0, At, B0); PG8_MMA(1, 1, At, B1); PG8_BAR; PG8_SCHED;
            PG8_LDB(B0, 1, 0); PG8_LDB(B1, 1, 1); PG8_SCHED; PG8_LDA(At, 1, 0); PG8_STAGE(PG8_SA(0, 1), a2 + hstep, voffA);
            PG8_WAIT_V(8); PG8_WAIT_L(0); PG8_BAR; PG8_MMA(0, 0, At, B0); PG8_MMA(0, 1, At, B1); PG8_BAR; PG8_SCHED;
            PG8_LDA(At, 1, 1); PG8_STAGE(PG8_SB(1, 0), b3, voffB); PG8_STAGE(PG8_SB(1, 1), b3 + hstep, voffB); PG8_STAGE(PG8_SA(1, 0), a3, voffA);
            PG8_WAIT_V(8); PG8_WAIT_L(0); PG8_BAR; PG8_MMA(1, 0, At, B0); PG8_MMA(1, 1, At, B1); PG8_BAR; PG8_SCHED;
            } else {
            PG8_LDB(B0, 0, 0); PG8_SCHED; PG8_LDA(At, 0, 0); PG8_STAGE(PG8_SA(1, 1), a1 + hstep, voffA);
            PG8_WAIT_L(8); PG8_BAR; PG8_WAIT_L(0); PG8_MMA(0, 0, At, B0); PG8_BAR; PG8_SCHED;
            PG8_LDB(B1, 0, 1); PG8_STAGE(PG8_SB(0, 0), b2, voffB);
            PG8_BAR; PG8_WAIT_L(0); PG8_MMA(0, 1, At, B1); PG8_BAR;
            PG8_LDA(At, 0, 1); PG8_STAGE(PG8_SA(0, 0), a2, voffA);
            PG8_BAR; PG8_WAIT_L(0); PG8_MMA(1, 0, At, B0); PG8_BAR; PG8_SCHED;
            PG8_STAGE(PG8_SB(0, 1), b2 + hstep, voffB);
            PG8_WAIT_V(6); PG8_BAR; PG8_MMA(1, 1, At, B1); PG8_BAR;
            PG8_LDB(B0, 1, 0); PG8_SCHED; PG8_LDA(At, 1, 0); PG8_STAGE(PG8_SA(0, 1), a2 + hstep, voffA);
            PG8_WAIT_L(8); PG8_BAR; PG8_WAIT_L(0); PG8_MMA(0, 0, At, B0); PG8_BAR; PG8_SCHED;
            PG8_LDB(B1, 1, 1); PG8_STAGE(PG8_SB(1, 0), b3, voffB);
            PG8_BAR; PG8_WAIT_L(0); PG8_MMA(0, 1, At, B1); PG8_BAR;
            PG8_LDA(At, 1, 1); PG8_STAGE(PG8_SA(1, 0), a3, voffA);
            PG8_BAR; PG8_WAIT_L(0); PG8_MMA(1, 0, At, B0); PG8_BAR; PG8_SCHED;
            PG8_STAGE(PG8_SB(1, 1), b3 + hstep, voffB);
            PG8_WAIT_V(6); PG8_BAR; PG8_MMA(1, 1, At, B1); PG8_BAR;
            }
        }
        if constexpr (ALIGN_EPI) { if (wr == 0) PG8_BAR; }
        { int fr_ = fr, fq_ = fq; asm volatile("" : "+v"(fr_), "+v"(fq_)); E(acc, cur, wr, wc, fr_, fq_); }
        if (!has_next) break;
#pragma unroll
        for (int a = 0; a < 2; ++a)
#pragma unroll
            for (int b = 0; b < 2; ++b)
#pragma unroll
                for (int m = 0; m < 4; ++m)
#pragma unroll
                    for (int n = 0; n < 2; ++n) acc[a][b][m][n] = (f32x4){0.f, 0.f, 0.f, 0.f};
        cur = nxt; cA = nA; cB = nB; ++ui; nt = S.ktiles(cur);
        if constexpr (ALIGN_EPI) { if (wr == 1) PG8_BAR; }
    }
    PG8_WAIT_V(0);
    if constexpr (!ALIGN_EPI) { if (wr == 0) PG8_BAR; }
    PG8_BAR;
#undef PG8_SA
#undef PG8_SB
#undef PG8_STAGE
#undef PG8_LDA
#undef PG8_LDB
#undef PG8_MMA
#undef PG8_WAIT_V
#undef PG8_WAIT_L
#undef PG8_BAR
#undef PG8_SCHED
}
}
#ifndef PG8_SP2
#define PG8_SP2 true
#endif
#ifndef PG8_ALIGN
#define PG8_ALIGN true
#endif

struct EpiInProj {
    static constexpr bool PERM = true;
    bf16_t* Z; int ldz; float* vstat;
    int e_gelu, e_stat, e_q, q_is_raw;
    float qscale;
    float* out_mk; float* out_mv; bf16_t* kvbf; bf16_t* vtb; int fused_ug;
    DI void operator()(const f32x4 (&acc)[2][2][4][2], const pg8::Unit& u, int wr, int wc, int fr, int fq) const {
        const int row0 = u.pm * 256 + wr * 64 + fr, col0_ = u.pn * 256 + wc * 32 + 8 * fq;
        if (u.gi == 1) {
            const int n0 = u.pn * 256; const int layer = n0 >> 10, kv = (n0 >> 9) & 1, cb = (n0 & 511) + wc * 32 + 8 * fq;
            float* ob = (kv ? out_mv : out_mk) + (size_t)layer * MMEM * XA; bf16_t* kb = kvbf + (size_t)(layer * 2 + kv) * MMEM * XA;
#pragma unroll
            for (int ai = 0; ai < 2; ++ai)
#pragma unroll
                for (int m = 0; m < 4; ++m) { const size_t ro = (size_t)(row0 + ai * 128 + m * 16) * XA + cb;
#pragma unroll
                    for (int bj = 0; bj < 2; ++bj) { const f32x4 v0 = acc[ai][bj][m][0], v1 = acc[ai][bj][m][1];
                        *(f32x4*)(ob + ro + bj * 128) = v0; *(f32x4*)(ob + ro + bj * 128 + 4) = v1;
                        u32x4 w; w.x = pg8::cvt_pk_bf16(v0[0], v0[1]); w.y = pg8::cvt_pk_bf16(v0[2], v0[3]); w.z = pg8::cvt_pk_bf16(v1[0], v1[1]); w.w = pg8::cvt_pk_bf16(v1[2], v1[3]);
                        *(u32x4*)(kb + ro + bj * 128) = w;
                        if (kv) { const int rr = row0 + ai * 128 + m * 16, bb = rr >> 8, mm = rr & 255, cc = cb + bj * 128, hh = cc >> 7, d0 = cc & 127;
                            bf16_t* vt = vtb + ((size_t)((layer * NB_P + bb) * NH + hh) * HD + d0) * NMEM + mm;
#pragma unroll
                            for (int e = 0; e < 4; ++e) { vt[(size_t)e * NMEM] = (bf16_t)f2bf(v0[e]); vt[(size_t)(e + 4) * NMEM] = (bf16_t)f2bf(v1[e]); } } } }
            return;
        }
        if (fused_ug && u.pn < 12) {
            const int oc = u.pn * 128 + wc * 32 + 8 * fq;
#pragma unroll
            for (int ai = 0; ai < 2; ++ai)
#pragma unroll
                for (int m = 0; m < 4; ++m) { const int row = row0 + ai * 128 + m * 16; float o[8];
#pragma unroll
                    for (int e = 0; e < 4; ++e) { o[e] = gelu_tanh(acc[ai][0][m][0][e]) * silu_f(acc[ai][1][m][0][e]); o[4 + e] = gelu_tanh(acc[ai][0][m][1][e]) * silu_f(acc[ai][1][m][1][e]); }
                    u32x4 w; w.x = pg8::cvt_pk_bf16(o[0], o[1]); w.y = pg8::cvt_pk_bf16(o[2], o[3]); w.z = pg8::cvt_pk_bf16(o[4], o[5]); w.w = pg8::cvt_pk_bf16(o[6], o[7]);
                    *(u32x4*)(Z + (size_t)row * ldz + oc) = w; }
            return; }
        const int kind = (u.pn < e_gelu) ? (q_is_raw ? 0 : 1) : (u.pn < e_stat) ? 2 : (u.pn < e_q) ? 3 : 4;
        const int col0 = fused_ug ? (u.pn - 6) * 256 + wc * 32 + 8 * fq : col0_;
#pragma unroll
        for (int ai = 0; ai < 2; ++ai)
#pragma unroll
            for (int m = 0; m < 4; ++m) { const int row = row0 + ai * 128 + m * 16; bf16_t* rowp = Z + (size_t)row * ldz + col0; float s1 = 0.f, s2 = 0.f;
#pragma unroll
                for (int bj = 0; bj < 2; ++bj) { f32x4 v0 = acc[ai][bj][m][0], v1 = acc[ai][bj][m][1];
                    if (kind == 1 || kind == 2) {
#pragma unroll
                        for (int e = 0; e < 4; ++e) { v0[e] = gelu_tanh(v0[e]); v1[e] = gelu_tanh(v1[e]); }
                    } else if (kind == 3) { v0 = v0 * qscale; v1 = v1 * qscale; }
                    else if (kind == 4) {
#pragma unroll
                        for (int e = 0; e < 4; ++e) { v0[e] = silu_f(v0[e]); v1[e] = silu_f(v1[e]); }
                    }
                    if (kind == 2) {
#pragma unroll
                        for (int e = 0; e < 4; ++e) { s1 += v0[e] + v1[e]; s2 += v0[e] * v0[e] + v1[e] * v1[e]; }
                    }
                    u32x4 w; w.x = pg8::cvt_pk_bf16(v0[0], v0[1]); w.y = pg8::cvt_pk_bf16(v0[2], v0[3]); w.z = pg8::cvt_pk_bf16(v1[0], v1[1]); w.w = pg8::cvt_pk_bf16(v1[2], v1[3]);
                    *(u32x4*)(rowp + bj * 128) = w; }
                if (kind == 2) { s1 += __shfl_xor(s1, 16); s1 += __shfl_xor(s1, 32); s2 += __shfl_xor(s2, 16); s2 += __shfl_xor(s2, 32);
                    if (fq == 0) { atomicAdd(vstat + 2 * (size_t)row, s1); atomicAdd(vstat + 2 * (size_t)row + 1, s2); } }
            }
    }
};
struct EpiOut {
    static constexpr bool PERM = true;
    bf16_t* O; float* part;
    DI void operator()(const f32x4 (&acc)[2][2][4][2], const pg8::Unit& u, int wr, int wc, int fr, int fq) const {
        const int row0 = u.pm * 256 + wr * 64 + fr, col0 = u.pn * 256 + wc * 32 + 8 * fq;
        if (u.gi) { float* base = part + (size_t)u.ks * MS * D;
#pragma unroll
            for (int ai = 0; ai < 2; ++ai)
#pragma unroll
                for (int m = 0; m < 4; ++m) { const int row = row0 + ai * 128 + m * 16; float* rowp = base + (size_t)row * D + col0;
#pragma unroll
                    for (int bj = 0; bj < 2; ++bj) { *(f32x4*)(rowp + bj * 128) = acc[ai][bj][m][0]; *(f32x4*)(rowp + bj * 128 + 4) = acc[ai][bj][m][1]; } }
        } else {
#pragma unroll
            for (int ai = 0; ai < 2; ++ai)
#pragma unroll
                for (int m = 0; m < 4; ++m) { const int row = row0 + ai * 128 + m * 16; bf16_t* rowp = O + (size_t)row * D + col0;
#pragma unroll
                    for (int bj = 0; bj < 2; ++bj) { const f32x4 v0 = acc[ai][bj][m][0], v1 = acc[ai][bj][m][1];
                        u32x4 w; w.x = pg8::cvt_pk_bf16(v0[0], v0[1]); w.y = pg8::cvt_pk_bf16(v0[2], v0[3]); w.z = pg8::cvt_pk_bf16(v1[0], v1[1]); w.w = pg8::cvt_pk_bf16(v1[2], v1[3]);
                        *(u32x4*)(rowp + bj * 128) = w; } }
        }
    }
};
DI void st_wt(float* p, const f32x4 v) {
    __hip_atomic_store((unsigned long long*)p, (unsigned long long)__float_as_uint(v.x) | ((unsigned long long)__float_as_uint(v.y) << 32), __ATOMIC_RELAXED, __HIP_MEMORY_SCOPE_AGENT);
    __hip_atomic_store((unsigned long long*)(p + 2), (unsigned long long)__float_as_uint(v.z) | ((unsigned long long)__float_as_uint(v.w) << 32), __ATOMIC_RELAXED, __HIP_MEMORY_SCOPE_AGENT);
}
struct EpiOutFused {
    static constexpr bool PERM = true;
    const bf16_t* base; const float* gain; float* yout; float* ss; unsigned* cnt; float* part; unsigned* subdone;
    DI void operator()(const f32x4 (&acc)[2][2][4][2], const pg8::Unit& u, int wr, int wc, int fr, int fq) const {
        const int row0 = u.pm * 256 + wr * 64 + fr, col0 = u.pn * 256 + wc * 32 + 8 * fq;
        if (u.gi) { float* pb = part + (size_t)u.ks * MS * D;
#pragma unroll
            for (int ai = 0; ai < 2; ++ai)
#pragma unroll
                for (int m = 0; m < 4; ++m) { const int row = row0 + ai * 128 + m * 16; float* rowp = pb + (size_t)row * D + col0;
#pragma unroll
                    for (int bj = 0; bj < 2; ++bj) { *(f32x4*)(rowp + bj * 128) = acc[ai][bj][m][0]; *(f32x4*)(rowp + bj * 128 + 4) = acc[ai][bj][m][1]; } }
            return; }
#pragma unroll
        for (int ai = 0; ai < 2; ++ai)
#pragma unroll
            for (int m = 0; m < 4; ++m) { float s2 = 0.f;
#pragma unroll
                for (int bj = 0; bj < 2; ++bj) { const f32x4 v0 = acc[ai][bj][m][0], v1 = acc[ai][bj][m][1];
#pragma unroll
                    for (int e = 0; e < 4; ++e) s2 += v0[e] * v0[e] + v1[e] * v1[e]; }
                s2 += __shfl_xor(s2, 16); s2 += __shfl_xor(s2, 32);
                if (fq == 0) atomicAdd(ss + row0 + ai * 128 + m * 16, s2); }
        asm volatile("s_waitcnt vmcnt(0)" ::: "memory");
        unsigned* pc = cnt + 64 * u.pm;
        if (fr == 0 && fq == 0) __hip_atomic_fetch_add(pc, 1u, __ATOMIC_RELAXED, __HIP_MEMORY_SCOPE_AGENT);
        { unsigned sp = 0; while ((unsigned)__builtin_amdgcn_readfirstlane((int)__hip_atomic_load(pc, __ATOMIC_RELAXED, __HIP_MEMORY_SCOPE_AGENT)) < 32u) { __builtin_amdgcn_s_sleep(2); if (++sp > (1u << 22)) break; } }
        __builtin_amdgcn_fence(__ATOMIC_ACQUIRE, "agent");
        asm volatile("s_waitcnt vmcnt(0)" ::: "memory");
        f32x4 gv[2][2];
#pragma unroll
        for (int bj = 0; bj < 2; ++bj)
#pragma unroll
            for (int n = 0; n < 2; ++n) gv[bj][n] = *(const f32x4*)(gain + col0 + bj * 128 + 4 * n);
        float rsv[8];
#pragma unroll
        for (int k = 0; k < 8; ++k) rsv[k] = __hip_atomic_load(ss + row0 + (k >> 2) * 128 + (k & 3) * 16, __ATOMIC_RELAXED, __HIP_MEMORY_SCOPE_AGENT);
#pragma unroll
        for (int ai = 0; ai < 2; ++ai)
#pragma unroll
            for (int m = 0; m < 4; ++m) { const int row = row0 + ai * 128 + m * 16;
                const float rs = 1.0f / sqrtf(rsv[ai * 4 + m] * (1.f / D) + EPS);
#pragma unroll
                for (int bj = 0; bj < 2; ++bj) { const u32x4 bw = *(const u32x4*)(base + (size_t)row * D + col0 + bj * 128);
                    const f32x4 b0 = {__uint_as_float(bw.x << 16), __uint_as_float(bw.x & 0xffff0000u), __uint_as_float(bw.y << 16), __uint_as_float(bw.y & 0xffff0000u)};
                    const f32x4 b1 = {__uint_as_float(bw.z << 16), __uint_as_float(bw.z & 0xffff0000u), __uint_as_float(bw.w << 16), __uint_as_float(bw.w & 0xffff0000u)};
                    float* op = yout + (size_t)row * D + col0 + bj * 128;
                    *(f32x4*)op = b0 + acc[ai][bj][m][0] * rs * gv[bj][0]; *(f32x4*)(op + 4) = b1 + acc[ai][bj][m][1] * rs * gv[bj][1]; } }
    }
};
struct EpiOutFused2 {
    static constexpr bool PERM = true;
    const float* xin; const float* gain; bf16_t* y1o; bf16_t* xn; float* ssa; float* ssb; unsigned* cnta; unsigned* cntb; float* part; unsigned* subdone;
    DI void operator()(const f32x4 (&accin)[2][2][4][2], const pg8::Unit& u, int wr, int wc, int fr, int fq) const {
        const int row0 = u.pm * 256 + wr * 64 + fr, col0 = u.pn * 256 + wc * 32 + 8 * fq;
        if (u.gi) { float* pb = part + (size_t)u.ks * MS * D;
#pragma unroll
            for (int ai = 0; ai < 2; ++ai)
#pragma unroll
                for (int m = 0; m < 4; ++m) { const int row = row0 + ai * 128 + m * 16; float* rowp = pb + (size_t)row * D + col0;
#pragma unroll
                    for (int bj = 0; bj < 2; ++bj) { *(f32x4*)(rowp + bj * 128) = accin[ai][bj][m][0]; *(f32x4*)(rowp + bj * 128 + 4) = accin[ai][bj][m][1]; } }
            return; }
        f32x4 acc[2][2][4][2];
#pragma unroll
        for (int ai = 0; ai < 2; ++ai)
#pragma unroll
            for (int bj = 0; bj < 2; ++bj)
#pragma unroll
                for (int m = 0; m < 4; ++m)
#pragma unroll
                    for (int n = 0; n < 2; ++n) acc[ai][bj][m][n] = accin[ai][bj][m][n];
#pragma unroll
        for (int ai = 0; ai < 2; ++ai)
#pragma unroll
            for (int m = 0; m < 4; ++m) { float s2 = 0.f;
#pragma unroll
                for (int bj = 0; bj < 2; ++bj) { const f32x4 v0 = acc[ai][bj][m][0], v1 = acc[ai][bj][m][1];
#pragma unroll
                    for (int e = 0; e < 4; ++e) s2 += v0[e] * v0[e] + v1[e] * v1[e]; }
                s2 += __shfl_xor(s2, 16); s2 += __shfl_xor(s2, 32);
                if (fq == 0) atomicAdd(ssa + row0 + ai * 128 + m * 16, s2); }
        asm volatile("s_waitcnt vmcnt(0)" ::: "memory");
        unsigned* pa = cnta + 64 * u.pm; unsigned* pb2 = cntb + 64 * u.pm;
        if (fr == 0 && fq == 0) __hip_atomic_fetch_add(pa, 1u, __ATOMIC_RELAXED, __HIP_MEMORY_SCOPE_AGENT);
        { unsigned sp = 0; while ((unsigned)__builtin_amdgcn_readfirstlane((int)__hip_atomic_load(pa, __ATOMIC_RELAXED, __HIP_MEMORY_SCOPE_AGENT)) < 32u) { __builtin_amdgcn_s_sleep(2); if (++sp > (1u << 22)) break; } }
        __builtin_amdgcn_fence(__ATOMIC_ACQUIRE, "agent");
        asm volatile("s_waitcnt vmcnt(0)" ::: "memory");
        f32x4 gv[2][2];
#pragma unroll
        for (int bj = 0; bj < 2; ++bj)
#pragma unroll
            for (int n = 0; n < 2; ++n) gv[bj][n] = *(const f32x4*)(gain + col0 + bj * 128 + 4 * n);
        float rsv[8];
#pragma unroll
        for (int k = 0; k < 8; ++k) rsv[k] = __hip_atomic_load(ssa + row0 + (k >> 2) * 128 + (k & 3) * 16, __ATOMIC_RELAXED, __HIP_MEMORY_SCOPE_AGENT);
#pragma unroll
        for (int ai = 0; ai < 2; ++ai)
#pragma unroll
            for (int m = 0; m < 4; ++m) { const int row = row0 + ai * 128 + m * 16;
                const float rs = 1.0f / sqrtf(rsv[ai * 4 + m] * (1.f / D) + EPS);
                float s2 = 0.f;
#pragma unroll
                for (int bj = 0; bj < 2; ++bj) { const float* xp = xin + (size_t)row * D + col0 + bj * 128;
                    const f32x4 y0 = __builtin_nontemporal_load((const f32x4*)xp) + acc[ai][bj][m][0] * rs * gv[bj][0], y1v = __builtin_nontemporal_load((const f32x4*)(xp + 4)) + acc[ai][bj][m][1] * rs * gv[bj][1];
                    acc[ai][bj][m][0] = y0; acc[ai][bj][m][1] = y1v;
                    u32x4 w; w.x = pg8::cvt_pk_bf16(y0[0], y0[1]); w.y = pg8::cvt_pk_bf16(y0[2], y0[3]); w.z = pg8::cvt_pk_bf16(y1v[0], y1v[1]); w.w = pg8::cvt_pk_bf16(y1v[2], y1v[3]);
                    *(u32x4*)(y1o + (size_t)row * D + col0 + bj * 128) = w;
#pragma unroll
                    for (int e = 0; e < 4; ++e) s2 += y0[e] * y0[e] + y1v[e] * y1v[e]; }
                s2 += __shfl_xor(s2, 16); s2 += __shfl_xor(s2, 32);
                if (fq == 0) atomicAdd(ssb + row, s2); }
        asm volatile("s_waitcnt vmcnt(0)" ::: "memory");
        if (fr == 0 && fq == 0) __hip_atomic_fetch_add(pb2, 1u, __ATOMIC_RELAXED, __HIP_MEMORY_SCOPE_AGENT);
        { unsigned sp = 0; while ((unsigned)__builtin_amdgcn_readfirstlane((int)__hip_atomic_load(pb2, __ATOMIC_RELAXED, __HIP_MEMORY_SCOPE_AGENT)) < 32u) { __builtin_amdgcn_s_sleep(2); if (++sp > (1u << 22)) break; } }
#pragma unroll
        for (int k = 0; k < 8; ++k) rsv[k] = __hip_atomic_load(ssb + row0 + (k >> 2) * 128 + (k & 3) * 16, __ATOMIC_RELAXED, __HIP_MEMORY_SCOPE_AGENT);
#pragma unroll
        for (int ai = 0; ai < 2; ++ai)
#pragma unroll
            for (int m = 0; m < 4; ++m) { const int row = row0 + ai * 128 + m * 16;
                const float rs1 = 1.0f / sqrtf(rsv[ai * 4 + m] * (1.f / D) + EPS);
#pragma unroll
                for (int bj = 0; bj < 2; ++bj) { const f32x4 y0 = acc[ai][bj][m][0] * rs1, y1v = acc[ai][bj][m][1] * rs1;
                    u32x4 w; w.x = pg8::cvt_pk_bf16(y0[0], y0[1]); w.y = pg8::cvt_pk_bf16(y0[2], y0[3]); w.z = pg8::cvt_pk_bf16(y1v[0], y1v[1]); w.w = pg8::cvt_pk_bf16(y1v[2], y1v[3]);
                    *(u32x4*)(xn + (size_t)row * D + col0 + bj * 128) = w; } }
    }
};
struct EpiGlu {
    static constexpr bool PERM = true;
    const bf16_t* YG; const bf16_t* Z1; const float* bglu; bf16_t* MIX;
    DI void operator()(const f32x4 (&acc)[2][2][4][2], const pg8::Unit& u, int wr, int wc, int fr, int fq) const {
        const int row0 = u.pm * 256 + wr * 64 + fr, col0 = u.pn * 256 + wc * 32 + 8 * fq;
        f32x4 bv[2][2];
#pragma unroll
        for (int bj = 0; bj < 2; ++bj)
#pragma unroll
            for (int n = 0; n < 2; ++n) bv[bj][n] = *(const f32x4*)(bglu + col0 + bj * 128 + 4 * n);
#pragma unroll
        for (int ai = 0; ai < 2; ++ai)
#pragma unroll
            for (int m = 0; m < 4; ++m) { const int row = row0 + ai * 128 + m * 16;
#pragma unroll
                for (int bj = 0; bj < 2; ++bj) { const int col = col0 + bj * 128;
                    const u32x4 yg = *(const u32x4*)(YG + (size_t)row * BR + col); const u32x4 sg = *(const u32x4*)(Z1 + (size_t)row * NBW + (BR + XA) + col);
                    const f32x4 v0 = acc[ai][bj][m][0] + bv[bj][0], v1 = acc[ai][bj][m][1] + bv[bj][1];
                    float o[8]; const float a8[8] = {v0[0], v0[1], v0[2], v0[3], v1[0], v1[1], v1[2], v1[3]};
#pragma unroll
                    for (int e = 0; e < 4; ++e) { const unsigned yw = yg[e], sw = sg[e];
                        const float y0 = __uint_as_float(yw << 16), y1 = __uint_as_float(yw & 0xffff0000u), g0 = __uint_as_float(sw << 16), g1 = __uint_as_float(sw & 0xffff0000u);
                        o[2 * e] = y0 * sigmoid_f(a8[2 * e]) * g0; o[2 * e + 1] = y1 * sigmoid_f(a8[2 * e + 1]) * g1; }
                    u32x4 w; w.x = pg8::cvt_pk_bf16(o[0], o[1]); w.y = pg8::cvt_pk_bf16(o[2], o[3]); w.z = pg8::cvt_pk_bf16(o[4], o[5]); w.w = pg8::cvt_pk_bf16(o[6], o[7]);
                    *(u32x4*)(MIX + (size_t)row * MW + col) = w; } }
    }
};

#define XB_TMO      128
#define XB_XCNT(j)  (256  + 64 * (j))
#define XB_XSUB(j)  (1280 + 64 * (j))
#define XB_XGEN(j)  (2304 + 64 * (j))
#define XB_TOP      3328
#define XB_TOPGEN   3392
#define XCD_BAR_WORDS 3456
#define XB_SPIN_CAP (1u << 18)
DI unsigned xb_ld(unsigned* p)              { return __hip_atomic_load(p, __ATOMIC_RELAXED, __HIP_MEMORY_SCOPE_AGENT); }
DI unsigned xb_add(unsigned* p, unsigned v) { return __hip_atomic_fetch_add(p, v, __ATOMIC_RELAXED, __HIP_MEMORY_SCOPE_AGENT); }
DI unsigned xb_xcc_id() { return (unsigned)__builtin_amdgcn_s_getreg((3 << 11) | 20) & 0xFu; }
#define XB_SPIN(cond, bar) do { unsigned _sp = 0; while (cond) { __builtin_amdgcn_s_sleep(1); \
    if ((++_sp & 255u) == 0u) { if (xb_ld(&(bar)[XB_TMO])) break; if (_sp > XB_SPIN_CAP) { atomicAdd(&(bar)[XB_TMO], 1u); break; } } } } while (0)
struct XcdBarrier { unsigned* bar; unsigned x; volatile LAS unsigned* st; };
DI XcdBarrier xcd_barrier_post(unsigned* bar, volatile LAS unsigned* st) {
    XcdBarrier b; b.bar = bar; b.x = xb_xcc_id(); b.st = st;
    if (threadIdx.x == 0) (void)xb_add(&bar[XB_XCNT(b.x)], 1u);
    return b;
}
DI void xcd_barrier_complete(unsigned* bar, unsigned x, unsigned& nloc, unsigned& nx) {
    const unsigned G = gridDim.x * gridDim.y * gridDim.z;
    unsigned sum, cnt, mine, sp = 0u;
    for (;;) {
        sum = 0u; cnt = 0u; mine = 0u;
#pragma unroll
        for (unsigned j = 0; j < 16; ++j) { const unsigned c = xb_ld(&bar[XB_XCNT(j)]); sum += c; cnt += (c > 0u) ? 1u : 0u; mine = (j == x) ? c : mine; }
        if (sum == G) break;
        __builtin_amdgcn_s_sleep(1);
        if ((++sp & 255u) == 0u) { if (xb_ld(&bar[XB_TMO])) break; if (sp > XB_SPIN_CAP) { atomicAdd(&bar[XB_TMO], 1u); break; } }
    }
    nloc = mine > 0u ? mine : 1u; nx = cnt > 0u ? cnt : 1u;
}
DI void xcd_barrier(const XcdBarrier& b) {
    asm volatile("s_waitcnt vmcnt(0)" ::: "memory");
    __syncthreads();
    if (threadIdx.x == 0) {
        unsigned* bar = b.bar;
        __builtin_amdgcn_s_waitcnt(0);
        unsigned nloc = b.st[0], nx = b.st[1];
        if (nloc == 0u) { xcd_barrier_complete(bar, b.x, nloc, nx); b.st[0] = nloc; b.st[1] = nx; }
        const unsigned old = xb_add(&bar[XB_XSUB(b.x)], 1u);
        const unsigned gen = old / nloc;
        if (old + 1u == (gen + 1u) * nloc) {
            __builtin_amdgcn_fence(__ATOMIC_RELEASE, "agent");
            asm volatile("s_waitcnt vmcnt(0)" ::: "memory");
            const unsigned og = xb_add(&bar[XB_TOP], 1u);
            const unsigned tg = og / nx;
            if (og + 1u == (tg + 1u) * nx) xb_add(&bar[XB_TOPGEN], 1u);
            else XB_SPIN(xb_ld(&bar[XB_TOPGEN]) == tg, bar);
            __builtin_amdgcn_fence(__ATOMIC_ACQUIRE, "agent");
            xb_add(&bar[XB_XGEN(b.x)], 1u);
            asm volatile("s_waitcnt vmcnt(0)" ::: "memory");
        } else {
            XB_SPIN(xb_ld(&bar[XB_XGEN(b.x)]) == gen, bar);
            __builtin_amdgcn_fence(__ATOMIC_ACQUIRE, "agent");
            asm volatile("s_waitcnt vmcnt(0)" ::: "memory");
        }
    }
    __syncthreads();
}

DI void publish_wg(unsigned* cnt) {
    if (threadIdx.x == 0) {
        __builtin_amdgcn_fence(__ATOMIC_RELEASE, "agent");
        asm volatile("s_waitcnt vmcnt(0)" ::: "memory");
        __hip_atomic_fetch_add(cnt, 1u, __ATOMIC_RELAXED, __HIP_MEMORY_SCOPE_AGENT);
    }
}
DI void wait_subunits(unsigned* cnt, const unsigned need) {
    if (threadIdx.x == 0) { unsigned sp = 0;
        while (__hip_atomic_load(cnt, __ATOMIC_RELAXED, __HIP_MEMORY_SCOPE_AGENT) < need) { __builtin_amdgcn_s_sleep(2); if (++sp > (1u << 22)) break; }
        __builtin_amdgcn_fence(__ATOMIC_ACQUIRE, "agent");
        asm volatile("s_waitcnt vmcnt(0)" ::: "memory"); }
    __syncthreads();
}
struct Args {
    const float* in[29]; float* out; unsigned char* ws; int ph_lo, ph_hi, li, pad;
};
constexpr int NWAVES = 8, NTHR = NWAVES * 64;
constexpr int RING_BYTES = 131072, MISC_OFF = RING_BYTES + 320, LDS_BYTES = 147456;

DI void p0_transpose_item(const float* W, const float* gk, int K, int N, bf16_t* WT, int row_off, LAS float* scr, int item, int lane_in) {
    int lane_o = lane_in; asm volatile("" : "+v"(lane_o)); const int lane = lane_o;
    const int nblk = N / 32, kb = item / nblk, nb = item % nblk, k0 = 64 * kb, n0 = 32 * nb;
    const int kq = lane >> 3, c4 = 4 * (lane & 7);
    f32x4 v[8];
#pragma unroll
    for (int i = 0; i < 8; ++i) v[i] = __builtin_nontemporal_load((const f32x4*)(W + (size_t)(k0 + 8 * i + kq) * N + n0 + c4));
#pragma unroll
    for (int i = 0; i < 8; ++i) { const int kk = 8 * i + kq; const float gg = gk ? gk[k0 + kk] : 1.0f; LAS float* d = scr + kk * 33 + c4;
        d[0] = v[i].x * gg; d[1] = v[i].y * gg; d[2] = v[i].z * gg; d[3] = v[i].w * gg; }
    LDS_WAIT();
    const int c = lane & 7;
#pragma unroll
    for (int j = 0; j < 4; ++j) { const int n = (lane >> 3) + 8 * j; const LAS float* s = scr + (8 * c) * 33 + n;
        u32x4 o; o.x = pk2(s[0 * 33], s[1 * 33]); o.y = pk2(s[2 * 33], s[3 * 33]); o.z = pk2(s[4 * 33], s[5 * 33]); o.w = pk2(s[6 * 33], s[7 * 33]);
        *(u32x4*)(WT + (size_t)(row_off + n0 + n) * K + k0 + 8 * c) = o; }
    LDS_WAIT();
}
DI void rms_row_to_bf16(const float* xrow, bf16_t* orow, int lane) {
    const f32x4* xr = (const f32x4*)xrow + lane;
    f32x4 v[4]; float s = 0.f;
#pragma unroll
    for (int j = 0; j < 4; ++j) { v[j] = xr[64 * j]; s += (v[j].x * v[j].x + v[j].y * v[j].y) + (v[j].z * v[j].z + v[j].w * v[j].w); }
    const float rs = 1.0f / sqrtf(wave_sum(s) * (1.f / D) + EPS);
    unsigned long long* o8 = (unsigned long long*)orow + lane;
#pragma unroll
    for (int j = 0; j < 4; ++j) o8[64 * j] = (unsigned long long)pk2(v[j].x * rs, v[j].y * rs) | ((unsigned long long)pk2(v[j].z * rs, v[j].w * rs) << 32);
}

DI void attn_naive(const bf16_t* Zb, int ldz, int qoff, int goff, const bf16_t* kbf, const bf16_t* vbf, const float* ck, const float* cv, bf16_t* MIX, LAS float* wscr, int gw, int NGW, int lane) {
    LAS float* qs = wscr; LAS float* ps = wscr + 128;
    for (int item = MP * NH + gw; item < M * NH; item += NGW) {
        const int row = item >> 2, h = item & 3;
        const bf16_t* zr = Zb + (size_t)row * ldz;
        { const unsigned qw = *(const unsigned*)(zr + qoff + h * HD + 2 * lane); qs[2 * lane] = __uint_as_float(qw << 16); qs[2 * lane + 1] = __uint_as_float(qw & 0xffff0000u); }
        LDS_WAIT();
        float sc[4];
        if (row < MP) {
            const int b = row >> 11; const bf16_t* kb = kbf + (size_t)(b * NMEM) * XA + h * HD;
#pragma unroll
            for (int kk = 0; kk < 4; ++kk) { const bf16_t* kr = kb + (size_t)(lane + 64 * kk) * XA; float a = 0.f;
#pragma unroll 2
                for (int d8 = 0; d8 < 16; ++d8) { const u32x4 kw = *(const u32x4*)(kr + 8 * d8); const LAS float* q = qs + 8 * d8;
#pragma unroll
                    for (int e = 0; e < 4; ++e) { a += q[2 * e] * __uint_as_float(kw[e] << 16); a += q[2 * e + 1] * __uint_as_float(kw[e] & 0xffff0000u); } }
                sc[kk] = a; }
        } else {
            const int b = (row - MP) >> 2; const float* kb = ck + (size_t)(b * NMEM) * XA + h * HD;
#pragma unroll
            for (int kk = 0; kk < 4; ++kk) { const float* kr = kb + (size_t)(lane + 64 * kk) * XA; float a = 0.f;
#pragma unroll 4
                for (int d4 = 0; d4 < 32; ++d4) { const f32x4 kw = *(const f32x4*)(kr + 4 * d4); const LAS float* q = qs + 4 * d4;
                    a += q[0] * kw.x + q[1] * kw.y + q[2] * kw.z + q[3] * kw.w; }
                sc[kk] = a; }
        }
        const float mx = wave_max(fmaxf(fmaxf(sc[0], sc[1]), fmaxf(sc[2], sc[3])));
        float sum = 0.f;
#pragma unroll
        for (int kk = 0; kk < 4; ++kk) { const float p = __builtin_amdgcn_exp2f((sc[kk] - mx) * 1.4426950408889634f); sum += p; ps[lane + 64 * kk] = p; }
        sum = wave_sum(sum);
        LDS_WAIT();
        float o0 = 0.f, o1 = 0.f;
        if (row < MP) {
            const int b = row >> 11; const bf16_t* vb = vbf + (size_t)(b * NMEM) * XA + h * HD + 2 * lane;
#pragma unroll 8
            for (int m = 0; m < NMEM; ++m) { const unsigned vw = *(const unsigned*)(vb + (size_t)m * XA); const float p = ps[m]; o0 += p * __uint_as_float(vw << 16); o1 += p * __uint_as_float(vw & 0xffff0000u); }
        } else {
            const int b = (row - MP) >> 2; const float* vb = cv + (size_t)(b * NMEM) * XA + h * HD + 2 * lane;
#pragma unroll 8
            for (int m = 0; m < NMEM; ++m) { const f32x2 vw = *(const f32x2*)(vb + (size_t)m * XA); const float p = ps[m]; o0 += p * vw.x; o1 += p * vw.y; }
        }
        const float inv = 1.0f / sum;
        const unsigned gwd = *(const unsigned*)(zr + goff + h * HD + 2 * lane);
        o0 *= inv * __uint_as_float(gwd << 16); o1 *= inv * __uint_as_float(gwd & 0xffff0000u);
        *(unsigned*)(MIX + (size_t)row * MW + BR + h * HD + 2 * lane) = pk2(o0, o1);
        LDS_WAIT();
    }
}


typedef float f32x16 __attribute__((ext_vector_type(16)));
typedef __bf16 bf16x2_t __attribute__((ext_vector_type(2)));
DI unsigned cvtpk(float lo, float hi) { f32x2 v = {lo, hi}; bf16x2_t b = __builtin_convertvector(v, bf16x2_t); return __builtin_bit_cast(unsigned, b); }
DI void attn_prompt_unit(const bf16_t* Zb, const int ldz, const int qoff, const int goff, const bf16_t* Kpl, const bf16_t* VTl, bf16_t* MIXp, LAS unsigned char* lds, const int unit, const int tid_in, const int wave, const int lane_in) {
    const int b = unit >> 5, h = (unit >> 3) & 3, qb = unit & 7;
    __syncthreads();
    {
        int tid_o = tid_in; asm volatile("" : "+v"(tid_o)); const int tid = tid_o;
        const bf16_t* kg = Kpl + (size_t)(b * NMEM) * XA + h * HD;
        const bf16_t* vg = VTl + (size_t)((b * NH + h) * HD) * NMEM;
#pragma unroll
        for (int i = 0; i < 8; ++i) { const int cid = tid + NTHR * i; const int row = cid >> 4, c = cid & 15;
            const u32x4 v = *(const u32x4*)(kg + (size_t)row * XA + c * 8);
            *(LAS u32x4*)(lds + row * 256 + ((c ^ (row & 15)) << 4)) = v; }
#pragma unroll
        for (int i = 0; i < 8; ++i) { const int cid = tid + NTHR * i; const int row = cid >> 5, c = cid & 31;
            const u32x4 v = *(const u32x4*)(vg + (size_t)row * NMEM + c * 8);
            *(LAS u32x4*)(lds + 65536 + row * 512 + ((c ^ (row & 15)) << 4)) = v; }
    }
    __syncthreads();
    int lane_o = lane_in; asm volatile("" : "+v"(lane_o)); const int lane = lane_o;
    const int qi = lane & 31, hh = lane >> 5;
    const int row = b * T_P + qb * 256 + wave * 32 + qi;
    const bf16_t* zr = Zb + (size_t)row * ldz;
    bf16x8 qf[8];
#pragma unroll
    for (int ks = 0; ks < 8; ++ks) qf[ks] = *(const bf16x8*)(zr + qoff + h * HD + 16 * ks + 8 * hh);
    const int pi = (qi & ~12) | ((qi & 4) << 1) | ((qi & 8) >> 1);
    int kb[8];
#pragma unroll
    for (int ks = 0; ks < 8; ++ks) kb[ks] = pi * 256 + (((2 * ks + hh) ^ (pi & 15)) << 4);
    int vb[8];
#pragma unroll
    for (int j = 0; j < 8; ++j) vb[j] = 65536 + qi * 512 + (((2 * j + hh) ^ (qi & 15)) << 4);
    f32x16 sacc[8];
#pragma unroll
    for (int T = 0; T < 8; ++T) {
#pragma unroll
        for (int r = 0; r < 16; ++r) sacc[T][r] = 0.f;
#pragma unroll
        for (int ks = 0; ks < 8; ++ks) { const bf16x8 kf = *(const LAS bf16x8*)(lds + kb[ks] + T * 8192);
            sacc[T] = __builtin_amdgcn_mfma_f32_32x32x16_bf16(kf, qf[ks], sacc[T], 0, 0, 0); }
    }
    float mx = -3.0e38f;
#pragma unroll
    for (int T = 0; T < 8; ++T)
#pragma unroll
        for (int r = 0; r < 16; ++r) mx = fmaxf(mx, sacc[T][r]);
    mx = fmaxf(mx, __shfl_xor(mx, 32));
    float sum = 0.f;
#pragma unroll
    for (int T = 0; T < 8; ++T)
#pragma unroll
        for (int r = 0; r < 16; ++r) { const float p = __builtin_amdgcn_exp2f((sacc[T][r] - mx) * 1.4426950408889634f); sacc[T][r] = p; sum += p; }
    sum += __shfl_xor(sum, 32);
    const float inv = 1.0f / sum;
    f32x16 oacc[4];
#pragma unroll
    for (int dt = 0; dt < 4; ++dt)
#pragma unroll
        for (int r = 0; r < 16; ++r) oacc[dt][r] = 0.f;
#pragma unroll
    for (int T = 0; T < 8; ++T)
#pragma unroll
        for (int s2 = 0; s2 < 2; ++s2) {
            u32x4 pw; pw.x = cvtpk(sacc[T][8 * s2 + 0], sacc[T][8 * s2 + 1]); pw.y = cvtpk(sacc[T][8 * s2 + 2], sacc[T][8 * s2 + 3]);
            pw.z = cvtpk(sacc[T][8 * s2 + 4], sacc[T][8 * s2 + 5]); pw.w = cvtpk(sacc[T][8 * s2 + 6], sacc[T][8 * s2 + 7]);
            const bf16x8 pf = __builtin_bit_cast(bf16x8, pw);
#pragma unroll
            for (int dt = 0; dt < 4; ++dt) {
                const bf16x8 vf = *(const LAS bf16x8*)(lds + vb[(T & 3) * 2 + s2] + (T >> 2) * 256 + dt * 16384);
                oacc[dt] = __builtin_amdgcn_mfma_f32_32x32x16_bf16(vf, pf, oacc[dt], 0, 0, 0); }
        }
    bf16_t* mr = MIXp + (size_t)row * MW + BR + h * HD;
#pragma unroll
    for (int dt = 0; dt < 4; ++dt)
#pragma unroll
        for (int g4 = 0; g4 < 4; ++g4) { const int d0 = 32 * dt + 8 * g4 + 4 * hh;
            const u32x2 gw2 = *(const u32x2*)(zr + goff + h * HD + d0);
            const float o0 = oacc[dt][4 * g4 + 0] * inv * __uint_as_float(gw2.x << 16), o1 = oacc[dt][4 * g4 + 1] * inv * __uint_as_float(gw2.x & 0xffff0000u);
            const float o2 = oacc[dt][4 * g4 + 2] * inv * __uint_as_float(gw2.y << 16), o3 = oacc[dt][4 * g4 + 3] * inv * __uint_as_float(gw2.y & 0xffff0000u);
            u32x2 w; w.x = cvtpk(o0, o1); w.y = cvtpk(o2, o3);
            *(u32x2*)(mr + d0) = w; }
}

DI void team_sync(volatile LAS unsigned* ctr, const unsigned target, const int lane) {
    LDS_WAIT();
    if (lane == 0) __hip_atomic_fetch_add((LAS unsigned*)ctr, 1u, __ATOMIC_RELAXED, __HIP_MEMORY_SCOPE_WORKGROUP);
    while (*ctr < target) { __builtin_amdgcn_s_sleep(1); }
    asm volatile("" ::: "memory");
}
DI void attn_prompt_unit4(const bf16_t* Zb, const int ldz, const int qoff, const int goff, const bf16_t* Kpl, const bf16_t* VTl, bf16_t* MIXp, LAS unsigned char* lds, volatile LAS unsigned* ctr, const unsigned epoch,
                          const int unit, const int t4_in, const int w4, const int lane_in) {
    const int b = unit >> 5, h = (unit >> 3) & 3, qb = unit & 7;
    {
        int t4_o = t4_in; asm volatile("" : "+v"(t4_o)); const int t4 = t4_o;
        const bf16_t* kg = Kpl + (size_t)(b * NMEM) * XA + h * HD;
        const bf16_t* vg = VTl + (size_t)((b * NH + h) * HD) * NMEM;
#pragma unroll
        for (int half = 0; half < 2; ++half) {
            u32x4 v[8];
#pragma unroll
            for (int i = 0; i < 8; ++i) { const int cid = t4 + 256 * (8 * half + i); const int row = cid >> 4, c = cid & 15; v[i] = *(const u32x4*)(kg + (size_t)row * XA + c * 8); }
#pragma unroll
            for (int i = 0; i < 8; ++i) { const int cid = t4 + 256 * (8 * half + i); const int row = cid >> 4, c = cid & 15; *(LAS u32x4*)(lds + row * 256 + ((c ^ (row & 15)) << 4)) = v[i]; }
        }
#pragma unroll
        for (int half = 0; half < 2; ++half) {
            u32x4 v[8];
#pragma unroll
            for (int i = 0; i < 8; ++i) { const int cid = t4 + 256 * (8 * half + i); const int row = cid >> 5, c = cid & 31; v[i] = *(const u32x4*)(vg + (size_t)row * NMEM + c * 8); }
#pragma unroll
            for (int i = 0; i < 8; ++i) { const int cid = t4 + 256 * (8 * half + i); const int row = cid >> 5, c = cid & 31; *(LAS u32x4*)(lds + 65536 + row * 512 + ((c ^ (row & 15)) << 4)) = v[i]; }
        }
    }
    team_sync(ctr, 8u * epoch + 4u, lane_in);
#pragma unroll 1
    for (int j = 0; j < 2; ++j) {
        int lane_o = lane_in; asm volatile("" : "+v"(lane_o)); const int lane = lane_o;
        const int qi = lane & 31, hh = lane >> 5;
        const int row = b * T_P + qb * 256 + (w4 + 4 * j) * 32 + qi;
        const bf16_t* zr = Zb + (size_t)row * ldz;
        bf16x8 qf[8];
#pragma unroll
        for (int ks = 0; ks < 8; ++ks) qf[ks] = *(const bf16x8*)(zr + qoff + h * HD + 16 * ks + 8 * hh);
        const int pi = (qi & ~12) | ((qi & 4) << 1) | ((qi & 8) >> 1);
        const int kbase = pi * 256, kx = pi & 15, vbase = 65536 + qi * 512, vx = qi & 15;
        f32x16 sacc[8];
#define AU_LDK(KF, T) do { _Pragma("unroll") for (int ks = 0; ks < 8; ++ks) KF[ks] = *(const LAS bf16x8*)(lds + kbase + (((2 * ks + hh) ^ kx) << 4) + (T) * 8192); } while (0)
#define AU_QK(KF, T) do { _Pragma("unroll") for (int r = 0; r < 16; ++r) sacc[T][r] = 0.f; \
            _Pragma("unroll") for (int ks = 0; ks < 8; ++ks) sacc[T] = __builtin_amdgcn_mfma_f32_32x32x16_bf16(KF[ks], qf[ks], sacc[T], 0, 0, 0); } while (0)
        { bf16x8 kfA[8], kfB[8];
          AU_LDK(kfA, 0);
#pragma unroll
          for (int T = 0; T < 8; T += 2) {
              AU_LDK(kfB, T + 1); __builtin_amdgcn_sched_barrier(0); AU_QK(kfA, T); __builtin_amdgcn_sched_barrier(0);
              if (T + 2 < 8) AU_LDK(kfA, T + 2);
              __builtin_amdgcn_sched_barrier(0); AU_QK(kfB, T + 1); __builtin_amdgcn_sched_barrier(0);
          } }
#undef AU_QK
#undef AU_LDK
        float mx = -3.0e38f;
#pragma unroll
        for (int T = 0; T < 8; ++T)
#pragma unroll
            for (int r = 0; r < 16; ++r) mx = fmaxf(mx, sacc[T][r]);
        mx = fmaxf(mx, __shfl_xor(mx, 32));
        float sum = 0.f;
#pragma unroll
        for (int T = 0; T < 8; ++T)
#pragma unroll
            for (int r = 0; r < 16; ++r) { const float p = __builtin_amdgcn_exp2f((sacc[T][r] - mx) * 1.4426950408889634f); sacc[T][r] = p; sum += p; }
        sum += __shfl_xor(sum, 32);
        const float inv = 1.0f / sum;
        f32x16 oacc[4];
#pragma unroll
        for (int dt = 0; dt < 4; ++dt)
#pragma unroll
            for (int r = 0; r < 16; ++r) oacc[dt][r] = 0.f;
#define AU_LDV(VF, TS) do { _Pragma("unroll") for (int dt = 0; dt < 4; ++dt) VF[dt] = *(const LAS bf16x8*)(lds + vbase + (((2 * ((((TS) >> 1) & 3) * 2 + ((TS) & 1)) + hh) ^ vx) << 4) + ((TS) >> 3) * 256 + dt * 16384); } while (0)
#define AU_PV(VF, TS) do { const int T_ = (TS) >> 1, s2_ = (TS) & 1; \
            u32x4 pw; pw.x = cvtpk(sacc[T_][8 * s2_ + 0], sacc[T_][8 * s2_ + 1]); pw.y = cvtpk(sacc[T_][8 * s2_ + 2], sacc[T_][8 * s2_ + 3]); \
            pw.z = cvtpk(sacc[T_][8 * s2_ + 4], sacc[T_][8 * s2_ + 5]); pw.w = cvtpk(sacc[T_][8 * s2_ + 6], sacc[T_][8 * s2_ + 7]); \
            const bf16x8 pf = __builtin_bit_cast(bf16x8, pw); \
            _Pragma("unroll") for (int dt = 0; dt < 4; ++dt) oacc[dt] = __builtin_amdgcn_mfma_f32_32x32x16_bf16(VF[dt], pf, oacc[dt], 0, 0, 0); } while (0)
        { bf16x8 vfA[4], vfB[4];
          AU_LDV(vfA, 0);
#pragma unroll
          for (int ts = 0; ts < 16; ts += 2) {
              AU_LDV(vfB, ts + 1); __builtin_amdgcn_sched_barrier(0); AU_PV(vfA, ts); __builtin_amdgcn_sched_barrier(0);
              if (ts + 2 < 16) AU_LDV(vfA, ts + 2);
              __builtin_amdgcn_sched_barrier(0); AU_PV(vfB, ts + 1); __builtin_amdgcn_sched_barrier(0);
          } }
#undef AU_PV
#undef AU_LDV
        bf16_t* mr = MIXp + (size_t)row * MW + BR + h * HD;
#pragma unroll
        for (int dt = 0; dt < 4; ++dt)
#pragma unroll
            for (int g4 = 0; g4 < 4; ++g4) { const int d0 = 32 * dt + 8 * g4 + 4 * hh;
                const u32x2 gw2 = *(const u32x2*)(zr + goff + h * HD + d0);
                const float o0 = oacc[dt][4 * g4 + 0] * inv * __uint_as_float(gw2.x << 16), o1 = oacc[dt][4 * g4 + 1] * inv * __uint_as_float(gw2.x & 0xffff0000u);
                const float o2 = oacc[dt][4 * g4 + 2] * inv * __uint_as_float(gw2.y << 16), o3 = oacc[dt][4 * g4 + 3] * inv * __uint_as_float(gw2.y & 0xffff0000u);
                u32x2 w; w.x = cvtpk(o0, o1); w.y = cvtpk(o2, o3);
                *(u32x2*)(mr + d0) = w; }
    }
    team_sync(ctr, 8u * epoch + 8u, lane_in);
}

DI void attn_prompt_unit_kv(const bf16_t* Zb, const int ldz, const int qoff, const int goff, const bf16_t* Kpl, const bf16_t* VTl, bf16_t* MIXp, LAS unsigned char* buf, volatile LAS unsigned* ctr, const unsigned epoch,
                            const int unit, const int t4_in, const int w4, const int lane_in) {
    const int b = unit >> 6, h = (unit >> 4) & 3, qb = unit & 15;
    int t4_o = t4_in, lane_o = lane_in; asm volatile("" : "+v"(t4_o), "+v"(lane_o)); const int t4 = t4_o, lane = lane_o;
    {   const bf16_t* kg = Kpl + (size_t)(b * NMEM) * XA + h * HD;
#pragma unroll
        for (int half = 0; half < 2; ++half) {
            u32x4 v[8];
#pragma unroll
            for (int i = 0; i < 8; ++i) { const int cid = t4 + 256 * (8 * half + i); const int row = cid >> 4, c = cid & 15; v[i] = *(const u32x4*)(kg + (size_t)row * XA + c * 8); }
#pragma unroll
            for (int i = 0; i < 8; ++i) { const int cid = t4 + 256 * (8 * half + i); const int row = cid >> 4, c = cid & 15; *(LAS u32x4*)(buf + row * 256 + ((c ^ (row & 15)) << 4)) = v[i]; }
        }
    }
    team_sync(ctr, 16u * epoch + 4u, lane);
    const int qi = lane & 31, hh = lane >> 5;
    const int row = b * T_P + qb * 128 + w4 * 32 + qi;
    const bf16_t* zr = Zb + (size_t)row * ldz;
    f32x16 sacc[8];
    {
        bf16x8 qf[8];
#pragma unroll
        for (int ks = 0; ks < 8; ++ks) qf[ks] = *(const bf16x8*)(zr + qoff + h * HD + 16 * ks + 8 * hh);
        const int pi = (qi & ~12) | ((qi & 4) << 1) | ((qi & 8) >> 1);
        const int kbase = pi * 256, kx = pi & 15;
#define AU_LDK(KF, T) do { _Pragma("unroll") for (int ks = 0; ks < 8; ++ks) KF[ks] = *(const LAS bf16x8*)(buf + kbase + (((2 * ks + hh) ^ kx) << 4) + (T) * 8192); } while (0)
#define AU_QK(KF, T) do { _Pragma("unroll") for (int r = 0; r < 16; ++r) sacc[T][r] = 0.f; \
            _Pragma("unroll") for (int ks = 0; ks < 8; ++ks) sacc[T] = __builtin_amdgcn_mfma_f32_32x32x16_bf16(KF[ks], qf[ks], sacc[T], 0, 0, 0); } while (0)
        { bf16x8 kfA[8], kfB[8];
          AU_LDK(kfA, 0);
#pragma unroll
          for (int T = 0; T < 8; T += 2) {
              AU_LDK(kfB, T + 1); __builtin_amdgcn_sched_barrier(0); AU_QK(kfA, T); __builtin_amdgcn_sched_barrier(0);
              if (T + 2 < 8) AU_LDK(kfA, T + 2);
              __builtin_amdgcn_sched_barrier(0); AU_QK(kfB, T + 1); __builtin_amdgcn_sched_barrier(0);
          } }
#undef AU_QK
#undef AU_LDK
    }
    team_sync(ctr, 16u * epoch + 8u, lane);
    {   const bf16_t* vg = VTl + (size_t)((b * NH + h) * HD) * NMEM;
#pragma unroll
        for (int half = 0; half < 2; ++half) {
            u32x4 v[8];
#pragma unroll
            for (int i = 0; i < 8; ++i) { const int cid = t4 + 256 * (8 * half + i); const int rw = cid >> 5, c = cid & 31; v[i] = *(const u32x4*)(vg + (size_t)rw * NMEM + c * 8); }
#pragma unroll
            for (int i = 0; i < 8; ++i) { const int cid = t4 + 256 * (8 * half + i); const int rw = cid >> 5, c = cid & 31; *(LAS u32x4*)(buf + rw * 512 + ((c ^ (rw & 15)) << 4)) = v[i]; }
        }
    }
    float mx = -3.0e38f;
#pragma unroll
    for (int T = 0; T < 8; ++T)
#pragma unroll
        for (int r = 0; r < 16; ++r) mx = fmaxf(mx, sacc[T][r]);
    mx = fmaxf(mx, __shfl_xor(mx, 32));
    float sum = 0.f;
#pragma unroll
    for (int T = 0; T < 8; ++T)
#pragma unroll
        for (int r = 0; r < 16; ++r) { const float p = __builtin_amdgcn_exp2f((sacc[T][r] - mx) * 1.4426950408889634f); sacc[T][r] = p; sum += p; }
    sum += __shfl_xor(sum, 32);
    const float inv = 1.0f / sum;
    team_sync(ctr, 16u * epoch + 12u, lane);
    f32x16 oacc[4];
#pragma unroll
    for (int dt = 0; dt < 4; ++dt)
#pragma unroll
        for (int r = 0; r < 16; ++r) oacc[dt][r] = 0.f;
    const int vbase = qi * 512, vx = qi & 15;
#define AU_LDV(VF, TS) do { _Pragma("unroll") for (int dt = 0; dt < 4; ++dt) VF[dt] = *(const LAS bf16x8*)(buf + vbase + (((2 * ((((TS) >> 1) & 3) * 2 + ((TS) & 1)) + hh) ^ vx) << 4) + ((TS) >> 3) * 256 + dt * 16384); } while (0)
#define AU_PV(VF, TS) do { const int T_ = (TS) >> 1, s2_ = (TS) & 1; \
            u32x4 pw; pw.x = cvtpk(sacc[T_][8 * s2_ + 0], sacc[T_][8 * s2_ + 1]); pw.y = cvtpk(sacc[T_][8 * s2_ + 2], sacc[T_][8 * s2_ + 3]); \
            pw.z = cvtpk(sacc[T_][8 * s2_ + 4], sacc[T_][8 * s2_ + 5]); pw.w = cvtpk(sacc[T_][8 * s2_ + 6], sacc[T_][8 * s2_ + 7]); \
            const bf16x8 pf = __builtin_bit_cast(bf16x8, pw); \
            _Pragma("unroll") for (int dt = 0; dt < 4; ++dt) oacc[dt] = __builtin_amdgcn_mfma_f32_32x32x16_bf16(VF[dt], pf, oacc[dt], 0, 0, 0); } while (0)
        { bf16x8 vfA[4], vfB[4];
          AU_LDV(vfA, 0);
#pragma unroll
          for (int ts = 0; ts < 16; ts += 2) {
              AU_LDV(vfB, ts + 1); __builtin_amdgcn_sched_barrier(0); AU_PV(vfA, ts); __builtin_amdgcn_sched_barrier(0);
              if (ts + 2 < 16) AU_LDV(vfA, ts + 2);
              __builtin_amdgcn_sched_barrier(0); AU_PV(vfB, ts + 1); __builtin_amdgcn_sched_barrier(0);
          } }
#undef AU_PV
#undef AU_LDV
    team_sync(ctr, 16u * epoch + 16u, lane);
    bf16_t* mr = MIXp + (size_t)row * MW + BR + h * HD;
#pragma unroll
    for (int dt = 0; dt < 4; ++dt)
#pragma unroll
        for (int g4 = 0; g4 < 4; ++g4) { const int d0 = 32 * dt + 8 * g4 + 4 * hh;
            const u32x2 gw2 = *(const u32x2*)(zr + goff + h * HD + d0);
            const float o0 = oacc[dt][4 * g4 + 0] * inv * __uint_as_float(gw2.x << 16), o1 = oacc[dt][4 * g4 + 1] * inv * __uint_as_float(gw2.x & 0xffff0000u);
            const float o2 = oacc[dt][4 * g4 + 2] * inv * __uint_as_float(gw2.y << 16), o3 = oacc[dt][4 * g4 + 3] * inv * __uint_as_float(gw2.y & 0xffff0000u);
            u32x2 w; w.x = cvtpk(o0, o1); w.y = cvtpk(o2, o3);
            *(u32x2*)(mr + d0) = w; }
}

typedef short s16x4 __attribute__((ext_vector_type(4)));
DI s16x4 tr_read16(const LAS unsigned char* p) { return __builtin_amdgcn_ds_read_tr16_b64_v4i16((LAS s16x4*)p); }
template <bool SAMPLE>
DI void s5_item(const bf16_t* Z1, const bf16_t* bbt, const bf16_t* ctt, const float* lbt, const float* dvec, const float* h0re, const float* h0im, float* hout_re, float* hout_im, bf16_t* YGp,
                LAS unsigned char* img, const int item, const int lane_in) {
    int lane_o = lane_in; asm volatile("" : "+v"(lane_o)); const int lane = lane_o;
    const int n = lane & 31, hh = lane >> 5, i16 = lane & 15, G4 = lane >> 4;
    const int g = SAMPLE ? item >> 4 : item >> 2, sub = SAMPLE ? (item & 15) : (item & 3);
    bf16x8 bfrag[4], cfrag[4];
#pragma unroll
    for (int j = 0; j < 4; ++j) { bfrag[j] = *(const bf16x8*)(bbt + ((size_t)g * 128 + 32 * j + n) * SC + 8 * hh); cfrag[j] = *(const bf16x8*)(ctt + ((size_t)g * SC + i16) * 128 + 32 * j + 8 * G4); }
    bf16x8 ifrag;
#pragma unroll
    for (int e = 0; e < 8; ++e) ifrag[e] = (n == 8 * hh + e) ? (short)0x3f80 : (short)0;
    bf16x8 dfrag; { const float dv = dvec[g * SC + i16];
#pragma unroll
        for (int e = 0; e < 8; ++e) dfrag[e] = (8 * G4 + e == i16) ? (short)f2bf(dv) : (short)0; }
    const float lbr0 = lbt[2 * (g * SP + n)], lbi0 = lbt[2 * (g * SP + n) + 1], lbr1 = lbt[2 * (g * SP + 32 + n)], lbi1 = lbt[2 * (g * SP + 32 + n) + 1];
    const int ha = (n >> 2) & 1, ra = (n & 3) + 4 * (n >> 3);
    int rowA, rowE[2];
    if (SAMPLE) { rowA = MP + (8 * sub + 4 * ha + (ra >> 2)) * T_S + (ra & 3); }
    else { rowA = (2 * sub + ha) * T_P + ra; }
#pragma unroll
    for (int rt = 0; rt < 2; ++rt) { const int rho = 16 * rt + i16, he = (rho >> 2) & 1, re = (rho & 3) + 4 * (rho >> 3);
        rowE[rt] = SAMPLE ? MP + (8 * sub + 4 * he + (re >> 2)) * T_S + (re & 3) : (2 * sub + he) * T_P + re; }
    const bf16_t* ua = Z1 + (size_t)rowA * NBW + g * SC + 8 * hh;
    bf16_t* yo0 = YGp + (size_t)rowE[0] * BR + g * SC + 4 * G4; bf16_t* yo1 = YGp + (size_t)rowE[1] * BR + g * SC + 4 * G4;
    const LAS unsigned char* trb = img + (8 * G4 + (i16 >> 2)) * 72 + 8 * (i16 & 3);
    LAS unsigned char* wrb = img + n * 72 + 8 * hh;
    float hr0 = 0.f, hi0 = 0.f, hr1 = 0.f, hi1 = 0.f;
    float s0r[4], s0i[4], s1r[4], s1i[4];
    if (SAMPLE) {
#pragma unroll
        for (int q = 0; q < 4; ++q) { const size_t o = ((size_t)(8 * sub + 4 * hh + q) * SG + g) * SP; s0r[q] = h0re[o + n]; s0i[q] = h0im[o + n]; s1r[q] = h0re[o + 32 + n]; s1i[q] = h0im[o + 32 + n]; }
    }
#define S5_STEP(UB, YO) do { \
        f32x16 T[5]; \
        _Pragma("unroll") for (int j = 0; j < 5; ++j) { \
            _Pragma("unroll") for (int r = 0; r < 16; ++r) T[j][r] = 0.f; \
            T[j] = __builtin_amdgcn_mfma_f32_32x32x16_bf16(UB, j < 4 ? bfrag[j] : ifrag, T[j], 0, 0, 0); } \
        _Pragma("unroll") for (int r = 0; r < 16; ++r) { \
            if (SAMPLE && (r & 3) == 0) { hr0 = s0r[r >> 2]; hi0 = s0i[r >> 2]; hr1 = s1r[r >> 2]; hi1 = s1i[r >> 2]; } \
            const float nr0 = fmaf(lbr0, hr0, fmaf(-lbi0, hi0, T[0][r])), ni0 = fmaf(lbr0, hi0, fmaf(lbi0, hr0, T[2][r])); \
            const float nr1 = fmaf(lbr1, hr1, fmaf(-lbi1, hi1, T[1][r])), ni1 = fmaf(lbr1, hi1, fmaf(lbi1, hr1, T[3][r])); \
            hr0 = nr0; hi0 = ni0; hr1 = nr1; hi1 = ni1; T[0][r] = nr0; T[2][r] = ni0; T[1][r] = nr1; T[3][r] = ni1; \
            if (SAMPLE && (r & 3) == 3) { const int b = 8 * sub + 4 * hh + (r >> 2); const size_t o = ((size_t)b * SG + g) * SP; \
                hout_re[o + n] = hr0; hout_im[o + n] = hi0; hout_re[o + 32 + n] = hr1; hout_im[o + 32 + n] = hi1; } \
        } \
        _Pragma("unroll") for (int j = 0; j < 5; ++j) \
            _Pragma("unroll") for (int gq = 0; gq < 4; ++gq) { u32x2 w; w.x = cvtpk(T[j][4 * gq], T[j][4 * gq + 1]); w.y = cvtpk(T[j][4 * gq + 2], T[j][4 * gq + 3]); \
                *(LAS u32x2*)(wrb + j * 2304 + 16 * gq) = w; } \
        LDS_WAIT(); \
        f32x4 ya[2]; \
        _Pragma("unroll") for (int rt = 0; rt < 2; ++rt) ya[rt] = (f32x4){0.f, 0.f, 0.f, 0.f}; \
        _Pragma("unroll") for (int kq = 0; kq < 5; ++kq) \
            _Pragma("unroll") for (int rt = 0; rt < 2; ++rt) { const s16x4 lo = tr_read16(trb + kq * 2304 + rt * 32), hi = tr_read16(trb + kq * 2304 + rt * 32 + 288); \
                const bf16x8 hb = __builtin_shufflevector(lo, hi, 0, 1, 2, 3, 4, 5, 6, 7); \
                ya[rt] = __builtin_amdgcn_mfma_f32_16x16x32_bf16(kq < 4 ? cfrag[kq] : dfrag, hb, ya[rt], 0, 0, 0); } \
        LDS_WAIT(); \
        _Pragma("unroll") for (int rt = 0; rt < 2; ++rt) { \
            const float y0 = gelu_tanh(ya[rt][0]), y1 = gelu_tanh(ya[rt][1]), y2 = gelu_tanh(ya[rt][2]), y3 = gelu_tanh(ya[rt][3]); \
            YO[rt].x = cvtpk(y0, y1); YO[rt].y = cvtpk(y2, y3); } \
    } while (0)
#define S5_LOAD4(U, GI) do { _Pragma("unroll") for (int q4 = 0; q4 < 4; ++q4) U[q4] = *(const bf16x8*)(ua + (size_t)((GI) * 4 + q4) * 16 * NBW); } while (0)
#define S5_STORE4(Y, GI) do { _Pragma("unroll") for (int q4 = 0; q4 < 4; ++q4) { *(u32x2*)(yo0 + (size_t)((GI) * 4 + q4) * 16 * BR) = Y[q4][0]; *(u32x2*)(yo1 + (size_t)((GI) * 4 + q4) * 16 * BR) = Y[q4][1]; } } while (0)
#define S5_GROUP(UC, UN, YP, YC, GI) do { \
        { const int gn = ((GI) + 1 < NGRP) ? (GI) + 1 : NGRP - 1; S5_LOAD4(UN, gn); } \
        if ((GI) > 0) S5_STORE4(YP, (GI) - 1); \
        __builtin_amdgcn_sched_barrier(0); \
        S5_STEP(UC[0], YC[0]); S5_STEP(UC[1], YC[1]); S5_STEP(UC[2], YC[2]); S5_STEP(UC[3], YC[3]); \
    } while (0)
    if (SAMPLE) { bf16x8 u1 = *(const bf16x8*)ua; u32x2 ysmp[2]; S5_STEP(u1, ysmp); *(u32x2*)yo0 = ysmp[0]; *(u32x2*)yo1 = ysmp[1]; }
    else {
        constexpr int NGRP = T_P / 64;
        bf16x8 uA[4], uB[4]; u32x2 yA[4][2], yB[4][2];
        S5_LOAD4(uA, 0);
#pragma unroll 1
        for (int gi = 0; gi < NGRP; gi += 2) { S5_GROUP(uA, uB, yB, yA, gi); S5_GROUP(uB, uA, yA, yB, gi + 1); }
        S5_STORE4(yB, NGRP - 1);
    }
#undef S5_GROUP
#undef S5_STORE4
#undef S5_LOAD4
#undef S5_STEP
    if (!SAMPLE) { const size_t o = ((size_t)(2 * sub + hh) * SG + g) * SP;
        hout_re[o + n] = hr0; hout_im[o + n] = hi0; hout_re[o + 32 + n] = hr1; hout_im[o + 32 + n] = hi1; }
}


DI void s5_item_split(const bf16_t* Z1, const bf16_t* bbt, const bf16_t* ctt, const float* lbt, const float* dvec, float* hout_re, float* hout_im, bf16_t* YGp,
                      LAS unsigned char* img2, volatile LAS unsigned* flags, const int item, const int r, const int lane_in) {
    int lane_o = lane_in; asm volatile("" : "+v"(lane_o)); const int lane = lane_o;
    const int n = lane & 31, hh = lane >> 5, i16 = lane & 15, G4 = lane >> 4;
    const int g = item >> 2, sub = item & 3;
    const bf16x8 bre = *(const bf16x8*)(bbt + ((size_t)g * 128 + 32 * r + n) * SC + 8 * hh), bim = *(const bf16x8*)(bbt + ((size_t)g * 128 + 64 + 32 * r + n) * SC + 8 * hh);
    bf16x8 cfrag[4];
#pragma unroll
    for (int j = 0; j < 4; ++j) cfrag[j] = *(const bf16x8*)(ctt + ((size_t)g * SC + i16) * 128 + 32 * j + 8 * G4);
    bf16x8 ifrag;
#pragma unroll
    for (int e = 0; e < 8; ++e) ifrag[e] = (n == 8 * hh + e) ? (short)0x3f80 : (short)0;
    bf16x8 dfrag; { const float dv = dvec[g * SC + i16];
#pragma unroll
        for (int e = 0; e < 8; ++e) dfrag[e] = (8 * G4 + e == i16) ? (short)f2bf(dv) : (short)0; }
    const float lbr = lbt[2 * (g * SP + 32 * r + n)], lbi = lbt[2 * (g * SP + 32 * r + n) + 1];
    const int ha = (n >> 2) & 1, ra = (n & 3) + 4 * (n >> 3);
    const int rowA = (2 * sub + ha) * T_P + ra;
    const int rho = 16 * r + i16, he = (rho >> 2) & 1, re = (rho & 3) + 4 * (rho >> 3);
    const int rowE = (2 * sub + he) * T_P + re;
    const bf16_t* ua = Z1 + (size_t)rowA * NBW + g * SC + 8 * hh;
    bf16_t* yo = YGp + (size_t)rowE * BR + g * SC + 4 * G4;
    const int trofs = (8 * G4 + (i16 >> 2)) * 72 + 8 * (i16 & 3) + r * 32;
    const int wrre = (32 * r + n) * 72 + 8 * hh, wrim = (64 + 32 * r + n) * 72 + 8 * hh, wru = (128 + n) * 72 + 8 * hh;
    volatile LAS unsigned* fmine = flags + r; volatile LAS unsigned* fother = flags + (1 - r);
    float hr = 0.f, hi = 0.f;
    constexpr int NGRP = T_P / 64;
#define S5S_STEP(UB, YO, SIDX) do { \
        LAS unsigned char* buf = img2 + (((SIDX) & 1) ? 11520 : 0); \
        f32x16 Tr, Ti, Tu; \
        _Pragma("unroll") for (int q = 0; q < 16; ++q) { Tr[q] = 0.f; Ti[q] = 0.f; Tu[q] = 0.f; } \
        Tr = __builtin_amdgcn_mfma_f32_32x32x16_bf16(UB, bre, Tr, 0, 0, 0); Ti = __builtin_amdgcn_mfma_f32_32x32x16_bf16(UB, bim, Ti, 0, 0, 0); \
        if (r == 0) Tu = __builtin_amdgcn_mfma_f32_32x32x16_bf16(UB, ifrag, Tu, 0, 0, 0); \
        _Pragma("unroll") for (int q = 0; q < 16; ++q) { \
            const float nr = fmaf(lbr, hr, fmaf(-lbi, hi, Tr[q])), ni = fmaf(lbr, hi, fmaf(lbi, hr, Ti[q])); hr = nr; hi = ni; Tr[q] = nr; Ti[q] = ni; } \
        _Pragma("unroll") for (int gq = 0; gq < 4; ++gq) { u32x2 w; w.x = cvtpk(Tr[4 * gq], Tr[4 * gq + 1]); w.y = cvtpk(Tr[4 * gq + 2], Tr[4 * gq + 3]); *(LAS u32x2*)(buf + wrre + 16 * gq) = w; \
            w.x = cvtpk(Ti[4 * gq], Ti[4 * gq + 1]); w.y = cvtpk(Ti[4 * gq + 2], Ti[4 * gq + 3]); *(LAS u32x2*)(buf + wrim + 16 * gq) = w; } \
        if (r == 0) { _Pragma("unroll") for (int gq = 0; gq < 4; ++gq) { u32x2 w; w.x = cvtpk(Tu[4 * gq], Tu[4 * gq + 1]); w.y = cvtpk(Tu[4 * gq + 2], Tu[4 * gq + 3]); *(LAS u32x2*)(buf + wru + 16 * gq) = w; } } \
        LDS_WAIT(); \
        *fmine = (unsigned)((SIDX) + 1); \
        while (*fother < (unsigned)((SIDX) + 1)) { __builtin_amdgcn_s_sleep(0); } \
        asm volatile("" ::: "memory"); \
        f32x4 ya = (f32x4){0.f, 0.f, 0.f, 0.f}; \
        _Pragma("unroll") for (int kq = 0; kq < 5; ++kq) { const s16x4 lo = tr_read16(buf + trofs + kq * 2304), hi2 = tr_read16(buf + trofs + kq * 2304 + 288); \
            const bf16x8 hb = __builtin_shufflevector(lo, hi2, 0, 1, 2, 3, 4, 5, 6, 7); \
            ya = __builtin_amdgcn_mfma_f32_16x16x32_bf16(kq < 4 ? cfrag[kq] : dfrag, hb, ya, 0, 0, 0); } \
        LDS_WAIT(); \
        { const float y0 = gelu_tanh(ya[0]), y1 = gelu_tanh(ya[1]), y2 = gelu_tanh(ya[2]), y3 = gelu_tanh(ya[3]); YO.x = cvtpk(y0, y1); YO.y = cvtpk(y2, y3); } \
    } while (0)
#define S5S_LOAD4(U, GI) do { _Pragma("unroll") for (int q4 = 0; q4 < 4; ++q4) U[q4] = *(const bf16x8*)(ua + (size_t)((GI) * 4 + q4) * 16 * NBW); } while (0)
#define S5S_STORE4(Y, GI) do { _Pragma("unroll") for (int q4 = 0; q4 < 4; ++q4) *(u32x2*)(yo + (size_t)((GI) * 4 + q4) * 16 * BR) = Y[q4]; } while (0)
#define S5S_GROUP(UC, UN, YP, YC, GI) do { \
        { const int gn = ((GI) + 1 < NGRP) ? (GI) + 1 : NGRP - 1; S5S_LOAD4(UN, gn); } \
        if ((GI) > 0) S5S_STORE4(YP, (GI) - 1); \
        __builtin_amdgcn_sched_barrier(0); \
        S5S_STEP(UC[0], YC[0], (GI) * 4 + 0); S5S_STEP(UC[1], YC[1], (GI) * 4 + 1); S5S_STEP(UC[2], YC[2], (GI) * 4 + 2); S5S_STEP(UC[3], YC[3], (GI) * 4 + 3); \
    } while (0)
    bf16x8 uA[4], uB[4]; u32x2 yA[4], yB[4];
    S5S_LOAD4(uA, 0);
#pragma unroll 1
    for (int gi = 0; gi < NGRP; gi += 2) { S5S_GROUP(uA, uB, yB, yA, gi); S5S_GROUP(uB, uA, yA, yB, gi + 1); }
    S5S_STORE4(yB, NGRP - 1);
#undef S5S_GROUP
#undef S5S_STORE4
#undef S5S_LOAD4
#undef S5S_STEP
    { const size_t o = ((size_t)(2 * sub + hh) * SG + g) * SP + 32 * r; hout_re[o + n] = hr; hout_im[o + n] = hi; }
}
constexpr int S5_NBUF = 4, S5_IMG = 11520;
template <int r>
DI void s5_prod(const bf16_t* Z1, const bf16_t* bbt, const float* lbt, float* hout_re, float* hout_im,
                LAS unsigned char* img, volatile LAS unsigned* flags, const int item, const int lane_in) {
    int lane_o = lane_in; asm volatile("" : "+v"(lane_o)); const int lane = lane_o;
    const int n = lane & 31, hh = lane >> 5;
    const int g = item >> 2, sub = item & 3;
    const bf16x8 bre = *(const bf16x8*)(bbt + ((size_t)g * 128 + 32 * r + n) * SC + 8 * hh), bim = *(const bf16x8*)(bbt + ((size_t)g * 128 + 64 + 32 * r + n) * SC + 8 * hh);
    bf16x8 ifrag;
#pragma unroll
    for (int e = 0; e < 8; ++e) ifrag[e] = (n == 8 * hh + e) ? (short)0x3f80 : (short)0;
    const float lbr = lbt[2 * (g * SP + 32 * r + n)], lbi = lbt[2 * (g * SP + 32 * r + n) + 1];
    const int ha = (n >> 2) & 1, ra = (n & 3) + 4 * (n >> 3);
    const int rowA = (2 * sub + ha) * T_P + ra;
    const bf16_t* ua = Z1 + (size_t)rowA * NBW + g * SC + 8 * hh;
    const int wrre = (32 * r + n) * 72 + 8 * hh, wrim = (64 + 32 * r + n) * 72 + 8 * hh, wru = (128 + n) * 72 + 8 * hh;
    volatile LAS unsigned* fmine = flags + r; volatile LAS unsigned long long* fcons = (volatile LAS unsigned long long*)(flags + 2);
    float hr = 0.f, hi = 0.f;
    constexpr int NGRP = T_P / 64;
#define S5P_STEP(UB, SIDX, J) do { \
        LAS unsigned char* buf = img + (J) * S5_IMG; \
        f32x16 Tr, Ti, Tu; \
        _Pragma("unroll") for (int q = 0; q < 16; ++q) { Tr[q] = 0.f; Ti[q] = 0.f; Tu[q] = 0.f; } \
        Tr = __builtin_amdgcn_mfma_f32_32x32x16_bf16(UB, bre, Tr, 0, 0, 0); Ti = __builtin_amdgcn_mfma_f32_32x32x16_bf16(UB, bim, Ti, 0, 0, 0); \
        if constexpr (r == 0) Tu = __builtin_amdgcn_mfma_f32_32x32x16_bf16(UB, ifrag, Tu, 0, 0, 0); \
        if (((J) & 1) == 0 && (SIDX) >= S5_NBUF) { const unsigned need = (unsigned)((SIDX) - 2);        \
            for (;;) { const unsigned long long fc = *fcons; if ((unsigned)fc >= need && (unsigned)(fc >> 32) >= need) break; __builtin_amdgcn_s_sleep(0); } \
            asm volatile("" ::: "memory"); } \
        _Pragma("unroll") for (int q = 0; q < 16; ++q) { \
            const float nr = fmaf(lbr, hr, fmaf(-lbi, hi, Tr[q])), ni = fmaf(lbr, hi, fmaf(lbi, hr, Ti[q])); hr = nr; hi = ni; \
            asm volatile("" : "+v"(hr)); asm volatile("" : "+v"(hi));         \
            Tr[q] = hr; Ti[q] = hi; } \
        if ((SIDX) > 0) { LDS_WAIT(); *fmine = (unsigned)(SIDX); }                                     \
        _Pragma("unroll") for (int gq = 0; gq < 4; ++gq) { u32x2 w; w.x = cvtpk(Tr[4 * gq], Tr[4 * gq + 1]); w.y = cvtpk(Tr[4 * gq + 2], Tr[4 * gq + 3]); *(LAS u32x2*)(buf + wrre + 16 * gq) = w; \
            w.x = cvtpk(Ti[4 * gq], Ti[4 * gq + 1]); w.y = cvtpk(Ti[4 * gq + 2], Ti[4 * gq + 3]); *(LAS u32x2*)(buf + wrim + 16 * gq) = w; } \
        if constexpr (r == 0) { _Pragma("unroll") for (int gq = 0; gq < 4; ++gq) { u32x2 w; w.x = cvtpk(Tu[4 * gq], Tu[4 * gq + 1]); w.y = cvtpk(Tu[4 * gq + 2], Tu[4 * gq + 3]); *(LAS u32x2*)(buf + wru + 16 * gq) = w; } } \
    } while (0)
#define S5P_LOAD4(U, GI) do { _Pragma("unroll") for (int q4 = 0; q4 < 4; ++q4) U[q4] = *(const bf16x8*)(ua + (size_t)((GI) * 4 + q4) * 16 * NBW); } while (0)
#define S5P_GROUP(UC, UN, GI) do { \
        { const int gn = ((GI) + 3 < NGRP) ? (GI) + 3 : NGRP - 1; S5P_LOAD4(UN, gn); } \
        __builtin_amdgcn_sched_barrier(0); \
        S5P_STEP(UC[0], (GI) * 4 + 0, 0); S5P_STEP(UC[1], (GI) * 4 + 1, 1); S5P_STEP(UC[2], (GI) * 4 + 2, 2); S5P_STEP(UC[3], (GI) * 4 + 3, 3); \
    } while (0)
    bf16x8 uA[4], uB[4], uC[4], uD[4];
    S5P_LOAD4(uA, 0); S5P_LOAD4(uB, 1); S5P_LOAD4(uC, 2);
#pragma unroll 1
    for (int gi = 0; gi < NGRP; gi += 4) { S5P_GROUP(uA, uD, gi); S5P_GROUP(uB, uA, gi + 1); S5P_GROUP(uC, uB, gi + 2); S5P_GROUP(uD, uC, gi + 3); }
#undef S5P_GROUP
#undef S5P_LOAD4
#undef S5P_STEP
    LDS_WAIT(); *fmine = (unsigned)(NGRP * 4);
    { const size_t o = ((size_t)(2 * sub + hh) * SG + g) * SP + 32 * r; hout_re[o + n] = hr; hout_im[o + n] = hi; }
}
DI void s5_cons(const bf16_t* ctt, const float* dvec, bf16_t* YGp, LAS unsigned char* img, volatile LAS unsigned* flags, const int item, const int c, const int lane_in) {
    int lane_o = lane_in; asm volatile("" : "+v"(lane_o)); const int lane = lane_o;
    const int i16 = lane & 15, G4 = lane >> 4;
    const int g = item >> 2, sub = item & 3;
    bf16x8 cfrag[4];
#pragma unroll
    for (int j = 0; j < 4; ++j) cfrag[j] = *(const bf16x8*)(ctt + ((size_t)g * SC + i16) * 128 + 32 * j + 8 * G4);
    bf16x8 dfrag; { const float dv = dvec[g * SC + i16];
#pragma unroll
        for (int e = 0; e < 8; ++e) dfrag[e] = (8 * G4 + e == i16) ? (short)f2bf(dv) : (short)0; }
    const int rho = 16 * c + i16, he = (rho >> 2) & 1, re = (rho & 3) + 4 * (rho >> 3);
    const int rowE = (2 * sub + he) * T_P + re;
    bf16_t* yo = YGp + (size_t)rowE * BR + g * SC + 4 * G4;
    const int trofs = (8 * G4 + (i16 >> 2)) * 72 + 8 * (i16 & 3) + c * 32;
    volatile LAS unsigned* fmine = flags + 2 + c; volatile LAS unsigned long long* fprod = (volatile LAS unsigned long long*)flags;
    constexpr int NGRP = T_P / 64;
#define S5C_BODY(YA, J) do { \
        const LAS unsigned char* buf = img + (J) * S5_IMG; \
        YA = (f32x4){0.f, 0.f, 0.f, 0.f}; \
        _Pragma("unroll") for (int kq = 0; kq < 5; ++kq) { const s16x4 lo = tr_read16(buf + trofs + kq * 2304), hi2 = tr_read16(buf + trofs + kq * 2304 + 288); \
            const bf16x8 hb = __builtin_shufflevector(lo, hi2, 0, 1, 2, 3, 4, 5, 6, 7); \
            YA = __builtin_amdgcn_mfma_f32_16x16x32_bf16(kq < 4 ? cfrag[kq] : dfrag, hb, YA, 0, 0, 0); } \
    } while (0)
#define S5C_GELU(YO, YA) do { const float y0 = gelu_tanh(YA[0]), y1 = gelu_tanh(YA[1]), y2 = gelu_tanh(YA[2]), y3 = gelu_tanh(YA[3]); YO.x = cvtpk(y0, y1); YO.y = cvtpk(y2, y3); } while (0)
#define S5C_PAIR(YO0, YO1, SIDX, J) do { \
        { const unsigned need = (unsigned)((SIDX) + 2); for (;;) { const unsigned long long fp = *fprod; if ((unsigned)fp >= need && (unsigned)(fp >> 32) >= need) break; __builtin_amdgcn_s_sleep(0); } \
          asm volatile("" ::: "memory"); } \
        f32x4 ya0, ya1; S5C_BODY(ya0, J); S5C_BODY(ya1, (J) + 1); \
        LDS_WAIT(); \
        *fmine = (unsigned)((SIDX) + 2); \
        S5C_GELU(YO0, ya0); S5C_GELU(YO1, ya1); \
    } while (0)
#define S5C_STORE4(Y, GI) do { _Pragma("unroll") for (int q4 = 0; q4 < 4; ++q4) *(u32x2*)(yo + (size_t)((GI) * 4 + q4) * 16 * BR) = Y[q4]; } while (0)
    u32x2 yA[4];
#pragma unroll 1
    for (int gi = 0; gi < NGRP; ++gi) {
        S5C_PAIR(yA[0], yA[1], gi * 4, 0); S5C_PAIR(yA[2], yA[3], gi * 4 + 2, 2);
        S5C_STORE4(yA, gi);
    }
#undef S5C_PAIR
#undef S5C_GELU
#undef S5C_BODY
#undef S5C_STORE4
}
DI void spatial_stage_w(const float* wg, LAS unsigned char* wimg, const int tid) {
#pragma unroll
    for (int i = 0; i < 4; ++i) { const int cid = tid + NTHR * i, t = cid >> 4, c = cid & 15;
        const f32x4 a = *(const f32x4*)(wg + t * CH + 8 * c), b = *(const f32x4*)(wg + t * CH + 8 * c + 4); const int s0 = 8 * c;
        u32x4 w; w.x = cvtpk(s0 + 0 <= t ? a.x : 0.f, s0 + 1 <= t ? a.y : 0.f); w.y = cvtpk(s0 + 2 <= t ? a.z : 0.f, s0 + 3 <= t ? a.w : 0.f);
        w.z = cvtpk(s0 + 4 <= t ? b.x : 0.f, s0 + 5 <= t ? b.y : 0.f); w.w = cvtpk(s0 + 6 <= t ? b.z : 0.f, s0 + 7 <= t ? b.w : 0.f);
        *(LAS u32x4*)(wimg + t * 256 + ((c ^ (t & 15)) << 4)) = w; }
}
DI void spatial_phase(const bf16_t* Zb, const float* vstat, const float* lng, const float* lnb, const float* wsp, const float* bsp, bf16_t* MIXp, LAS unsigned char* lds,
                      const int vcu, const int G, const int tid_in, const int wave, const int lane_in) {
    int tid_o = tid_in, lane_o = lane_in; asm volatile("" : "+v"(tid_o), "+v"(lane_o)); const int tid = tid_o, lane = lane_o;
    LAS unsigned char* wimg = lds; LAS unsigned char* vimg = lds + 32768; LAS unsigned char* oimg = vimg;
    constexpr int NITEM = (MP / CH) * AG;
    const bool act = tid < 504; const int cc = tid % 24, r0 = tid / 24;
    const int a = wave & 3, hf = wave >> 2, n = lane & 31, hh = lane >> 5, i16 = lane & 15, blk = (lane >> 4) & 1;
    const LAS unsigned char* trb = vimg + (8 * hh + (i16 >> 2)) * 448 + 32 * blk + 8 * (i16 & 3);
    u32x4 vw[7]; f32x2 st[7];
    int item = vcu, last_g = -1;
    if (item < NITEM && act) { const int g = item & 7, c = item >> 3;
#pragma unroll
        for (int i = 0; i < 7; ++i) { const int sr = r0 + 21 * i; if (sr < CH) { const int row = c * CH + sr; vw[i] = __builtin_nontemporal_load((const u32x4*)(Zb + (size_t)row * ZA + BR + g * AD + 8 * cc)); st[i] = *(const f32x2*)(vstat + 2 * row); } } }
    for (; item < NITEM; item += G) {
        const int g = item & 7, c = item >> 3;
        __syncthreads();
        if (g != last_g) { spatial_stage_w(wsp + (size_t)g * CH * CH, wimg, tid); last_g = g; }
        if (act) { const int vcol = g * AD + 8 * cc;
            const f32x4 g0 = *(const f32x4*)(lng + vcol), g1 = *(const f32x4*)(lng + vcol + 4), b0 = *(const f32x4*)(lnb + vcol), b1 = *(const f32x4*)(lnb + vcol + 4);
            const float gg[8] = {g0[0], g0[1], g0[2], g0[3], g1[0], g1[1], g1[2], g1[3]}, bv[8] = {b0[0], b0[1], b0[2], b0[3], b1[0], b1[1], b1[2], b1[3]};
#pragma unroll
            for (int i = 0; i < 7; ++i) { const int sr = r0 + 21 * i;
                if (sr < CH) { const float mean = st[i].x * (1.f / BR), var = st[i].y * (1.f / BR) - mean * mean; const float rstd = 1.0f / sqrtf(var + EPS), mr = -mean * rstd;
                    float o[8];
#pragma unroll
                    for (int e = 0; e < 4; ++e) { const float x0 = __uint_as_float(vw[i][e] << 16), x1 = __uint_as_float(vw[i][e] & 0xffff0000u);
                        o[2 * e] = (x0 * rstd + mr) * gg[2 * e] + bv[2 * e]; o[2 * e + 1] = (x1 * rstd + mr) * gg[2 * e + 1] + bv[2 * e + 1]; }
                    u32x4 w; w.x = cvtpk(o[0], o[1]); w.y = cvtpk(o[2], o[3]); w.z = cvtpk(o[4], o[5]); w.w = cvtpk(o[6], o[7]);
                    *(LAS u32x4*)(vimg + sr * 448 + cc * 16) = w; } } }
        __syncthreads();
        u32x4 uq[7];
        if (act) { const int nit = item + G;
            if (nit < NITEM) { const int g2 = nit & 7, c2 = nit >> 3;
#pragma unroll
                for (int i = 0; i < 7; ++i) { const int sr = r0 + 21 * i; if (sr < CH) { const int row = c2 * CH + sr; vw[i] = __builtin_nontemporal_load((const u32x4*)(Zb + (size_t)row * ZA + BR + g2 * AD + 8 * cc)); st[i] = *(const f32x2*)(vstat + 2 * row); } } }
#pragma unroll
            for (int i = 0; i < 7; ++i) { const int sr = r0 + 21 * i; if (sr < CH) { const bf16_t* zr = Zb + (size_t)(c * CH + sr) * ZA + g * AD + 8 * cc; uq[i] = __builtin_nontemporal_load((const u32x4*)zr); } } }
        f32x16 acc[3];
#pragma unroll
        for (int k = 0; k < 3; ++k) {
            const int tt = hf == 0 ? (k < 2 ? a : 3 - a) : (k < 1 ? a : 3 - a);
            const int dt = hf == 0 ? (k < 2 ? k : 3) : (k < 1 ? 2 : 3 + k);
            const int t = 32 * tt + n;
#pragma unroll
            for (int r = 0; r < 16; ++r) acc[k][r] = 0.f;
            const LAS unsigned char* wb = wimg + t * 256; const int tx = t & 15;
            const int nks = 2 * (tt + 1);
#pragma unroll 2
            for (int ks = 0; ks < nks; ++ks) {
                const s16x4 lo = tr_read16(trb + ks * 16 * 448 + dt * 64), hi = tr_read16(trb + ks * 16 * 448 + dt * 64 + 4 * 448);
                const bf16x8 af = __builtin_shufflevector(lo, hi, 0, 1, 2, 3, 4, 5, 6, 7);
                const bf16x8 bfr = *(const LAS bf16x8*)(wb + (((2 * ks + hh) ^ tx) << 4));
                acc[k] = __builtin_amdgcn_mfma_f32_32x32x16_bf16(af, bfr, acc[k], 0, 0, 0);
            }
        }
        __syncthreads();
#pragma unroll
        for (int k = 0; k < 3; ++k) {
            const int tt = hf == 0 ? (k < 2 ? a : 3 - a) : (k < 1 ? a : 3 - a);
            const int dt = hf == 0 ? (k < 2 ? k : 3) : (k < 1 ? 2 : 3 + k);
            const int t = 32 * tt + n; const float bs = bsp[g * CH + t];
#pragma unroll
            for (int q4 = 0; q4 < 4; ++q4) { u32x2 w; w.x = cvtpk(acc[k][4 * q4] + bs, acc[k][4 * q4 + 1] + bs); w.y = cvtpk(acc[k][4 * q4 + 2] + bs, acc[k][4 * q4 + 3] + bs);
                *(LAS u32x2*)(oimg + t * 400 + (32 * dt + 8 * q4 + 4 * hh) * 2) = w; }
        }
        __syncthreads();
        if (act) {
#pragma unroll
            for (int i = 0; i < 7; ++i) { const int sr = r0 + 21 * i;
                if (sr < CH) { const u32x4 mw = *(const LAS u32x4*)(oimg + sr * 400 + cc * 16); u32x4 w;
#pragma unroll
                    for (int e = 0; e < 4; ++e) { const float o0 = __uint_as_float(uq[i][e] << 16) * __uint_as_float(mw[e] << 16);
                        const float o1 = __uint_as_float(uq[i][e] & 0xffff0000u) * __uint_as_float(mw[e] & 0xffff0000u); w[e] = cvtpk(o0, o1); }
                    *(u32x4*)(MIXp + (size_t)(c * CH + sr) * MW + g * AD + 8 * cc) = w; } } }
    }
}

DI float selv(bool c, float a, float b) { asm volatile("" : "+v"(a), "+v"(b)); return c ? a : b; }
DI void attn_sample_seq(const bf16_t* Zb, const int ldz, const int qoff, const int goff, const float* ck, const float* cv, bf16_t* MIXp, LAS unsigned char* lds, const int item, const int wave, const int lane_in) {
    int lane_o = lane_in; asm volatile("" : "+v"(lane_o)); const int lane = lane_o;
    const int b = item >> 1, hb = wave & 1, h = 2 * (item & 1) + hb, kq = wave >> 1, hf = lane >> 5, dl = lane & 31;
    LAS float* sc = (LAS float*)(lds + wave * 1024);
    LAS float* xch = (LAS float*)(lds + 8192 + (hb * 3 + (kq - 1)) * 2176);
    const float L2E = 1.4426950408889634f;
    float q[4][4];
#pragma unroll
    for (int t = 0; t < 4; ++t) { const u32x2 w = *(const u32x2*)(Zb + (size_t)(MP + b * T_S + t) * ldz + qoff + h * HD + 4 * dl);
        q[t][0] = __uint_as_float(w.x << 16); q[t][1] = __uint_as_float(w.x & 0xffff0000u); q[t][2] = __uint_as_float(w.y << 16); q[t][3] = __uint_as_float(w.y & 0xffff0000u); }
    const size_t kvo = ((size_t)(b * NMEM + 64 * kq + hf)) * XA + h * HD + 4 * dl;
    const float* kbase = ck + kvo; const float* vbase = cv + kvo;
    const int t_l = ((lane >> 4) & 1) * 2 + ((lane >> 3) & 1);
    f32x4 kv[32];
#pragma unroll
    for (int mp = 0; mp < 32; ++mp) kv[mp] = __builtin_nontemporal_load((const f32x4*)(kbase + (size_t)mp * 2 * XA));
    f32x4 vv[16];
#pragma unroll
    for (int mp = 0; mp < 16; ++mp) vv[mp] = __builtin_nontemporal_load((const f32x4*)(vbase + (size_t)mp * 2 * XA));
    __builtin_amdgcn_sched_barrier(0);
#pragma unroll
    for (int mp = 0; mp < 32; ++mp) {
        const f32x4 k4 = kv[mp];
        const float s0 = q[0][0] * k4.x + q[0][1] * k4.y + q[0][2] * k4.z + q[0][3] * k4.w, s1 = q[1][0] * k4.x + q[1][1] * k4.y + q[1][2] * k4.z + q[1][3] * k4.w;
        const float s2 = q[2][0] * k4.x + q[2][1] * k4.y + q[2][2] * k4.z + q[2][3] * k4.w, s3 = q[3][0] * k4.x + q[3][1] * k4.y + q[3][2] * k4.z + q[3][3] * k4.w;
        const bool u16 = (lane & 16) != 0, u8 = (lane & 8) != 0;
        const float a = (u16 ? s2 : s0) + __shfl_xor(u16 ? s0 : s2, 16), c = (u16 ? s3 : s1) + __shfl_xor(u16 ? s1 : s3, 16);
        float v = (u8 ? c : a) + __shfl_xor(u8 ? a : c, 8);
        v += __shfl_xor(v, 4); v += __shfl_xor(v, 2); v += __shfl_xor(v, 1);
        if ((lane & 7) == 0) sc[(2 * mp + hf) * 4 + t_l] = v;
    }
    LDS_WAIT();
    float mx[4], l[4];
#pragma unroll
    for (int t = 0; t < 4; ++t) { const float x0 = sc[lane * 4 + t]; mx[t] = wave_max(x0);
        const float p0 = __builtin_amdgcn_exp2f((x0 - mx[t]) * L2E); l[t] = wave_sum(p0); sc[lane * 4 + t] = p0; }
    LDS_WAIT();
    f32x4 o[4];
#pragma unroll
    for (int t = 0; t < 4; ++t) o[t] = (f32x4){0.f, 0.f, 0.f, 0.f};
#pragma unroll
    for (int mp = 0; mp < 16; ++mp) { const f32x4 pv = *(const LAS f32x4*)(sc + (2 * mp + hf) * 4); o[0] += vv[mp] * pv.x; o[1] += vv[mp] * pv.y; o[2] += vv[mp] * pv.z; o[3] += vv[mp] * pv.w; }
#pragma unroll
    for (int mp = 0; mp < 16; ++mp) vv[mp] = __builtin_nontemporal_load((const f32x4*)(vbase + (size_t)(16 + mp) * 2 * XA));
#pragma unroll
    for (int mp = 0; mp < 16; ++mp) { const f32x4 pv = *(const LAS f32x4*)(sc + (2 * (16 + mp) + hf) * 4); o[0] += vv[mp] * pv.x; o[1] += vv[mp] * pv.y; o[2] += vv[mp] * pv.z; o[3] += vv[mp] * pv.w; }
#pragma unroll
    for (int t = 0; t < 4; ++t)
#pragma unroll
        for (int e = 0; e < 4; ++e) o[t][e] += __shfl_xor(o[t][e], 32);
    if (kq != 0) {
        if (lane < 32) {
#pragma unroll
            for (int t = 0; t < 4; ++t) *(LAS f32x4*)(xch + 8 + t * 128 + 4 * dl) = o[t]; }
        if (lane == 0) { *(LAS f32x4*)xch = (f32x4){mx[0], mx[1], mx[2], mx[3]}; *(LAS f32x4*)(xch + 4) = (f32x4){l[0], l[1], l[2], l[3]}; }
    }
    __syncthreads();
    if (kq == 0) {
        const LAS float* x1 = (const LAS float*)(lds + 8192 + (hb * 3 + 0) * 2176); const LAS float* x2 = x1 + 544; const LAS float* x3 = x2 + 544;
        const f32x4 m1 = *(const LAS f32x4*)x1, l1 = *(const LAS f32x4*)(x1 + 4), m2 = *(const LAS f32x4*)x2, l2 = *(const LAS f32x4*)(x2 + 4), m3 = *(const LAS f32x4*)x3, l3 = *(const LAS f32x4*)(x3 + 4);
#pragma unroll
        for (int j = 0; j < 2; ++j) {
            const int t = 2 * hf + j; const bool up = hf != 0;
            const float m0s = selv(up, mx[2 + j], mx[j]), l0s = selv(up, l[2 + j], l[j]), m1s = selv(up, m1[2 + j], m1[j]), l1s = selv(up, l1[2 + j], l1[j]);
            const float m2s = selv(up, m2[2 + j], m2[j]), l2s = selv(up, l2[2 + j], l2[j]), m3s = selv(up, m3[2 + j], m3[j]), l3s = selv(up, l3[2 + j], l3[j]);
            f32x4 o0; o0.x = selv(up, o[2 + j].x, o[j].x); o0.y = selv(up, o[2 + j].y, o[j].y); o0.z = selv(up, o[2 + j].z, o[j].z); o0.w = selv(up, o[2 + j].w, o[j].w);
            const f32x4 o1 = *(const LAS f32x4*)(x1 + 8 + t * 128 + 4 * dl), o2 = *(const LAS f32x4*)(x2 + 8 + t * 128 + 4 * dl), o3 = *(const LAS f32x4*)(x3 + 8 + t * 128 + 4 * dl);
            const float Mx = fmaxf(fmaxf(m0s, m1s), fmaxf(m2s, m3s));
            const float a0 = __builtin_amdgcn_exp2f((m0s - Mx) * L2E), a1 = __builtin_amdgcn_exp2f((m1s - Mx) * L2E), a2 = __builtin_amdgcn_exp2f((m2s - Mx) * L2E), a3 = __builtin_amdgcn_exp2f((m3s - Mx) * L2E);
            const float inv = 1.0f / (l0s * a0 + l1s * a1 + l2s * a2 + l3s * a3);
            const size_t row = (size_t)(MP + b * T_S + t);
            const u32x2 gw2 = *(const u32x2*)(Zb + row * ldz + goff + h * HD + 4 * dl);
            const f32x4 os = (o0 * a0 + o1 * a1 + o2 * a2 + o3 * a3) * inv;
            const float r0 = os.x * __uint_as_float(gw2.x << 16), r1 = os.y * __uint_as_float(gw2.x & 0xffff0000u), r2 = os.z * __uint_as_float(gw2.y << 16), r3 = os.w * __uint_as_float(gw2.y & 0xffff0000u);
            u32x2 w; w.x = cvtpk(r0, r1); w.y = cvtpk(r2, r3);
            *(u32x2*)(MIXp + row * MW + BR + h * HD + 4 * dl) = w;
        }
    }
    __syncthreads();
}

DI void attn_prompt_tile(const bf16_t* Zb, const int ldz, const int qoff, const int goff, const bf16_t* Kpl, const bf16_t* VTl, bf16_t* MIXp, const int tile, const int lane_in) {
    int lane_o = lane_in; asm volatile("" : "+v"(lane_o)); const int lane = lane_o;
    const int unit = tile >> 3, wt = tile & 7, b = unit >> 5, h = (unit >> 3) & 3, qb = unit & 7;
    const int qi = lane & 31, hh = lane >> 5;
    const int row = b * T_P + qb * 256 + wt * 32 + qi;
    const bf16_t* zr = Zb + (size_t)row * ldz;
    bf16x8 qf[8];
#pragma unroll
    for (int ks = 0; ks < 8; ++ks) qf[ks] = *(const bf16x8*)(zr + qoff + h * HD + 16 * ks + 8 * hh);
    const int pi = (qi & ~12) | ((qi & 4) << 1) | ((qi & 8) >> 1);
    const bf16_t* kg = Kpl + (size_t)(b * NMEM + pi) * XA + h * HD + 8 * hh;
    const bf16_t* vg = VTl + (size_t)((b * NH + h) * HD + qi) * NMEM + 8 * hh;
    f32x16 sacc[8];
#pragma unroll
    for (int T = 0; T < 8; ++T) {
#pragma unroll
        for (int r = 0; r < 16; ++r) sacc[T][r] = 0.f;
        bf16x8 kf[8];
#pragma unroll
        for (int ks = 0; ks < 8; ++ks) kf[ks] = *(const bf16x8*)(kg + (size_t)(32 * T) * XA + 16 * ks);
#pragma unroll
        for (int ks = 0; ks < 8; ++ks) sacc[T] = __builtin_amdgcn_mfma_f32_32x32x16_bf16(kf[ks], qf[ks], sacc[T], 0, 0, 0);
    }
    float mx = -3.0e38f;
#pragma unroll
    for (int T = 0; T < 8; ++T)
#pragma unroll
        for (int r = 0; r < 16; ++r) mx = fmaxf(mx, sacc[T][r]);
    mx = fmaxf(mx, __shfl_xor(mx, 32));
    float sum = 0.f;
#pragma unroll
    for (int T = 0; T < 8; ++T)
#pragma unroll
        for (int r = 0; r < 16; ++r) { const float p = __builtin_amdgcn_exp2f((sacc[T][r] - mx) * 1.4426950408889634f); sacc[T][r] = p; sum += p; }
    sum += __shfl_xor(sum, 32);
    const float inv = 1.0f / sum;
    f32x16 oacc[4];
#pragma unroll
    for (int dt = 0; dt < 4; ++dt)
#pragma unroll
        for (int r = 0; r < 16; ++r) oacc[dt][r] = 0.f;
#pragma unroll
    for (int T = 0; T < 8; ++T) {
#pragma unroll
        for (int s2 = 0; s2 < 2; ++s2) {
            bf16x8 vf[2][4];
#pragma unroll
            for (int dt = 0; dt < 4; ++dt) vf[s2][dt] = *(const bf16x8*)(vg + (size_t)(32 * dt) * NMEM + 32 * T + 16 * s2);
            u32x4 pw; pw.x = cvtpk(sacc[T][8 * s2 + 0], sacc[T][8 * s2 + 1]); pw.y = cvtpk(sacc[T][8 * s2 + 2], sacc[T][8 * s2 + 3]);
            pw.z = cvtpk(sacc[T][8 * s2 + 4], sacc[T][8 * s2 + 5]); pw.w = cvtpk(sacc[T][8 * s2 + 6], sacc[T][8 * s2 + 7]);
            const bf16x8 pf = __builtin_bit_cast(bf16x8, pw);
#pragma unroll
            for (int dt = 0; dt < 4; ++dt) oacc[dt] = __builtin_amdgcn_mfma_f32_32x32x16_bf16(vf[s2][dt], pf, oacc[dt], 0, 0, 0);
        }
    }
    bf16_t* mr = MIXp + (size_t)row * MW + BR + h * HD;
#pragma unroll
    for (int dt = 0; dt < 4; ++dt)
#pragma unroll
        for (int g4 = 0; g4 < 4; ++g4) { const int d0 = 32 * dt + 8 * g4 + 4 * hh;
            const u32x2 gw2 = *(const u32x2*)(zr + goff + h * HD + d0);
            const float o0 = oacc[dt][4 * g4 + 0] * inv * __uint_as_float(gw2.x << 16), o1 = oacc[dt][4 * g4 + 1] * inv * __uint_as_float(gw2.x & 0xffff0000u);
            const float o2 = oacc[dt][4 * g4 + 2] * inv * __uint_as_float(gw2.y << 16), o3 = oacc[dt][4 * g4 + 3] * inv * __uint_as_float(gw2.y & 0xffff0000u);
            u32x2 w; w.x = cvtpk(o0, o1); w.y = cvtpk(o2, o3);
            *(u32x2*)(mr + d0) = w; }
}
DI void attn_sample_item(const bf16_t* Zb, const int ldz, const int qoff, const int goff, const float* ck, const float* cv, bf16_t* MIXp, LAS float* sc, const int item, const int lane_in) {
    int lane_o = lane_in; asm volatile("" : "+v"(lane_o)); const int lane = lane_o;
    const int b = item >> 2, h = item & 3, hf = lane >> 5, dl = lane & 31;
    const float L2E = 1.4426950408889634f;
    float q[4][4];
#pragma unroll
    for (int t = 0; t < 4; ++t) { const u32x2 w = *(const u32x2*)(Zb + (size_t)(MP + b * T_S + t) * ldz + qoff + h * HD + 4 * dl);
        q[t][0] = __uint_as_float(w.x << 16); q[t][1] = __uint_as_float(w.x & 0xffff0000u); q[t][2] = __uint_as_float(w.y << 16); q[t][3] = __uint_as_float(w.y & 0xffff0000u); }
    const size_t kvo = ((size_t)(b * NMEM + hf)) * XA + h * HD + 4 * dl;
    const float* kbase = ck + kvo; const float* vbase = cv + kvo;
    const int t_l = ((lane >> 4) & 1) * 2 + ((lane >> 3) & 1);
    constexpr int NBT = 16;
#define SA_KLOAD(KV, BT) do { _Pragma("unroll") for (int mp = 0; mp < 8; ++mp) KV[mp] = __builtin_nontemporal_load((const f32x4*)(kbase + (size_t)((BT) * 8 + mp) * 2 * XA)); } while (0)
#define SA_KRED(KV, BT) do { _Pragma("unroll") for (int mp = 0; mp < 8; ++mp) { \
            const f32x4 k4 = KV[mp]; \
            const float s0 = q[0][0] * k4.x + q[0][1] * k4.y + q[0][2] * k4.z + q[0][3] * k4.w, s1 = q[1][0] * k4.x + q[1][1] * k4.y + q[1][2] * k4.z + q[1][3] * k4.w; \
            const float s2 = q[2][0] * k4.x + q[2][1] * k4.y + q[2][2] * k4.z + q[2][3] * k4.w, s3 = q[3][0] * k4.x + q[3][1] * k4.y + q[3][2] * k4.z + q[3][3] * k4.w; \
            const bool u16 = (lane & 16) != 0, u8 = (lane & 8) != 0; \
            const float a = (u16 ? s2 : s0) + __shfl_xor(u16 ? s0 : s2, 16), c = (u16 ? s3 : s1) + __shfl_xor(u16 ? s1 : s3, 16); \
            float v = (u8 ? c : a) + __shfl_xor(u8 ? a : c, 8); \
            v += __shfl_xor(v, 4); v += __shfl_xor(v, 2); v += __shfl_xor(v, 1); \
            if ((lane & 7) == 0) sc[(2 * ((BT) * 8 + mp) + hf) * 4 + t_l] = v; } } while (0)
    {
        f32x4 kvA[8], kvB[8], kvC[8];
        SA_KLOAD(kvA, 0); SA_KLOAD(kvB, 1);
#pragma unroll 1
        for (int bt = 0; bt < NBT - 1; bt += 3) {
            SA_KLOAD(kvC, bt + 2); __builtin_amdgcn_sched_barrier(0); SA_KRED(kvA, bt);
            SA_KLOAD(kvA, bt + 3); __builtin_amdgcn_sched_barrier(0); SA_KRED(kvB, bt + 1);
            { const int bn = (bt + 4 < NBT) ? bt + 4 : NBT - 1; SA_KLOAD(kvB, bn); } __builtin_amdgcn_sched_barrier(0); SA_KRED(kvC, bt + 2);
        }
        SA_KRED(kvA, NBT - 1);
    }
#undef SA_KRED
#undef SA_KLOAD
    LDS_WAIT();
    float inv[4];
#pragma unroll
    for (int t = 0; t < 4; ++t) { float x[4]; float m = -3.0e38f;
#pragma unroll
        for (int j = 0; j < 4; ++j) { x[j] = sc[(lane + 64 * j) * 4 + t]; m = fmaxf(m, x[j]); }
        m = wave_max(m); float l = 0.f;
#pragma unroll
        for (int j = 0; j < 4; ++j) { const float p = __builtin_amdgcn_exp2f((x[j] - m) * L2E); l += p; sc[(lane + 64 * j) * 4 + t] = p; }
        inv[t] = 1.0f / wave_sum(l); }
    LDS_WAIT();
    f32x4 o[4];
#pragma unroll
    for (int t = 0; t < 4; ++t) o[t] = (f32x4){0.f, 0.f, 0.f, 0.f};
#define SA_VLOAD(VV, BT) do { _Pragma("unroll") for (int mp = 0; mp < 8; ++mp) VV[mp] = __builtin_nontemporal_load((const f32x4*)(vbase + (size_t)((BT) * 8 + mp) * 2 * XA)); } while (0)
#define SA_VACC(VV, BT) do { _Pragma("unroll") for (int mp = 0; mp < 8; ++mp) { const f32x4 pv = *(const LAS f32x4*)(sc + (2 * ((BT) * 8 + mp) + hf) * 4); \
            o[0] += VV[mp] * pv.x; o[1] += VV[mp] * pv.y; o[2] += VV[mp] * pv.z; o[3] += VV[mp] * pv.w; } } while (0)
    {
        f32x4 vvA[8], vvB[8], vvC[8];
        SA_VLOAD(vvA, 0); SA_VLOAD(vvB, 1);
#pragma unroll 1
        for (int bt = 0; bt < NBT - 1; bt += 3) {
            SA_VLOAD(vvC, bt + 2); __builtin_amdgcn_sched_barrier(0); SA_VACC(vvA, bt);
            SA_VLOAD(vvA, bt + 3); __builtin_amdgcn_sched_barrier(0); SA_VACC(vvB, bt + 1);
            { const int bn = (bt + 4 < NBT) ? bt + 4 : NBT - 1; SA_VLOAD(vvB, bn); } __builtin_amdgcn_sched_barrier(0); SA_VACC(vvC, bt + 2);
        }
        SA_VACC(vvA, NBT - 1);
    }
#undef SA_VACC
#undef SA_VLOAD
#pragma unroll
    for (int t = 0; t < 4; ++t)
#pragma unroll
        for (int e = 0; e < 4; ++e) o[t][e] += __shfl_xor(o[t][e], 32);
#pragma unroll
    for (int j = 0; j < 2; ++j) {
        const int t = 2 * hf + j; const bool up = hf != 0;
        const float iv = selv(up, inv[2 + j], inv[j]);
        f32x4 o0; o0.x = selv(up, o[2 + j].x, o[j].x); o0.y = selv(up, o[2 + j].y, o[j].y); o0.z = selv(up, o[2 + j].z, o[j].z); o0.w = selv(up, o[2 + j].w, o[j].w);
        const size_t row = (size_t)(MP + b * T_S + t);
        const u32x2 gw2 = *(const u32x2*)(Zb + row * ldz + goff + h * HD + 4 * dl);
        const float r0 = o0.x * iv * __uint_as_float(gw2.x << 16), r1 = o0.y * iv * __uint_as_float(gw2.x & 0xffff0000u), r2 = o0.z * iv * __uint_as_float(gw2.y << 16), r3 = o0.w * iv * __uint_as_float(gw2.y & 0xffff0000u);
        u32x2 w; w.x = cvtpk(r0, r1); w.y = cvtpk(r2, r3);
        *(u32x2*)(MIXp + row * MW + BR + h * HD + 4 * dl) = w;
    }
    LDS_WAIT();
}

DI void attn_sample_half(const bf16_t* Zb, const int ldz, const int qoff, const float* ck, const float* cv, LAS float* sc, LAS float* part, const int item, const int half, const int lane_in) {
    int lane_o = lane_in; asm volatile("" : "+v"(lane_o)); const int lane = lane_o;
    const int b = item >> 2, h = item & 3, hf = lane >> 5, dl = lane & 31;
    const float L2E = 1.4426950408889634f;
    float q[4][4];
#pragma unroll
    for (int t = 0; t < 4; ++t) { const u32x2 w = *(const u32x2*)(Zb + (size_t)(MP + b * T_S + t) * ldz + qoff + h * HD + 4 * dl);
        q[t][0] = __uint_as_float(w.x << 16); q[t][1] = __uint_as_float(w.x & 0xffff0000u); q[t][2] = __uint_as_float(w.y << 16); q[t][3] = __uint_as_float(w.y & 0xffff0000u); }
    const size_t kvo = ((size_t)(b * NMEM + 128 * half + hf)) * XA + h * HD + 4 * dl;
    const float* kbase = ck + kvo; const float* vbase = cv + kvo;
    const int t_l = ((lane >> 4) & 1) * 2 + ((lane >> 3) & 1);
#pragma unroll 1
    for (int bt = 0; bt < 2; ++bt) {
        f32x4 kv[32];
#pragma unroll
        for (int mp = 0; mp < 32; ++mp) kv[mp] = __builtin_nontemporal_load((const f32x4*)(kbase + (size_t)(bt * 32 + mp) * 2 * XA));
#pragma unroll
        for (int mp = 0; mp < 32; ++mp) {
            const f32x4 k4 = kv[mp];
            const float s0 = q[0][0] * k4.x + q[0][1] * k4.y + q[0][2] * k4.z + q[0][3] * k4.w, s1 = q[1][0] * k4.x + q[1][1] * k4.y + q[1][2] * k4.z + q[1][3] * k4.w;
            const float s2 = q[2][0] * k4.x + q[2][1] * k4.y + q[2][2] * k4.z + q[2][3] * k4.w, s3 = q[3][0] * k4.x + q[3][1] * k4.y + q[3][2] * k4.z + q[3][3] * k4.w;
            const bool u16 = (lane & 16) != 0, u8 = (lane & 8) != 0;
            const float a = (u16 ? s2 : s0) + __shfl_xor(u16 ? s0 : s2, 16), c = (u16 ? s3 : s1) + __shfl_xor(u16 ? s1 : s3, 16);
            float v = (u8 ? c : a) + __shfl_xor(u8 ? a : c, 8);
            v += __shfl_xor(v, 4); v += __shfl_xor(v, 2); v += __shfl_xor(v, 1);
            if ((lane & 7) == 0) sc[(2 * (bt * 32 + mp) + hf) * 4 + t_l] = v;
        }
    }
    LDS_WAIT();
    float mx[4], l[4];
#pragma unroll
    for (int t = 0; t < 4; ++t) { const float x0 = sc[lane * 4 + t], x1 = sc[(lane + 64) * 4 + t]; mx[t] = wave_max(fmaxf(x0, x1));
        const float p0 = __builtin_amdgcn_exp2f((x0 - mx[t]) * L2E), p1 = __builtin_amdgcn_exp2f((x1 - mx[t]) * L2E); l[t] = wave_sum(p0 + p1);
        sc[lane * 4 + t] = p0; sc[(lane + 64) * 4 + t] = p1; }
    LDS_WAIT();
    f32x4 o[4];
#pragma unroll
    for (int t = 0; t < 4; ++t) o[t] = (f32x4){0.f, 0.f, 0.f, 0.f};
#pragma unroll 1
    for (int bt = 0; bt < 2; ++bt) {
        f32x4 vv[32];
#pragma unroll
        for (int mp = 0; mp < 32; ++mp) vv[mp] = __builtin_nontemporal_load((const f32x4*)(vbase + (size_t)(bt * 32 + mp) * 2 * XA));
#pragma unroll
        for (int mp = 0; mp < 32; ++mp) { const f32x4 pv = *(const LAS f32x4*)(sc + (2 * (bt * 32 + mp) + hf) * 4); o[0] += vv[mp] * pv.x; o[1] += vv[mp] * pv.y; o[2] += vv[mp] * pv.z; o[3] += vv[mp] * pv.w; }
    }
#pragma unroll
    for (int t = 0; t < 4; ++t)
#pragma unroll
        for (int e = 0; e < 4; ++e) o[t][e] += __shfl_xor(o[t][e], 32);
    if (lane < 32) {
#pragma unroll
        for (int t = 0; t < 4; ++t) *(LAS f32x4*)(part + 8 + t * 128 + 4 * dl) = o[t]; }
    if (lane == 0) { *(LAS f32x4*)part = (f32x4){mx[0], mx[1], mx[2], mx[3]}; *(LAS f32x4*)(part + 4) = (f32x4){l[0], l[1], l[2], l[3]}; }
    LDS_WAIT();
}
DI void attn_sample_merge(const bf16_t* Zb, const int ldz, const int goff, bf16_t* MIXp, const LAS float* p0, const LAS float* p1, const int item, const int lane) {
    const int b = item >> 2, h = item & 3, hf = lane >> 5, dl = lane & 31; const float L2E = 1.4426950408889634f;
#pragma unroll
    for (int j = 0; j < 2; ++j) {
        const int t = 2 * hf + j;
        const float m0 = p0[t], l0 = p0[4 + t], m1 = p1[t], l1 = p1[4 + t];
        const f32x4 o0 = *(const LAS f32x4*)(p0 + 8 + t * 128 + 4 * dl), o1 = *(const LAS f32x4*)(p1 + 8 + t * 128 + 4 * dl);
        const float Mx = fmaxf(m0, m1), a0 = __builtin_amdgcn_exp2f((m0 - Mx) * L2E), a1 = __builtin_amdgcn_exp2f((m1 - Mx) * L2E);
        const float inv = 1.0f / (l0 * a0 + l1 * a1);
        const f32x4 os = (o0 * a0 + o1 * a1) * inv;
        const size_t row = (size_t)(MP + b * T_S + t);
        const u32x2 gw2 = *(const u32x2*)(Zb + row * ldz + goff + h * HD + 4 * dl);
        const float r0 = os.x * __uint_as_float(gw2.x << 16), r1 = os.y * __uint_as_float(gw2.x & 0xffff0000u), r2 = os.z * __uint_as_float(gw2.y << 16), r3 = os.w * __uint_as_float(gw2.y & 0xffff0000u);
        u32x2 w; w.x = cvtpk(r0, r1); w.y = cvtpk(r2, r3);
        *(u32x2*)(MIXp + row * MW + BR + h * HD + 4 * dl) = w;
    }
}
template <int LO, int HI> __global__ void __launch_bounds__(NTHR, 2) mega(Args args) {
    extern __shared__ __attribute__((aligned(16))) unsigned char lds_raw[];
    LAS unsigned char* lds = (LAS unsigned char*)lds_raw;
    const int tid = threadIdx.x, lane = tid & 63, wave = __builtin_amdgcn_readfirstlane(tid >> 6);
    const int G = gridDim.x, bx = blockIdx.x;
    const int vcu = (G % 8 == 0) ? (bx % 8) * (G / 8) + bx / 8 : bx;
    const int gw = vcu * NWAVES + wave, NGW = G * NWAVES;
    unsigned char* ws = args.ws;
    unsigned* ctl = (unsigned*)(ws + WS_CTL);
    volatile LAS unsigned* MISC = (volatile LAS unsigned*)(lds + MISC_OFF);
    for (int u = tid; u < (LDS_BYTES - RING_BYTES) / 4; u += NTHR) ((LAS unsigned*)(lds + RING_BYTES))[u] = 0u;
    __syncthreads();
    XcdBarrier bar; bar.bar = ctl + CW_BAR; bar.x = 0; bar.st = nullptr;
    if constexpr (HI - LO > 1) bar = xcd_barrier_post(ctl + CW_BAR, MISC + 8);
#define IN(k) (LO <= (k) && (k) < HI)
#define SEAM(k) do { if constexpr (IN(k) && IN((k) + 1)) xcd_barrier(bar); } while (0)

#define x_prompt (args.in[0])
#define x_sample (args.in[1])
#define cache_k (args.in[2])
#define cache_v (args.in[3])
#define st_re (args.in[4])
#define st_im (args.in[5])
#define mem_prompt (args.in[6])
#define w_in_a (args.in[7])
#define ln_v_g (args.in[8])
#define ln_v_b (args.in[9])
#define w_spatial (args.in[10])
#define b_spatial (args.in[11])
#define w_in_b (args.in[12])
#define lam_re (args.in[13])
#define lam_im (args.in[14])
#define log_dt (args.in[15])
#define sb_re (args.in[16])
#define sb_im (args.in[17])
#define sc_re (args.in[18])
#define sc_im (args.in[19])
#define ssm_d (args.in[20])
#define w_glu (args.in[21])
#define b_glu (args.in[22])
#define mem_norm_g (args.in[23])
#define w_mem_k (args.in[24])
#define w_mem_v (args.in[25])
#define w_out (args.in[26])
#define pre_g (args.in[27])
#define post_g (args.in[28])
#define out (args.out)
#define WinA ((bf16_t*)(ws + WS_WINA))
#define WinB ((bf16_t*)(ws + WS_WINB))
#define Wglu ((bf16_t*)(ws + WS_WGLU))
#define Wout0 ((bf16_t*)(ws + WS_WOUT0))
#define Wout1 ((bf16_t*)(ws + WS_WOUT1))
#define Wmem ((bf16_t*)(ws + WS_WMEM))
#define MEMN ((bf16_t*)(ws + WS_MEMN))
#define KVBF ((bf16_t*)(ws + WS_KVBF))
#define VTB ((bf16_t*)(ws + WS_VT))
#define SMALL ((float*)(ws + WS_SMALL))
#define XN ((bf16_t*)(ws + WS_XN))
#define Z ((bf16_t*)(ws + WS_Z))
#define YG ((bf16_t*)(ws + WS_YG))
#define MIX ((bf16_t*)(ws + WS_MIX))
#define OUT ((bf16_t*)(ws + WS_OUT))
#define PART ((float*)(ws + WS_PART))
#define Y1 ((bf16_t*)(ws + WS_Y1))
#define VSTAT (SMALL + SM_VSTAT)
#define SS0 (SMALL + SM_SS0)
#define SS1 (SMALL + SM_SS1)
#define SS2 (SMALL + SM_SS2)
#define LB (SMALL + SM_LB)
#define BB (SMALL + SM_BB)
#define BBT ((bf16_t*)(SMALL + SM_BBT))
#define CTT ((bf16_t*)(SMALL + SM_CT))

    if constexpr (IN(0)) {
        LAS float* scr = (LAS float*)(lds + wave * 16384);
        constexpr int I_A = (D / 64) * (NA / 32), I_B = (D / 64) * (NBW / 32), I_G = (BR / 64) * (BR / 32), I_O = (MW / 64) * (D / 32), I_M = (D / 64) * (XA / 32);
        constexpr int NITEMS = I_A + I_B + I_O + 4 * I_M;
        for (int it = gw; it < NITEMS; it += NGW) {
            int r = it;
            if (r < I_A) { const int nb = r % (NA / 32), n_src = 32 * nb;
                const int n_dst = (n_src < BR) ? (n_src >> 7) * 256 + (n_src & 127)
                                : (n_src < 2 * BR) ? 2 * BR + (n_src - BR)
                                : (n_src < 2 * BR + XA) ? 3 * BR + (n_src - 2 * BR)
                                : (n_src < 3 * BR + XA) ? ((n_src - 2 * BR - XA) >> 7) * 256 + 128 + ((n_src - 2 * BR - XA) & 127)
                                : n_src;
                p0_transpose_item(w_in_a, pre_g, D, NA, WinA, n_dst - n_src, scr, r, lane); continue; } r -= I_A;
            if (r < I_B) { p0_transpose_item(w_in_b, pre_g + D, D, NBW, WinB, 0, scr, r, lane); continue; } r -= I_B;
            if (r < I_O) { p0_transpose_item(w_out, nullptr, MW, D, Wout0, 0, scr, r, lane); continue; } r -= I_O;
            const int which = r / I_M; r -= which * I_M;
            const int layer = which >> 1; const float* wsrc = ((which & 1) ? w_mem_v : w_mem_k) + (size_t)layer * D * XA;
            p0_transpose_item(wsrc, mem_norm_g + layer * D, D, XA, Wmem, which * XA, scr, r, lane);
        }
        for (int m0 = gw; m0 < M + MMEM; m0 += 2 * NGW) {
            const float* src[2]; bf16_t* dst[2]; f32x4 v[2][4]; float ss[2];
#pragma unroll
            for (int q = 0; q < 2; ++q) { int m = m0 + q * NGW; if (m >= M + MMEM) m = m0;
                src[q] = (m < MP) ? x_prompt + (size_t)m * D : (m < M) ? x_sample + (size_t)(m - MP) * D : mem_prompt + (size_t)(m - M) * D;
                dst[q] = (m < M) ? XN + (size_t)m * D : MEMN + (size_t)(m - M) * D; }
#pragma unroll
            for (int q = 0; q < 2; ++q)
#pragma unroll
                for (int j = 0; j < 4; ++j) v[q][j] = __builtin_nontemporal_load((const f32x4*)src[q] + lane + 64 * j);
#pragma unroll
            for (int q = 0; q < 2; ++q) { float s2 = 0.f;
#pragma unroll
                for (int j = 0; j < 4; ++j) s2 += (v[q][j].x * v[q][j].x + v[q][j].y * v[q][j].y) + (v[q][j].z * v[q][j].z + v[q][j].w * v[q][j].w);
                ss[q] = 1.0f / sqrtf(wave_sum(s2) * (1.f / D) + EPS); }
#pragma unroll
            for (int q = 0; q < 2; ++q) { unsigned long long* o8 = (unsigned long long*)dst[q] + lane;
#pragma unroll
                for (int j = 0; j < 4; ++j) o8[64 * j] = (unsigned long long)pk2(v[q][j].x * ss[q], v[q][j].y * ss[q]) | ((unsigned long long)pk2(v[q][j].z * ss[q], v[q][j].w * ss[q]) << 32); }
        }
        for (size_t i = (size_t)bx * NTHR + tid; i < SM_ZERO_END; i += (size_t)G * NTHR) SMALL[i] = 0.f;
        for (int e = bx * NTHR + tid; e < SG * SP * SC; e += G * NTHR) {
            const int i = e / SC, c = e % SC, g = i / SP, p = i % SP; const float dt = expf(log_dt[g]); const float lr = lam_re[i], li = lam_im[i];
            const float ar = lr * dt, ai = li * dt; const float ex = expf(ar), cs = cosf(ai), sn = sinf(ai);
            const float lbr = ex * cs, lbi = ex * sn; if (c == 0) { LB[2 * i] = lbr; LB[2 * i + 1] = lbi; }
            const float sh = sinf(0.5f * ai); const float nr = expm1f(ar) * cs - 2.0f * sh * sh, ni = lbi;
            const float den = lr * lr + li * li; const float qr = (nr * lr + ni * li) / den, qi = (ni * lr - nr * li) / den;
            const float br = sb_re[(size_t)i * SC + c], bi = sb_im[(size_t)i * SC + c];
            const float xr = qr * br - qi * bi, xi = qr * bi + qi * br;
            BB[((size_t)i * SC + c) * 2] = xr; BB[((size_t)i * SC + c) * 2 + 1] = xi;
            BBT[((size_t)g * 128 + p) * SC + c] = (bf16_t)f2bf(xr); BBT[((size_t)g * 128 + 64 + p) * SC + c] = (bf16_t)f2bf(xi);
            CTT[((size_t)g * SC + c) * 128 + p] = (bf16_t)f2bf(sc_re[((size_t)g * SC + c) * SP + p]); CTT[((size_t)g * SC + c) * 128 + 64 + p] = (bf16_t)f2bf(-sc_im[((size_t)g * SC + c) * SP + p]);
        }
    }
    SEAM(0);

    if constexpr (IN(1)) {
        pg8::MultiOrder S; S.init(XN, WinA, M, NA, MEMN, Wmem, MMEM, 2 * 2 * XA, D, G, bx);
        EpiInProj E{Z, ZA, VSTAT, 12, 18, 20, 0, 0.08838834764831845f, out + O_MK, out + O_MV, KVBF, VTB, 1};
        pg8::gemm_phase<EpiInProj, pg8::MultiOrder, PG8_ALIGN, PG8_SP2>(lds, D, S, E);
    }
    SEAM(1);

    if constexpr (IN(2)) {
        spatial_phase(Z, VSTAT, ln_v_g, ln_v_b, w_spatial, b_spatial, MIX, lds, vcu, G, tid, wave, lane);
        __syncthreads();
        for (int i = bx * NTHR + tid; i < NB_S * BR; i += G * NTHR) {
            const int b = i / BR, col = i % BR, g = col / AD; float vn[4];
#pragma unroll
            for (int t = 0; t < 4; ++t) { const int row = MP + b * 4 + t; const float v = bf2f(Z[(size_t)row * ZA + BR + col]); const float mean = VSTAT[2 * row] * (1.f / BR); const float var = VSTAT[2 * row + 1] * (1.f / BR) - mean * mean;
                vn[t] = (v - mean) * (1.0f / sqrtf(var + EPS)) * ln_v_g[col] + ln_v_b[col]; out[O_CV + (size_t)(b * 4 + t) * BR + col] = vn[t]; }
#pragma unroll
            for (int t = 0; t < 4; ++t) { float mx = b_spatial[g * CH + t];
#pragma unroll
                for (int s = 0; s < 4; ++s) if (s <= t) mx += w_spatial[(size_t)g * CH * CH + t * CH + s] * vn[s];
                const int row = MP + b * 4 + t; const bf16_t* zr = Z + (size_t)row * ZA;
                MIX[(size_t)row * MW + col] = (bf16_t)f2bf(bf2f(zr[col]) * mx); }
        }
        __syncthreads();
        {
            LAS float* parts = (LAS float*)(lds + RING_BYTES + 4096);
            if (wave < 4) { const int item = 2 * vcu + (wave >> 1); if (item < NB_S * NH) attn_sample_half(Z, ZA, 2 * BR, cache_k, cache_v, parts + wave * 576, parts + wave * 576, item, wave & 1, lane); }
            else { unsigned ep = 0; for (int u = vcu; u < NB_P * NH * 8; u += G, ++ep)
                       attn_prompt_unit4(Z, ZA, 2 * BR, 2 * BR + XA, KVBF, VTB, MIX, lds, (volatile LAS unsigned*)(lds + RING_BYTES + 2048 + 256), ep, u, tid - 256, wave - 4, lane); }
            __syncthreads();
            if (wave < 2) { const int item = 2 * vcu + wave; if (item < NB_S * NH) attn_sample_merge(Z, ZA, 2 * BR + XA, MIX, parts + (2 * wave) * 576, parts + (2 * wave + 1) * 576, item, lane); }
        }
    }
    SEAM(2);

    if constexpr (IN(3)) {
        pg8::MultiOrder S; S.init(MIX, Wout0, MP, D, MIX + (size_t)MP * MW, Wout0, MS, D, MW, G, bx, KSPLIT);
        EpiOutFused2 E{x_prompt, post_g, Y1, XN, SS0, SS2, ctl + CW_PANEL + 4096, ctl + CW_PANEL + 8192, PART, ctl + CW_SUB};
        pg8::gemm_phase<EpiOutFused2, pg8::MultiOrder, PG8_ALIGN, PG8_SP2>(lds, MW, S, E);
    }
    const bool fastseam = (G == 256);
    if constexpr (IN(3) && IN(4)) { if (!fastseam) xcd_barrier(bar); else if (bx < 64) { publish_wg(ctl + CW_SUB + 64 * (bx >> 5)); wait_subunits(ctl + CW_SUB + 64 * (bx >> 5), (D / 256) * KSPLIT); } } else SEAM(3);

    if constexpr (IN(4)) {
        constexpr int NR = 1;
        const int m_first = fastseam ? ((bx < 64) ? MP + (bx >> 5) * 256 + (bx & 31) * 8 + wave : M) : MP + gw, m_step = fastseam ? M : NR * NGW;
        for (int m0 = m_first; m0 < M; m0 += m_step) {
            f32x4 ov[NR][4], xv[NR][4]; float so[NR]; int mm[NR];
#pragma unroll
            for (int q = 0; q < NR; ++q) { const int m = m0 + q * NGW; mm[q] = m;
                if (m >= M) {
#pragma unroll
                    for (int j = 0; j < 4; ++j) { xv[q][j] = (f32x4){0.f, 0.f, 0.f, 0.f}; ov[q][j] = xv[q][j]; }
                    continue; }
                const float* xr = (m < MP) ? x_prompt + (size_t)m * D : x_sample + (size_t)(m - MP) * D;
#pragma unroll
                for (int j = 0; j < 4; ++j) { xv[q][j] = ((const f32x4*)xr)[lane + 64 * j];
                    if (m < MP) { const u32x2 w = ((const u32x2*)(OUT + (size_t)m * D))[lane + 64 * j]; ov[q][j] = (f32x4){__uint_as_float(w.x << 16), __uint_as_float(w.x & 0xffff0000u), __uint_as_float(w.y << 16), __uint_as_float(w.y & 0xffff0000u)}; }
                    else { ov[q][j] = (f32x4){0.f, 0.f, 0.f, 0.f};
#pragma unroll
                        for (int ks = 0; ks < KSPLIT; ++ks) ov[q][j] += ((const f32x4*)(PART + ((size_t)ks * MS + (m - MP)) * D))[lane + 64 * j]; } } }
#pragma unroll
            for (int q = 0; q < NR; ++q) { float a = 0.f;
#pragma unroll
                for (int j = 0; j < 4; ++j) a += (ov[q][j].x * ov[q][j].x + ov[q][j].y * ov[q][j].y) + (ov[q][j].z * ov[q][j].z + ov[q][j].w * ov[q][j].w);
                so[q] = a; }
#pragma unroll
            for (int q = 0; q < NR; ++q) so[q] = wave_sum(so[q]);
            float s1[NR];
#pragma unroll
            for (int q = 0; q < NR; ++q) { const float rs = 1.0f / sqrtf(so[q] * (1.f / D) + EPS); float a = 0.f;
#pragma unroll
                for (int j = 0; j < 4; ++j) { const f32x4 gv = ((const f32x4*)post_g)[lane + 64 * j]; const f32x4 v = xv[q][j] + ov[q][j] * rs * gv; xv[q][j] = v;
                    u32x2 w; w.x = pk2(v.x, v.y); w.y = pk2(v.z, v.w); if (mm[q] < M) ((u32x2*)(Y1 + (size_t)mm[q] * D))[lane + 64 * j] = w;
                    a += (v.x * v.x + v.y * v.y) + (v.z * v.z + v.w * v.w); }
                s1[q] = a; }
#pragma unroll
            for (int q = 0; q < NR; ++q) s1[q] = wave_sum(s1[q]);
#pragma unroll
            for (int q = 0; q < NR; ++q) { if (mm[q] >= M) continue; const float rs1 = 1.0f / sqrtf(s1[q] * (1.f / D) + EPS); unsigned long long* o8 = (unsigned long long*)(XN + (size_t)mm[q] * D) + lane;
#pragma unroll
                for (int j = 0; j < 4; ++j) o8[64 * j] = (unsigned long long)pk2(xv[q][j].x * rs1, xv[q][j].y * rs1) | ((unsigned long long)pk2(xv[q][j].z * rs1, xv[q][j].w * rs1) << 32); }
        }
    }
    SEAM(4);

    if constexpr (IN(5)) {
        pg8::MultiOrder S; S.init(XN, WinB, M, NBW, XN, WinB, 0, 0, D, G, bx);
        EpiInProj E{Z, NBW, VSTAT, BR / 256, BR / 256, (BR + XA) / 256, 1, 0.08838834764831845f, out + O_MK, out + O_MV, KVBF, VTB, 0};
        pg8::gemm_phase<EpiInProj, pg8::MultiOrder, PG8_ALIGN, PG8_SP2>(lds, D, S, E);
    }
    SEAM(5);

    if constexpr (IN(6)) {
        constexpr int NCA = SG * 4 - 256, NCB = 256 - NCA;
        const int slot = wave >> 2, pitem = vcu + 256 * slot, role = (slot == 0) ? (wave & 3) : ((wave + 2) & 3);
        LAS unsigned char* half = lds + slot * 65536;
        LAS unsigned char* wl = half + (wave & 3) * ((slot == 0) ? S5_IMG : 16384);
        volatile LAS unsigned* fl = (volatile LAS unsigned*)(lds + RING_BYTES + 2048 + slot * 64);
        if (pitem < SG * 4) {
            if (role == 0) { __builtin_amdgcn_s_setprio(3); s5_prod<0>(Z, BBT, LB, out + O_HPR, out + O_HPI, half, fl, pitem, lane); }
            else if (role == 1) { __builtin_amdgcn_s_setprio(3); s5_prod<1>(Z, BBT, LB, out + O_HPR, out + O_HPI, half, fl, pitem, lane); }
            else { __builtin_amdgcn_s_setprio(0); s5_cons(CTT, ssm_d, YG, half, fl, pitem, role - 2, lane); }
            __builtin_amdgcn_s_setprio(0);
        } else {
            for (int it = (vcu - NCA) + NCB * (wave - 4); it < NB_S * NH; it += 4 * NCB)
                attn_sample_item(Z, NBW, BR, BR + XA + BR, cache_k + (size_t)NB_S * NMEM * XA, cache_v + (size_t)NB_S * NMEM * XA, MIX, (LAS float*)wl, it, lane);
        }
        team_sync(fl + 8, 4u, lane);
        attn_prompt_unit_kv(Z, NBW, BR, BR + XA + BR, KVBF + 2ull * MMEM * XA, VTB + (size_t)NB_P * NH * HD * NMEM, MIX, half, fl + 9, 0u, vcu + 256 * slot, tid & 255, wave & 3, lane);
        {
            constexpr int N_SS = SG * 16 / 2, N_TG = (BR / 64) * (BR / 32) / 4, N_TO = (MW / 64) * (D / 32) / 4;
            LAS unsigned* wq = (LAS unsigned*)(lds + RING_BYTES + 2048 + 128);
            for (;;) {
                unsigned tk = 0; if (lane == 0) tk = __hip_atomic_fetch_add(wq, 1u, __ATOMIC_RELAXED, __HIP_MEMORY_SCOPE_WORKGROUP);
                const int it = __builtin_amdgcn_readfirstlane((int)tk) * 256 + vcu;
                if (it >= N_SS + N_TG + N_TO) break;
                if (it < N_SS) {
#pragma unroll 1
                    for (int q = 0; q < 2; ++q) s5_item<true>(Z, BBT, CTT, LB, ssm_d, st_re, st_im, out + O_HSR, out + O_HSI, YG, wl, 2 * it + q, lane); }
                else if (it < N_SS + N_TG) {
#pragma unroll 1
                    for (int q = 0; q < 4; ++q) p0_transpose_item(w_glu, nullptr, BR, BR, Wglu, 0, (LAS float*)wl, 4 * (it - N_SS) + q, lane); }
                else {
#pragma unroll 1
                    for (int q = 0; q < 4; ++q) p0_transpose_item(w_out + (size_t)MW * D, nullptr, MW, D, Wout1, 0, (LAS float*)wl, 4 * (it - N_SS - N_TG) + q, lane); }
            }
        }
    }
    SEAM(6);

    if constexpr (IN(8)) {
        pg8::MultiOrder S; S.init(YG, Wglu, M, BR, YG, Wglu, 0, 0, BR, G, bx);
        EpiGlu E{YG, Z, b_glu, MIX};
        pg8::gemm_phase<EpiGlu, pg8::MultiOrder, PG8_ALIGN, PG8_SP2>(lds, BR, S, E);
    }
    SEAM(8);

    if constexpr (IN(9)) {
        pg8::MultiOrder S; S.init(MIX, Wout1, MP, D, MIX + (size_t)MP * MW, Wout1, MS, D, MW, G, bx, KSPLIT);
        EpiOutFused E{Y1, post_g + D, out + O_Y, SS1, ctl + CW_PANEL, PART, ctl + CW_SUB + 128};
        pg8::gemm_phase<EpiOutFused, pg8::MultiOrder, PG8_ALIGN, PG8_SP2>(lds, MW, S, E);
    }
    if constexpr (IN(9) && IN(10)) { if (!fastseam) xcd_barrier(bar); else if (bx < 64) { publish_wg(ctl + CW_SUB + 128 + 64 * (bx >> 5)); wait_subunits(ctl + CW_SUB + 128 + 64 * (bx >> 5), (D / 256) * KSPLIT); } } else SEAM(9);

    if constexpr (IN(10)) {
        constexpr int NR = 1;
        const int m_first = fastseam ? ((bx < 64) ? MP + (bx >> 5) * 256 + (bx & 31) * 8 + wave : M) : MP + gw, m_step = fastseam ? M : NR * NGW;
        for (int m0 = m_first; m0 < M; m0 += m_step) {
            f32x4 ov[NR][4]; u32x2 yw[NR][4]; float so[NR]; int mm[NR];
#pragma unroll
            for (int q = 0; q < NR; ++q) { const int m = m0 + q * NGW; mm[q] = m;
                if (m >= M) {
#pragma unroll
                    for (int j = 0; j < 4; ++j) { ov[q][j] = (f32x4){0.f, 0.f, 0.f, 0.f}; yw[q][j] = (u32x2){0u, 0u}; }
                    continue; }
#pragma unroll
                for (int j = 0; j < 4; ++j) { yw[q][j] = ((const u32x2*)(Y1 + (size_t)m * D))[lane + 64 * j];
                    if (m < MP) { const u32x2 w = ((const u32x2*)(OUT + (size_t)m * D))[lane + 64 * j]; ov[q][j] = (f32x4){__uint_as_float(w.x << 16), __uint_as_float(w.x & 0xffff0000u), __uint_as_float(w.y << 16), __uint_as_float(w.y & 0xffff0000u)}; }
                    else { ov[q][j] = (f32x4){0.f, 0.f, 0.f, 0.f};
#pragma unroll
                        for (int ks = 0; ks < KSPLIT; ++ks) ov[q][j] += ((const f32x4*)(PART + ((size_t)ks * MS + (m - MP)) * D))[lane + 64 * j]; } } }
#pragma unroll
            for (int q = 0; q < NR; ++q) { float a = 0.f;
#pragma unroll
                for (int j = 0; j < 4; ++j) a += (ov[q][j].x * ov[q][j].x + ov[q][j].y * ov[q][j].y) + (ov[q][j].z * ov[q][j].z + ov[q][j].w * ov[q][j].w);
                so[q] = a; }
#pragma unroll
            for (int q = 0; q < NR; ++q) so[q] = wave_sum(so[q]);
#pragma unroll
            for (int q = 0; q < NR; ++q) { if (mm[q] >= M) continue; const float rs = 1.0f / sqrtf(so[q] * (1.f / D) + EPS);
#pragma unroll
                for (int j = 0; j < 4; ++j) { const f32x4 yv = {__uint_as_float(yw[q][j].x << 16), __uint_as_float(yw[q][j].x & 0xffff0000u), __uint_as_float(yw[q][j].y << 16), __uint_as_float(yw[q][j].y & 0xffff0000u)}, gv = ((const f32x4*)(post_g + D))[lane + 64 * j];
                    ((f32x4*)(out + O_Y + (size_t)mm[q] * D))[lane + 64 * j] = yv + ov[q][j] * rs * gv; } }
        }
    }
#undef IN
#undef SEAM
}
#undef x_prompt
#undef x_sample
#undef cache_k
#undef cache_v
#undef st_re
#undef st_im
#undef mem_prompt
#undef w_in_a
#undef ln_v_g
#undef ln_v_b
#undef w_spatial
#undef b_spatial
#undef w_in_b
#undef lam_re
#undef lam_im
#undef log_dt
#undef sb_re
#undef sb_im
#undef sc_re
#undef sc_im
#undef ssm_d
#undef w_glu
#undef b_glu
#undef mem_norm_g
#undef w_mem_k
#undef w_mem_v
#undef w_out
#undef pre_g
#undef post_g
#undef out
#undef WinA
#undef WinB
#undef Wglu
#undef Wout0
#undef Wout1
#undef Wmem
#undef MEMN
#undef KVBF
#undef VTB
#undef SMALL
#undef XN
#undef Z
#undef YG
#undef MIX
#undef OUT
#undef PART
#undef Y1
#undef VSTAT
#undef SS0
#undef SS1
#undef SS2
#undef LB
#undef BB
#undef BBT
#undef CTT

template <int LO, int HI> static bool prep_kernel() {
    return hipFuncSetAttribute((const void*)mega<LO, HI>, hipFuncAttributeMaxDynamicSharedMemorySize, LDS_BYTES) == hipSuccess;
}
template <int LO, int HI> static void launch_ph(int grid, hipStream_t stream, const Args& a) { hipLaunchKernelGGL((mega<LO, HI>), dim3(grid), dim3(NTHR), LDS_BYTES, stream, a); }
extern "C" void kernel_launch(void* const* d_in, const int* in_sizes, int n_in, void* d_out, int out_size, void* d_ws, size_t ws_size, hipStream_t stream) {
    static int grid = 0;
    if (grid == 0) {
        if (n_in != 29 || (size_t)out_size != O_END || ws_size < WS_END) { fprintf(stderr, "kernel_launch: unexpected shapes (n_in %d out %d ws %zu)\n", n_in, out_size, ws_size); grid = -1; return; }
        int dev = 0, cus = 0;
        if (hipGetDevice(&dev) != hipSuccess || hipDeviceGetAttribute(&cus, hipDeviceAttributeMultiprocessorCount, dev) != hipSuccess) { grid = -1; return; }
        bool ok = true;
#if MK_N_LAUNCHES == 1
        ok = prep_kernel<0, 11>();
        int per_cu = 0;
        if (hipOccupancyMaxActiveBlocksPerMultiprocessor(&per_cu, (const void*)mega<0, 11>, NTHR, LDS_BYTES) != hipSuccess || per_cu < 1) { fprintf(stderr, "kernel_launch: occupancy query says %d blocks per CU\n", per_cu); }
#else
        ok = prep_kernel<0, 1>() && prep_kernel<1, 2>() && prep_kernel<2, 3>() && prep_kernel<3, 4>() && prep_kernel<4, 5>() && prep_kernel<5, 6>() && prep_kernel<6, 7>() && prep_kernel<7, 8>() && prep_kernel<8, 9>() && prep_kernel<9, 10>() && prep_kernel<10, 11>();
#endif
        if (!ok) { fprintf(stderr, "kernel_launch: hipFuncSetAttribute failed\n"); grid = -1; return; }
        (void)hipGetLastError();
        grid = cus;
    }
    if (grid < 0) return;
    (void)hipMemsetAsync((char*)d_ws + WS_CTL, 0, CTL_ZERO_BYTES, stream);
    Args a{};
    for (int i = 0; i < 29; ++i) a.in[i] = (const float*)d_in[i];
    a.out = (float*)d_out; a.ws = (unsigned char*)d_ws;
#if MK_N_LAUNCHES == 1
    launch_ph<0, 11>(grid, stream, a);
#else
    launch_ph<0, 1>(grid, stream, a); launch_ph<1, 2>(grid, stream, a); launch_ph<2, 3>(grid, stream, a); launch_ph<3, 4>(grid, stream, a); launch_ph<4, 5>(grid, stream, a);
    launch_ph<5, 6>(grid, stream, a); launch_ph<6, 7>(grid, stream, a); launch_ph<7, 8>(grid, stream, a); launch_ph<8, 9>(grid, stream, a); launch_ph<9, 10>(grid, stream, a); launch_ph<10, 11>(grid, stream, a);
#endif
}
```

```cpp
#include <hip/hip_runtime.h>
#include <cstdio>
#include <cstdint>

#ifndef MK_N_LAUNCHES
#define MK_N_LAUNCHES 1
#endif

#define DI __device__ __forceinline__
#define GAS __attribute__((address_space(1)))
#define LAS __attribute__((address_space(3)))
typedef unsigned short bf16_t;
typedef short bf16x8 __attribute__((ext_vector_type(8)));
typedef float f32x4 __attribute__((ext_vector_type(4)));
typedef float f32x2 __attribute__((ext_vector_type(2)));
typedef unsigned u32x4 __attribute__((ext_vector_type(4)));
typedef unsigned u32x2 __attribute__((ext_vector_type(2)));

constexpr int D = 1024, NB_P = 8, T_P = 2048, MP = NB_P * T_P, NB_S = 128, T_S = 4, MS = NB_S * T_S, M = MP + MS;
constexpr int BR = 1536, XA = 512, MW = 2048, NA = 2 * BR + XA + MW  , NBW = BR + XA + MW  ;
constexpr int ZA = 2 * BR + 2 * XA;
constexpr int NMEM = 256, CH = 128, AG = 8, AD = 192, SG = 96, SC = 16, SP = 64, NH = 4, HD = 128;
constexpr int MMEM = NB_P * NMEM;
constexpr float EPS = 1e-6f;
constexpr size_t O_Y = 0, O_MK = (size_t)M * D, O_MV = O_MK + 2ull * MMEM * XA, O_HPR = O_MV + 2ull * MMEM * XA, O_HPI = O_HPR + (size_t)NB_P * SG * SP,
                 O_HSR = O_HPI + (size_t)NB_P * SG * SP, O_HSI = O_HSR + (size_t)NB_S * SG * SP, O_CV = O_HSI + (size_t)NB_S * SG * SP, O_END = O_CV + (size_t)MS * BR;
static_assert(O_END == 23953408ull, "output size");

constexpr size_t MiB = 1u << 20;
constexpr size_t WS_CTL = 0, CTL_ZERO_BYTES = 1 * MiB;
constexpr size_t WS_WINA = 2 * MiB;
constexpr size_t WS_WINB = 13 * MiB;
constexpr size_t WS_WGLU = 21 * MiB;
constexpr size_t WS_WOUT0 = 26 * MiB, WS_WOUT1 = 30 * MiB;
constexpr size_t WS_WMEM = 34 * MiB;
constexpr size_t WS_MEMN = 38 * MiB;
constexpr size_t WS_KVBF = 42 * MiB;
constexpr size_t WS_SMALL = 50 * MiB;
constexpr size_t WS_XN = 52 * MiB;
constexpr size_t WS_Z = 86 * MiB;
constexpr size_t WS_YG = WS_Z + (size_t)M * NBW * 2;
constexpr size_t WS_MIX = 268 * MiB;
constexpr size_t WS_OUT = 334 * MiB;
constexpr size_t WS_Y1 = 400 * MiB;
constexpr size_t WS_VT = 466 * MiB;
constexpr size_t WS_PART = 470 * MiB;
constexpr size_t WS_END = 486 * MiB;
static_assert(WS_Z + (size_t)M * NA * 2 <= WS_MIX && WS_YG + (size_t)M * BR * 2 <= WS_MIX && WS_XN + (size_t)M * D * 2 <= WS_Z, "ws map");
constexpr size_t SM_VSTAT = 0;
constexpr size_t SM_SS0 = SM_VSTAT + 2 * (size_t)M;
constexpr size_t SM_SS1 = SM_SS0 + M;
constexpr size_t SM_SS2 = SM_SS1 + M;
constexpr size_t SM_ZERO_END = SM_SS2 + M;
constexpr size_t SM_LB = SM_ZERO_END;
constexpr size_t SM_BB = SM_LB + (size_t)SG * SP * 2;
constexpr size_t SM_BBT = SM_BB + (size_t)SG * SP * SC * 2;
constexpr size_t SM_CT = SM_BBT + (size_t)SG * 128 * SC / 2;
constexpr size_t SM_END = SM_CT + (size_t)SG * 128 * SC / 2;
static_assert(SM_END * 4 <= 2 * MiB, "small region");
constexpr int CW_BAR = 4096;
constexpr int CW_SUB = 30720;
constexpr int CW_PANEL = 16384;
constexpr int KSPLIT = 8;

DI float bf2f(bf16_t v) { return __uint_as_float(((unsigned)v) << 16); }
DI unsigned f2bf(float f) { unsigned u = __float_as_uint(f); return (u + 0x7fffu + ((u >> 16) & 1u)) >> 16; }
DI unsigned pk2(float lo, float hi) { return f2bf(lo) | (f2bf(hi) << 16); }
DI float wave_sum(float v) {
#pragma unroll
    for (int o = 1; o < 64; o <<= 1) v += __shfl_xor(v, o);
    return v;
}
DI float wave_max(float v) {
#pragma unroll
    for (int o = 1; o < 64; o <<= 1) v = fmaxf(v, __shfl_xor(v, o));
    return v;
}
DI float gelu_tanh(float x) {
    const float t = x * (1.0f + 0.044715f * x * x);
    const float e = __builtin_amdgcn_exp2f(t * (-2.0f * 0.7978845608028654f * 1.4426950408889634f));
    return x * __builtin_amdgcn_rcpf(1.0f + e);
}
DI float silu_f(float x) { return x * __builtin_amdgcn_rcpf(1.0f + __builtin_amdgcn_exp2f(x * -1.4426950408889634f)); }
DI float sigmoid_f(float x) { return __builtin_amdgcn_rcpf(1.0f + __builtin_amdgcn_exp2f(x * -1.4426950408889634f)); }
#define LDS_WAIT() asm volatile("s_waitcnt lgkmcnt(0)" ::: "memory")
#define VM_WAIT() asm volatile("s_waitcnt vmcnt(0)" ::: "memory")

namespace pg8 {
constexpr int BM = 256, BK = 64, HALF = 128, HTB = HALF * BK * 2, STAGE_BYTES = 8 * HTB, NXCD = 8, WGM = 8;
__host__ __device__ __forceinline__ int lds_byte(int r, int c) { const int st = (r >> 4) * 2 + (c >> 5), rr = r & 15, cc = c & 31, ob = rr * 64 + cc * 2; return st * 1024 + (ob ^ (((ob >> 9) & 1) << 5)); }
__host__ __device__ __forceinline__ void stage_rc(int b, int& R, int& C) { const int st = b / 1024, sb = b % 1024, swz = sb ^ (((sb >> 9) & 1) << 5); R = (st >> 1) * 16 + swz / 64; C = (st & 1) * 32 + (swz % 64) / 2; }
__host__ __device__ __forceinline__ int perm32(int rho) { const int n = rho >> 4, i = rho & 15; return 8 * (i >> 2) + 4 * n + (i & 3); }

struct Unit { int pm, pn, gi, ks; };

struct MultiOrder {
    const bf16_t* A0; const bf16_t* B0; const bf16_t* A1; const bf16_t* B1;
    int nM0, nN0, nM1, nN1, n0, n1, ntot, G, c, KS, nt0, nt1, sf; size_t tstep, tstep1;
    DI void init(const bf16_t* a0, const bf16_t* b0, int M0, int N0, const bf16_t* a1, const bf16_t* b1, int M1, int N1, int K, int G_, int c_, int KS1 = 1) {
        A0 = a0; B0 = b0; A1 = a1; B1 = b1; nM0 = M0 / BM; nN0 = N0 / BM; nM1 = M1 / BM; nN1 = N1 / BM; n0 = nM0 * nN0; KS = KS1; n1 = nM1 * nN1 * KS1; ntot = n0 + n1; G = G_; c = c_; tstep = (size_t)BM * K * 2; tstep1 = tstep;
        nt0 = K / BK; nt1 = K / BK / KS1; sf = 0;
    }
    DI void init2k(const bf16_t* a0, const bf16_t* b0, int M0, int N0, int K0, const bf16_t* a1, const bf16_t* b1, int M1, int N1, int K1, int G_, int c_) {
        A0 = a0; B0 = b0; A1 = a1; B1 = b1; nM0 = M0 / BM; nN0 = N0 / BM; nM1 = M1 / BM; nN1 = N1 / BM; n0 = nM0 * nN0; KS = 1; n1 = nM1 * nN1; ntot = n0 + n1; G = G_; c = c_;
        tstep = (size_t)BM * K0 * 2; tstep1 = (size_t)BM * K1 * 2; nt0 = K0 / BK; nt1 = K1 / BK; sf = 1;
    }
    DI bool next(int i, Unit& u) const {
        const long L = (long)i * G + c; if (L >= ntot) return false;
        const int gi = sf ? ((L < n1) ? 1 : 0) : ((L >= n0) ? 1 : 0);
        const int w = gi ? (sf ? (int)L : (int)L - n0) : 0; const int ks1 = w % KS, t1 = w / KS, pn1 = t1 % (nN1 > 0 ? nN1 : 1), pm1 = t1 / (nN1 > 0 ? nN1 : 1);
        int wgid = gi ? 0 : (sf ? (int)L - n1 : (int)L); const int nM = nM0, nN = nN0, nwg = n0;
        { const int q = nwg / NXCD, r = nwg % NXCD, xcd = wgid % NXCD, off = wgid / NXCD; wgid = (xcd < r ? xcd * (q + 1) : r * (q + 1) + (xcd - r) * q) + off; }
        const int nig = WGM * nN, gid = wgid / nig, fm = gid * WGM, gsz = (nM - fm) < WGM ? (nM - fm) : WGM;
        const int pm0 = fm + ((wgid % nig) % gsz), pn0 = (wgid % nig) / gsz;
        u.pm = gi ? pm1 : pm0; u.pn = gi ? pn1 : pn0; u.gi = gi; u.ks = gi ? ks1 : 0; return true;
    }
    DI const char* baseA(const Unit& u) const { return (const char*)(u.gi ? A1 : A0) + (size_t)u.pm * (u.gi ? tstep1 : tstep) + (size_t)(u.ks * nt1) * (BK * 2); }
    DI const char* baseB(const Unit& u) const { return (const char*)(u.gi ? B1 : B0) + (size_t)u.pn * (u.gi ? tstep1 : tstep) + (size_t)(u.ks * nt1) * (BK * 2); }
    DI int ktiles(const Unit& u) const { return u.gi ? nt1 : nt0; }
};

DI unsigned cvt_pk_bf16(float lo, float hi) { unsigned r; asm volatile("v_cvt_pk_bf16_f32 %0, %1, %2" : "=v"(r) : "v"(lo), "v"(hi)); return r; }

template <class Epi, class Sched, bool ALIGN_EPI = false, bool SP2 = false>
DI void gemm_phase(LAS unsigned char* lds, const int K, const Sched& S, const Epi& E) {
    int tid_o = threadIdx.x; asm volatile("" : "+v"(tid_o));
    const int tid = tid_o, wid = __builtin_amdgcn_readfirstlane(tid >> 6), lane = tid & 63, wr = wid >> 2, wc = wid & 3, fr = lane & 15, fq = lane >> 4;
    unsigned voffA[2], voffB[2];
#pragma unroll
    for (int i = 0; i < 2; ++i) { int R, C; stage_rc(tid * 16 + i * 8192, R, C); const int Rb = Epi::PERM ? ((R & ~31) + perm32(R & 31)) : R;
        voffA[i] = (unsigned)(R * K + C) * 2u; voffB[i] = (unsigned)(Rb * K + C) * 2u; }
    const size_t kstep = (size_t)(BK * 2);
    const size_t hstep = (size_t)HALF * K * 2;
    const unsigned ldsw = (unsigned)wid * 1024u;
    const int aoff = lds_byte(wr * 64 + fr, fq * 8), boff = lds_byte(wc * 32 + fr, fq * 8);
#define PG8_SA(b, h) (((b) * 2 + (h)) * HTB)
#define PG8_SB(b, h) ((4 + (b) * 2 + (h)) * HTB)
#define PG8_STAGE(bufoff, gbase, voff) do { _Pragma("unroll") for (int _i = 0; _i < 2; ++_i) \
        __builtin_amdgcn_global_load_lds((const unsigned*)((const char*)(gbase) + (voff)[_i]), (LAS unsigned*)(lds + (bufoff) + ldsw + _i * 8192), 16, 0, 0); } while (0)
#define PG8_LDA(dst, b, h) do { _Pragma("unroll") for (int m = 0; m < 4; ++m) _Pragma("unroll") for (int k = 0; k < 2; ++k) dst[m][k] = *(const LAS bf16x8*)(lds + PG8_SA(b, h) + aoff + m * 2048 + k * 1024); } while (0)
#define PG8_LDB(dst, b, h) do { _Pragma("unroll") for (int n = 0; n < 2; ++n) _Pragma("unroll") for (int k = 0; k < 2; ++k) dst[n][k] = *(const LAS bf16x8*)(lds + PG8_SB(b, h) + boff + n * 2048 + k * 1024); } while (0)
#define PG8_MMA(ai, bj, At, Bt) do { __builtin_amdgcn_s_setprio(1); _Pragma("unroll") for (int m = 0; m < 4; ++m) _Pragma("unroll") for (int n = 0; n < 2; ++n) _Pragma("unroll") for (int k = 0; k < 2; ++k) \
        acc[ai][bj][m][n] = __builtin_amdgcn_mfma_f32_16x16x32_bf16(Bt[n][k], At[m][k], acc[ai][bj][m][n], 0, 0, 0); __builtin_amdgcn_s_setprio(0); } while (0)
#define PG8_WAIT_V(n) asm volatile("s_waitcnt vmcnt(" #n ")" ::: "memory")
#define PG8_WAIT_L(n) asm volatile("s_waitcnt lgkmcnt(" #n ")" ::: "memory")
#define PG8_BAR __builtin_amdgcn_s_barrier()
#define PG8_SCHED __builtin_amdgcn_sched_barrier(0)
    Unit cur, nxt; int ui = 0;
    if (!S.next(0, cur)) return;
    int nt = S.ktiles(cur);
    f32x4 acc[2][2][4][2];
#pragma unroll
    for (int a = 0; a < 2; ++a)
#pragma unroll
        for (int b = 0; b < 2; ++b)
#pragma unroll
            for (int m = 0; m < 4; ++m)
#pragma unroll
                for (int n = 0; n < 2; ++n) acc[a][b][m][n] = (f32x4){0.f, 0.f, 0.f, 0.f};
    bf16x8 At[4][2], B0[2][2], B1[2][2];
    const char* cA = S.baseA(cur); const char* cB = S.baseB(cur);
    if constexpr (SP2) {
        PG8_STAGE(PG8_SB(0, 0), cB, voffB); PG8_STAGE(PG8_SB(0, 1), cB + hstep, voffB); PG8_STAGE(PG8_SA(0, 0), cA, voffA); PG8_STAGE(PG8_SA(0, 1), cA + hstep, voffA);
        if (wr == 1) PG8_BAR;
        PG8_WAIT_V(2); PG8_BAR;
        PG8_STAGE(PG8_SB(1, 0), cB + kstep, voffB); PG8_STAGE(PG8_SA(1, 0), cA + kstep, voffA); PG8_STAGE(PG8_SB(1, 1), cB + hstep + kstep, voffB);
        PG8_WAIT_V(6); PG8_BAR;
    } else {
        PG8_STAGE(PG8_SB(0, 0), cB, voffB); PG8_STAGE(PG8_SA(0, 0), cA, voffA); PG8_STAGE(PG8_SB(0, 1), cB + hstep, voffB); PG8_STAGE(PG8_SA(0, 1), cA + hstep, voffA);
        if (wr == 1) PG8_BAR;
        PG8_WAIT_V(4); PG8_BAR;
        PG8_STAGE(PG8_SB(1, 0), cB + kstep, voffB); PG8_STAGE(PG8_SA(1, 0), cA + kstep, voffA); PG8_STAGE(PG8_SB(1, 1), cB + hstep + kstep, voffB);
        PG8_WAIT_V(6); PG8_BAR;
    }
    for (;;) {
        const bool has_next = S.next(ui + 1, nxt);
        const char* nA = has_next ? S.baseA(nxt) : cA; const char* nB = has_next ? S.baseB(nxt) : cB;
        for (int t = 0; t < nt; t += 2) {
            const bool last = (t == nt - 2);
            const char* a1 = cA + (size_t)(t + 1) * kstep;
            const char* a2 = last ? nA : cA + (size_t)(t + 2) * kstep; const char* b2 = last ? nB : cB + (size_t)(t + 2) * kstep;
            const char* a3 = a2 + kstep; const char* b3 = b2 + kstep;
            if constexpr (SP2) {
            PG8_LDB(B0, 0, 0); PG8_LDB(B1, 0, 1); PG8_SCHED; PG8_LDA(At, 0, 0); PG8_STAGE(PG8_SA(1, 1), a1 + hstep, voffA);
            PG8_WAIT_V(8); PG8_WAIT_L(0); PG8_BAR; PG8_MMA(0, 0, At, B0); PG8_MMA(0, 1, At, B1); PG8_BAR; PG8_SCHED;
            PG8_LDA(At, 0, 1); PG8_STAGE(PG8_SB(0, 0), b2, voffB); PG8_STAGE(PG8_SB(0, 1), b2 + hstep, voffB); PG8_STAGE(PG8_SA(0, 0), a2, voffA);
            PG8_WAIT_V(8); PG8_WAIT_L(0); PG8_BAR; PG8_MMA(1, 0, At, B0); PG8_MMA(1, 1, At, B1); PG8_BAR; PG8_SCHED;
            PG8_LDB(B0, 1, 0); PG8_LDB(B1, 1, 1); PG8_SCHED; PG8_LDA(At, 1, 0); PG8_STAGE(PG8_SA(0, 1), a2 + hstep, voffA);
            PG8_WAIT_V(8); PG8_WAIT_L(0); PG8_BAR; PG8_MMA(0, 0, At, B0); PG8_MMA(0, 1, At, B1); PG8_BAR; PG8_SCHED;
            PG8_LDA(At, 1, 1); PG8_STAGE(PG8_SB(1, 0), b3, voffB); PG8_STAGE(PG8_SB(1, 1), b3 + hstep, voffB); PG8_STAGE(PG8_SA(1, 0), a3, voffA);
            PG8_WAIT_V(8); PG8_WAIT_L(0); PG8_BAR; PG8_MMA(1, 0, At, B0); PG8_MMA(1, 1, At, B1); PG8_BAR; PG8_SCHED;
            } else {
            PG8_LDB(B0, 0, 0); PG8_SCHED; PG8_LDA(At, 0, 0); PG8_STAGE(PG8_SA(1, 1), a1 + hstep, voffA);
            PG8_WAIT_L(8); PG8_BAR; PG8_WAIT_L(0); PG8_MMA(0, 0, At, B0); PG8_BAR; PG8_SCHED;
            PG8_LDB(B1, 0, 1); PG8_STAGE(PG8_SB(0, 0), b2, voffB);
            PG8_BAR; PG8_WAIT_L(0); PG8_MMA(0, 1, At, B1); PG8_BAR;
            PG8_LDA(At, 0, 1); PG8_STAGE(PG8_SA(0, 0), a2, voffA);
            PG8_BAR; PG8_WAIT_L(0); PG8_MMA(1, 0, At, B0); PG8_BAR; PG8_SCHED;
            PG8_STAGE(PG8_SB(0, 1), b2 + hstep, voffB);
            PG8_WAIT_V(6); PG8_BAR; PG8_MMA(1, 1, At, B1); PG8_BAR;
            PG8_LDB(B0, 1, 0); PG8_SCHED; PG8_LDA(At, 1, 0); PG8_STAGE(PG8_SA(0, 1), a2 + hstep, voffA);
            PG8_WAIT_L(8); PG8_BAR; PG8_WAIT_L(0); PG8_MMA(0, 0, At, B0); PG8_BAR; PG8_SCHED;
            PG8_LDB(B1, 1, 1); PG8_STAGE(PG8_SB(1, 0), b3, voffB);
            PG8_BAR; PG8_WAIT_L(0); PG8_MMA(0, 1, At, B1); PG8_BAR;
            PG8_LDA(At, 1, 1); PG8_STAGE(PG8_SA(1, 0), a3, voffA);
            PG8_BAR; PG8_WAIT_L(0); PG8_MMA(1, 0, At, B0); PG8_BAR; PG8_SCHED;
            PG8_STAGE(PG8_SB(1, 1), b3 + hstep, voffB);
            PG8_WAIT_V(6); PG8_BAR; PG8_MMA(1, 1, At, B1); PG8_BAR;
            }
        }
        if constexpr (ALIGN_EPI) { if (wr == 0) PG8_BAR; }
        { int fr_ = fr, fq_ = fq; asm volatile("" : "+v"(fr_), "+v"(fq_)); E(acc, cur, wr, wc, fr_, fq_); }
        if (!has_next) break;
#pragma unroll
        for (int a = 0; a < 2; ++a)
#pragma unroll
            for (int b = 0; b < 2; ++b)
#pragma unroll
                for (int m = 0; m < 4; ++m)
#pragma unroll
                    for (int n = 0; n < 2; ++n) acc[a][b][m][n] = (f32x4){0.f, 0.f, 0.f, 0.f};
        cur = nxt; cA = nA; cB = nB; ++ui; nt = S.ktiles(cur);
        if constexpr (ALIGN_EPI) { if (wr == 1) PG8_BAR; }
    }
    PG8_WAIT_V(0);
    if constexpr (!ALIGN_EPI) { if (wr == 0) PG8_BAR; }
    PG8_BAR;
#undef PG8_SA
#undef PG8_SB
#undef PG8_STAGE
#undef PG8_LDA
#undef PG8_LDB
#undef PG8_MMA
#undef PG8_WAIT_V
#undef PG8_WAIT_L
#undef PG8_BAR
#undef PG8_SCHED
}
}
#ifndef PG8_SP2
#define PG8_SP2 true
#endif
#ifndef PG8_ALIGN
#define PG8_ALIGN true
#endif

struct EpiInProj {
    static constexpr bool PERM = true;
    bf16_t* Z; int ldz; float* vstat;
    int e_gelu, e_stat, e_q, q_is_raw;
    float qscale;
    float* out_mk; float* out_mv; bf16_t* kvbf; bf16_t* vtb; int fused_ug;
    DI void operator()(const f32x4 (&acc)[2][2][4][2], const pg8::Unit& u, int wr, int wc, int fr, int fq) const {
        const int row0 = u.pm * 256 + wr * 64 + fr, col0_ = u.pn * 256 + wc * 32 + 8 * fq;
        if (u.gi == 1) {
            const int n0 = u.pn * 256; const int layer = n0 >> 10, kv = (n0 >> 9) & 1, cb = (n0 & 511) + wc * 32 + 8 * fq;
            float* ob = (kv ? out_mv : out_mk) + (size_t)layer * MMEM * XA; bf16_t* kb = kvbf + (size_t)(layer * 2 + kv) * MMEM * XA;
#pragma unroll
            for (int ai = 0; ai < 2; ++ai)
#pragma unroll
                for (int m = 0; m < 4; ++m) { const size_t ro = (size_t)(row0 + ai * 128 + m * 16) * XA + cb;
#pragma unroll
                    for (int bj = 0; bj < 2; ++bj) { const f32x4 v0 = acc[ai][bj][m][0], v1 = acc[ai][bj][m][1];
                        *(f32x4*)(ob + ro + bj * 128) = v0; *(f32x4*)(ob + ro + bj * 128 + 4) = v1;
                        u32x4 w; w.x = pg8::cvt_pk_bf16(v0[0], v0[1]); w.y = pg8::cvt_pk_bf16(v0[2], v0[3]); w.z = pg8::cvt_pk_bf16(v1[0], v1[1]); w.w = pg8::cvt_pk_bf16(v1[2], v1[3]);
                        *(u32x4*)(kb + ro + bj * 128) = w;
                        if (kv) { const int rr = row0 + ai * 128 + m * 16, bb = rr >> 8, mm = rr & 255, cc = cb + bj * 128, hh = cc >> 7, d0 = cc & 127;
                            bf16_t* vt = vtb + ((size_t)((layer * NB_P + bb) * NH + hh) * HD + d0) * NMEM + mm;
#pragma unroll
                            for (int e = 0; e < 4; ++e) { vt[(size_t)e * NMEM] = (bf16_t)f2bf(v0[e]); vt[(size_t)(e + 4) * NMEM] = (bf16_t)f2bf(v1[e]); } } } }
            return;
        }
        if (fused_ug && u.pn < 12) {
            const int oc = u.pn * 128 + wc * 32 + 8 * fq;
#pragma unroll
            for (int ai = 0; ai < 2; ++ai)
#pragma unroll
                for (int m = 0; m < 4; ++m) { const int row = row0 + ai * 128 + m * 16; float o[8];
#pragma unroll
                    for (int e = 0; e < 4; ++e) { o[e] = gelu_tanh(acc[ai][0][m][0][e]) * silu_f(acc[ai][1][m][0][e]); o[4 + e] = gelu_tanh(acc[ai][0][m][1][e]) * silu_f(acc[ai][1][m][1][e]); }
                    u32x4 w; w.x = pg8::cvt_pk_bf16(o[0], o[1]); w.y = pg8::cvt_pk_bf16(o[2], o[3]); w.z = pg8::cvt_pk_bf16(o[4], o[5]); w.w = pg8::cvt_pk_bf16(o[6], o[7]);
                    *(u32x4*)(Z + (size_t)row * ldz + oc) = w; }
            return; }
        const int kind = (u.pn < e_gelu) ? (q_is_raw ? 0 : 1) : (u.pn < e_stat) ? 2 : (u.pn < e_q) ? 3 : 4;
        const int col0 = fused_ug ? (u.pn - 6) * 256 + wc * 32 + 8 * fq : col0_;
#pragma unroll
        for (int ai = 0; ai < 2; ++ai)
#pragma unroll
            for (int m = 0; m < 4; ++m) { const int row = row0 + ai * 128 + m * 16; bf16_t* rowp = Z + (size_t)row * ldz + col0; float s1 = 0.f, s2 = 0.f;
#pragma unroll
                for (int bj = 0; bj < 2; ++bj) { f32x4 v0 = acc[ai][bj][m][0], v1 = acc[ai][bj][m][1];
                    if (kind == 1 || kind == 2) {
#pragma unroll
                        for (int e = 0; e < 4; ++e) { v0[e] = gelu_tanh(v0[e]); v1[e] = gelu_tanh(v1[e]); }
                    } else if (kind == 3) { v0 = v0 * qscale; v1 = v1 * qscale; }
                    else if (kind == 4) {
#pragma unroll
                        for (int e = 0; e < 4; ++e) { v0[e] = silu_f(v0[e]); v1[e] = silu_f(v1[e]); }
                    }
                    if (kind == 2) {
#pragma unroll
                        for (int e = 0; e < 4; ++e) { s1 += v0[e] + v1[e]; s2 += v0[e] * v0[e] + v1[e] * v1[e]; }
                    }
                    u32x4 w; w.x = pg8::cvt_pk_bf16(v0[0], v0[1]); w.y = pg8::cvt_pk_bf16(v0[2], v0[3]); w.z = pg8::cvt_pk_bf16(v1[0], v1[1]); w.w = pg8::cvt_pk_bf16(v1[2], v1[3]);
                    *(u32x4*)(rowp + bj * 128) = w; }
                if (kind == 2) { s1 += __shfl_xor(s1, 16); s1 += __shfl_xor(s1, 32); s2 += __shfl_xor(s2, 16); s2 += __shfl_xor(s2, 32);
                    if (fq == 0) { atomicAdd(vstat + 2 * (size_t)row, s1); atomicAdd(vstat + 2 * (size_t)row + 1, s2); } }
            }
    }
};
struct EpiOut {
    static constexpr bool PERM = true;
    bf16_t* O; float* part;
    DI void operator()(const f32x4 (&acc)[2][2][4][2], const pg8::Unit& u, int wr, int wc, int fr, int fq) const {
        const int row0 = u.pm * 256 + wr * 64 + fr, col0 = u.pn * 256 + wc * 32 + 8 * fq;
        if (u.gi) { float* base = part + (size_t)u.ks * MS * D;
#pragma unroll
            for (int ai = 0; ai < 2; ++ai)
#pragma unroll
                for (int m = 0; m < 4; ++m) { const int row = row0 + ai * 128 + m * 16; float* rowp = base + (size_t)row * D + col0;
#pragma unroll
                    for (int bj = 0; bj < 2; ++bj) { *(f32x4*)(rowp + bj * 128) = acc[ai][bj][m][0]; *(f32x4*)(rowp + bj * 128 + 4) = acc[ai][bj][m][1]; } }
        } else {
#pragma unroll
            for (int ai = 0; ai < 2; ++ai)
#pragma unroll
                for (int m = 0; m < 4; ++m) { const int row = row0 + ai * 128 + m * 16; bf16_t* rowp = O + (size_t)row * D + col0;
#pragma unroll
                    for (int bj = 0; bj < 2; ++bj) { const f32x4 v0 = acc[ai][bj][m][0], v1 = acc[ai][bj][m][1];
                        u32x4 w; w.x = pg8::cvt_pk_bf16(v0[0], v0[1]); w.y = pg8::cvt_pk_bf16(v0[2], v0[3]); w.z = pg8::cvt_pk_bf16(v1[0], v1[1]); w.w = pg8::cvt_pk_bf16(v1[2], v1[3]);
                        *(u32x4*)(rowp + bj * 128) = w; } }
        }
    }
};
DI void st_wt(float* p, const f32x4 v) {
    __hip_atomic_store((unsigned long long*)p, (unsigned long long)__float_as_uint(v.x) | ((unsigned long long)__float_as_uint(v.y) << 32), __ATOMIC_RELAXED, __HIP_MEMORY_SCOPE_AGENT);
    __hip_atomic_store((unsigned long long*)(p + 2), (unsigned long long)__float_as_uint(v.z) | ((unsigned long long)__float_as_uint(v.w) << 32), __ATOMIC_RELAXED, __HIP_MEMORY_SCOPE_AGENT);
}
struct EpiOutFused {
    static constexpr bool PERM = true;
    const bf16_t* base; const float* gain; float* yout; float* ss; unsigned* cnt; float* part; unsigned* subdone;
    DI void operator()(const f32x4 (&acc)[2][2][4][2], const pg8::Unit& u, int wr, int wc, int fr, int fq) const {
        const int row0 = u.pm * 256 + wr * 64 + fr, col0 = u.pn * 256 + wc * 32 + 8 * fq;
        if (u.gi) { float* pb = part + (size_t)u.ks * MS * D;
#pragma unroll
            for (int ai = 0; ai < 2; ++ai)
#pragma unroll
                for (int m = 0; m < 4; ++m) { const int row = row0 + ai * 128 + m * 16; float* rowp = pb + (size_t)row * D + col0;
#pragma unroll
                    for (int bj = 0; bj < 2; ++bj) { *(f32x4*)(rowp + bj * 128) = acc[ai][bj][m][0]; *(f32x4*)(rowp + bj * 128 + 4) = acc[ai][bj][m][1]; } }
            return; }
#pragma unroll
        for (int ai = 0; ai < 2; ++ai)
#pragma unroll
            for (int m = 0; m < 4; ++m) { float s2 = 0.f;
#pragma unroll
                for (int bj = 0; bj < 2; ++bj) { const f32x4 v0 = acc[ai][bj][m][0], v1 = acc[ai][bj][m][1];
#pragma unroll
                    for (int e = 0; e < 4; ++e) s2 += v0[e] * v0[e] + v1[e] * v1[e]; }
                s2 += __shfl_xor(s2, 16); s2 += __shfl_xor(s2, 32);
                if (fq == 0) atomicAdd(ss + row0 + ai * 128 + m * 16, s2); }
        asm volatile("s_waitcnt vmcnt(0)" ::: "memory");
        unsigned* pc = cnt + 64 * u.pm;
        if (fr == 0 && fq == 0) __hip_atomic_fetch_add(pc, 1u, __ATOMIC_RELAXED, __HIP_MEMORY_SCOPE_AGENT);
        { unsigned sp = 0; while ((unsigned)__builtin_amdgcn_readfirstlane((int)__hip_atomic_load(pc, __ATOMIC_RELAXED, __HIP_MEMORY_SCOPE_AGENT)) < 32u) { __builtin_amdgcn_s_sleep(2); if (++sp > (1u << 22)) break; } }
        __builtin_amdgcn_fence(__ATOMIC_ACQUIRE, "agent");
        asm volatile("s_waitcnt vmcnt(0)" ::: "memory");
        f32x4 gv[2][2];
#pragma unroll
        for (int bj = 0; bj < 2; ++bj)
#pragma unroll
            for (int n = 0; n < 2; ++n) gv[bj][n] = *(const f32x4*)(gain + col0 + bj * 128 + 4 * n);
        float rsv[8];
#pragma unroll
        for (int k = 0; k < 8; ++k) rsv[k] = __hip_atomic_load(ss + row0 + (k >> 2) * 128 + (k & 3) * 16, __ATOMIC_RELAXED, __HIP_MEMORY_SCOPE_AGENT);
#pragma unroll
        for (int ai = 0; ai < 2; ++ai)
#pragma unroll
            for (int m = 0; m < 4; ++m) { const int row = row0 + ai * 128 + m * 16;
                const float rs = 1.0f / sqrtf(rsv[ai * 4 + m] * (1.f / D) + EPS);
#pragma unroll
                for (int bj = 0; bj < 2; ++bj) { const u32x4 bw = __builtin_nontemporal_load((const u32x4*)(base + (size_t)(u.pm * 4 + u.pn) * 65536 + (size_t)((wr * 4 + wc) * 512 + (fq * 16 + fr) * 8) + (size_t)(((ai * 4 + m) * 2 + bj) * 4096)));
                    const f32x4 b0 = {__uint_as_float(bw.x << 16), __uint_as_float(bw.x & 0xffff0000u), __uint_as_float(bw.y << 16), __uint_as_float(bw.y & 0xffff0000u)};
                    const f32x4 b1 = {__uint_as_float(bw.z << 16), __uint_as_float(bw.z & 0xffff0000u), __uint_as_float(bw.w << 16), __uint_as_float(bw.w & 0xffff0000u)};
                    float* op = yout + (size_t)row * D + col0 + bj * 128;
                    *(f32x4*)op = b0 + acc[ai][bj][m][0] * rs * gv[bj][0]; *(f32x4*)(op + 4) = b1 + acc[ai][bj][m][1] * rs * gv[bj][1]; } }
    }
};
struct EpiOutFused2 {
    static constexpr bool PERM = true;
    const float* xin; const float* gain; bf16_t* y1o; bf16_t* xn; float* ssa; float* ssb; unsigned* cnta; unsigned* cntb; float* part; unsigned* subdone;
    DI void operator()(const f32x4 (&accin)[2][2][4][2], const pg8::Unit& u, int wr, int wc, int fr, int fq) const {
        const int row0 = u.pm * 256 + wr * 64 + fr, col0 = u.pn * 256 + wc * 32 + 8 * fq;
        if (u.gi) { float* pb = part + (size_t)u.ks * MS * D;
#pragma unroll
            for (int ai = 0; ai < 2; ++ai)
#pragma unroll
                for (int m = 0; m < 4; ++m) { const int row = row0 + ai * 128 + m * 16; float* rowp = pb + (size_t)row * D + col0;
#pragma unroll
                    for (int bj = 0; bj < 2; ++bj) { *(f32x4*)(rowp + bj * 128) = accin[ai][bj][m][0]; *(f32x4*)(rowp + bj * 128 + 4) = accin[ai][bj][m][1]; } }
            return; }
        const size_t y1blk = (size_t)(u.pm * 4 + u.pn) * 65536 + (size_t)((wr * 4 + wc) * 512 + (fq * 16 + fr) * 8);
        f32x4 acc[2][2][4][2];
#pragma unroll
        for (int ai = 0; ai < 2; ++ai)
#pragma unroll
            for (int bj = 0; bj < 2; ++bj)
#pragma unroll
                for (int m = 0; m < 4; ++m)
#pragma unroll
                    for (int n = 0; n < 2; ++n) acc[ai][bj][m][n] = accin[ai][bj][m][n];
#pragma unroll
        for (int ai = 0; ai < 2; ++ai)
#pragma unroll
            for (int m = 0; m < 4; ++m) { float s2 = 0.f;
#pragma unroll
                for (int bj = 0; bj < 2; ++bj) { const f32x4 v0 = acc[ai][bj][m][0], v1 = acc[ai][bj][m][1];
#pragma unroll
                    for (int e = 0; e < 4; ++e) s2 += v0[e] * v0[e] + v1[e] * v1[e]; }
                s2 += __shfl_xor(s2, 16); s2 += __shfl_xor(s2, 32);
                if (fq == 0) atomicAdd(ssa + row0 + ai * 128 + m * 16, s2); }
        asm volatile("s_waitcnt vmcnt(0)" ::: "memory");
        unsigned* pa = cnta + 64 * u.pm; unsigned* pb2 = cntb + 64 * u.pm;
        if (fr == 0 && fq == 0) __hip_atomic_fetch_add(pa, 1u, __ATOMIC_RELAXED, __HIP_MEMORY_SCOPE_AGENT);
        { unsigned sp = 0; while ((unsigned)__builtin_amdgcn_readfirstlane((int)__hip_atomic_load(pa, __ATOMIC_RELAXED, __HIP_MEMORY_SCOPE_AGENT)) < 32u) { __builtin_amdgcn_s_sleep(2); if (++sp > (1u << 22)) break; } }
        __builtin_amdgcn_fence(__ATOMIC_ACQUIRE, "agent");
        asm volatile("s_waitcnt vmcnt(0)" ::: "memory");
        f32x4 gv[2][2];
#pragma unroll
        for (int bj = 0; bj < 2; ++bj)
#pragma unroll
            for (int n = 0; n < 2; ++n) gv[bj][n] = *(const f32x4*)(gain + col0 + bj * 128 + 4 * n);
        float rsv[8];
#pragma unroll
        for (int k = 0; k < 8; ++k) rsv[k] = __hip_atomic_load(ssa + row0 + (k >> 2) * 128 + (k & 3) * 16, __ATOMIC_RELAXED, __HIP_MEMORY_SCOPE_AGENT);
#pragma unroll
        for (int ai = 0; ai < 2; ++ai)
#pragma unroll
            for (int m = 0; m < 4; ++m) { const int row = row0 + ai * 128 + m * 16;
                const float rs = 1.0f / sqrtf(rsv[ai * 4 + m] * (1.f / D) + EPS);
                float s2 = 0.f;
#pragma unroll
                for (int bj = 0; bj < 2; ++bj) { const float* xp = xin + (size_t)row * D + col0 + bj * 128;
                    const f32x4 y0 = __builtin_nontemporal_load((const f32x4*)xp) + acc[ai][bj][m][0] * rs * gv[bj][0], y1v = __builtin_nontemporal_load((const f32x4*)(xp + 4)) + acc[ai][bj][m][1] * rs * gv[bj][1];
                    acc[ai][bj][m][0] = y0; acc[ai][bj][m][1] = y1v;
                    u32x4 w; w.x = pg8::cvt_pk_bf16(y0[0], y0[1]); w.y = pg8::cvt_pk_bf16(y0[2], y0[3]); w.z = pg8::cvt_pk_bf16(y1v[0], y1v[1]); w.w = pg8::cvt_pk_bf16(y1v[2], y1v[3]);
                    *(u32x4*)(y1o + y1blk + (size_t)(((ai * 4 + m) * 2 + bj) * 4096)) = w;
#pragma unroll
                    for (int e = 0; e < 4; ++e) s2 += y0[e] * y0[e] + y1v[e] * y1v[e]; }
                s2 += __shfl_xor(s2, 16); s2 += __shfl_xor(s2, 32);
                if (fq == 0) atomicAdd(ssb + row, s2); }
        asm volatile("s_waitcnt vmcnt(0)" ::: "memory");
        if (fr == 0 && fq == 0) __hip_atomic_fetch_add(pb2, 1u, __ATOMIC_RELAXED, __HIP_MEMORY_SCOPE_AGENT);
        { unsigned sp = 0; while ((unsigned)__builtin_amdgcn_readfirstlane((int)__hip_atomic_load(pb2, __ATOMIC_RELAXED, __HIP_MEMORY_SCOPE_AGENT)) < 32u) { __builtin_amdgcn_s_sleep(2); if (++sp > (1u << 22)) break; } }
#pragma unroll
        for (int k = 0; k < 8; ++k) rsv[k] = __hip_atomic_load(ssb + row0 + (k >> 2) * 128 + (k & 3) * 16, __ATOMIC_RELAXED, __HIP_MEMORY_SCOPE_AGENT);
#pragma unroll
        for (int ai = 0; ai < 2; ++ai)
#pragma unroll
            for (int m = 0; m < 4; ++m) { const int row = row0 + ai * 128 + m * 16;
                const float rs1 = 1.0f / sqrtf(rsv[ai * 4 + m] * (1.f / D) + EPS);
#pragma unroll
                for (int bj = 0; bj < 2; ++bj) { const f32x4 y0 = acc[ai][bj][m][0] * rs1, y1v = acc[ai][bj][m][1] * rs1;
                    u32x4 w; w.x = pg8::cvt_pk_bf16(y0[0], y0[1]); w.y = pg8::cvt_pk_bf16(y0[2], y0[3]); w.z = pg8::cvt_pk_bf16(y1v[0], y1v[1]); w.w = pg8::cvt_pk_bf16(y1v[2], y1v[3]);
                    *(u32x4*)(xn + (size_t)row * D + col0 + bj * 128) = w; } }
    }
};
struct EpiGlu {
    static constexpr bool PERM = true;
    const bf16_t* YG; const bf16_t* Z1; const float* bglu; bf16_t* MIX;
    DI void operator()(const f32x4 (&acc)[2][2][4][2], const pg8::Unit& u, int wr, int wc, int fr, int fq) const {
        const int row0 = u.pm * 256 + wr * 64 + fr, col0 = u.pn * 256 + wc * 32 + 8 * fq;
        f32x4 bv[2][2];
#pragma unroll
        for (int bj = 0; bj < 2; ++bj)
#pragma unroll
            for (int n = 0; n < 2; ++n) bv[bj][n] = *(const f32x4*)(bglu + col0 + bj * 128 + 4 * n);
#pragma unroll
        for (int ai = 0; ai < 2; ++ai)
#pragma unroll
            for (int m = 0; m < 4; ++m) { const int row = row0 + ai * 128 + m * 16;
#pragma unroll
                for (int bj = 0; bj < 2; ++bj) { const int col = col0 + bj * 128;
                    const u32x4 yg = *(const u32x4*)(YG + (size_t)row * BR + col); const u32x4 sg = *(const u32x4*)(Z1 + (size_t)row * NBW + (BR + XA) + col);
                    const f32x4 v0 = acc[ai][bj][m][0] + bv[bj][0], v1 = acc[ai][bj][m][1] + bv[bj][1];
                    float o[8]; const float a8[8] = {v0[0], v0[1], v0[2], v0[3], v1[0], v1[1], v1[2], v1[3]};
#pragma unroll
                    for (int e = 0; e < 4; ++e) { const unsigned yw = yg[e], sw = sg[e];
                        const float y0 = __uint_as_float(yw << 16), y1 = __uint_as_float(yw & 0xffff0000u), g0 = __uint_as_float(sw << 16), g1 = __uint_as_float(sw & 0xffff0000u);
                        o[2 * e] = y0 * sigmoid_f(a8[2 * e]) * g0; o[2 * e + 1] = y1 * sigmoid_f(a8[2 * e + 1]) * g1; }
                    u32x4 w; w.x = pg8::cvt_pk_bf16(o[0], o[1]); w.y = pg8::cvt_pk_bf16(o[2], o[3]); w.z = pg8::cvt_pk_bf16(o[4], o[5]); w.w = pg8::cvt_pk_bf16(o[6], o[7]);
                    *(u32x4*)(MIX + (size_t)row * MW + col) = w; } }
    }
};

#define XB_TMO      128
#define XB_XCNT(j)  (256  + 64 * (j))
#define XB_XSUB(j)  (1280 + 64 * (j))
#define XB_XGEN(j)  (2304 + 64 * (j))
#define XB_TOP      3328
#define XB_TOPGEN   3392
#define XCD_BAR_WORDS 3456
#define XB_SPIN_CAP (1u << 18)
DI unsigned xb_ld(unsigned* p)              { return __hip_atomic_load(p, __ATOMIC_RELAXED, __HIP_MEMORY_SCOPE_AGENT); }
DI unsigned xb_add(unsigned* p, unsigned v) { return __hip_atomic_fetch_add(p, v, __ATOMIC_RELAXED, __HIP_MEMORY_SCOPE_AGENT); }
DI unsigned xb_xcc_id() { return (unsigned)__builtin_amdgcn_s_getreg((3 << 11) | 20) & 0xFu; }
#define XB_SPIN(cond, bar) do { unsigned _sp = 0; while (cond) { __builtin_amdgcn_s_sleep(1); \
    if ((++_sp & 255u) == 0u) { if (xb_ld(&(bar)[XB_TMO])) break; if (_sp > XB_SPIN_CAP) { atomicAdd(&(bar)[XB_TMO], 1u); break; } } } } while (0)
struct XcdBarrier { unsigned* bar; unsigned x; volatile LAS unsigned* st; };
DI XcdBarrier xcd_barrier_post(unsigned* bar, volatile LAS unsigned* st) {
    XcdBarrier b; b.bar = bar; b.x = xb_xcc_id(); b.st = st;
    if (threadIdx.x == 0) (void)xb_add(&bar[XB_XCNT(b.x)], 1u);
    return b;
}
DI void xcd_barrier_complete(unsigned* bar, unsigned x, unsigned& nloc, unsigned& nx) {
    const unsigned G = gridDim.x * gridDim.y * gridDim.z;
    unsigned sum, cnt, mine, sp = 0u;
    for (;;) {
        sum = 0u; cnt = 0u; mine = 0u;
#pragma unroll
        for (unsigned j = 0; j < 16; ++j) { const unsigned c = xb_ld(&bar[XB_XCNT(j)]); sum += c; cnt += (c > 0u) ? 1u : 0u; mine = (j == x) ? c : mine; }
        if (sum == G) break;
        __builtin_amdgcn_s_sleep(1);
        if ((++sp & 255u) == 0u) { if (xb_ld(&bar[XB_TMO])) break; if (sp > XB_SPIN_CAP) { atomicAdd(&bar[XB_TMO], 1u); break; } }
    }
    nloc = mine > 0u ? mine : 1u; nx = cnt > 0u ? cnt : 1u;
}
DI void xcd_barrier(const XcdBarrier& b) {
    asm volatile("s_waitcnt vmcnt(0)" ::: "memory");
    __syncthreads();
    if (threadIdx.x == 0) {
        unsigned* bar = b.bar;
        __builtin_amdgcn_s_waitcnt(0);
        unsigned nloc = b.st[0], nx = b.st[1];
        if (nloc == 0u) { xcd_barrier_complete(bar, b.x, nloc, nx); b.st[0] = nloc; b.st[1] = nx; }
        const unsigned old = xb_add(&bar[XB_XSUB(b.x)], 1u);
        const unsigned gen = old / nloc;
        if (old + 1u == (gen + 1u) * nloc) {
            __builtin_amdgcn_fence(__ATOMIC_RELEASE, "agent");
            asm volatile("s_waitcnt vmcnt(0)" ::: "memory");
            const unsigned og = xb_add(&bar[XB_TOP], 1u);
            const unsigned tg = og / nx;
            if (og + 1u == (tg + 1u) * nx) xb_add(&bar[XB_TOPGEN], 1u);
            else XB_SPIN(xb_ld(&bar[XB_TOPGEN]) == tg, bar);
            __builtin_amdgcn_fence(__ATOMIC_ACQUIRE, "agent");
            xb_add(&bar[XB_XGEN(b.x)], 1u);
            asm volatile("s_waitcnt vmcnt(0)" ::: "memory");
        } else {
            XB_SPIN(xb_ld(&bar[XB_XGEN(b.x)]) == gen, bar);
            __builtin_amdgcn_fence(__ATOMIC_ACQUIRE, "agent");
            asm volatile("s_waitcnt vmcnt(0)" ::: "memory");
        }
    }
    __syncthreads();
}

DI void publish_wg(unsigned* cnt) {
    if (threadIdx.x == 0) {
        __builtin_amdgcn_fence(__ATOMIC_RELEASE, "agent");
        asm volatile("s_waitcnt vmcnt(0)" ::: "memory");
        __hip_atomic_fetch_add(cnt, 1u, __ATOMIC_RELAXED, __HIP_MEMORY_SCOPE_AGENT);
    }
}
DI void wait_subunits(unsigned* cnt, const unsigned need) {
    if (threadIdx.x == 0) { unsigned sp = 0;
        while (__hip_atomic_load(cnt, __ATOMIC_RELAXED, __HIP_MEMORY_SCOPE_AGENT) < need) { __builtin_amdgcn_s_sleep(2); if (++sp > (1u << 22)) break; }
        __builtin_amdgcn_fence(__ATOMIC_ACQUIRE, "agent");
        asm volatile("s_waitcnt vmcnt(0)" ::: "memory"); }
    __syncthreads();
}
struct Args {
    const float* in[29]; float* out; unsigned char* ws; int ph_lo, ph_hi, li, pad;
};
constexpr int NWAVES = 8, NTHR = NWAVES * 64;
constexpr int RING_BYTES = 131072, MISC_OFF = RING_BYTES + 320, LDS_BYTES = 147456;

DI void p0_transpose_item(const float* W, const float* gk, int K, int N, bf16_t* WT, int row_off, LAS float* scr, int item, int lane_in) {
    int lane_o = lane_in; asm volatile("" : "+v"(lane_o)); const int lane = lane_o;
    const int nblk = N / 32, kb = item / nblk, nb = item % nblk, k0 = 64 * kb, n0 = 32 * nb;
    const int kq = lane >> 3, c4 = 4 * (lane & 7);
    f32x4 v[8];
#pragma unroll
    for (int i = 0; i < 8; ++i) v[i] = __builtin_nontemporal_load((const f32x4*)(W + (size_t)(k0 + 8 * i + kq) * N + n0 + c4));
#pragma unroll
    for (int i = 0; i < 8; ++i) { const int kk = 8 * i + kq; const float gg = gk ? gk[k0 + kk] : 1.0f; LAS float* d = scr + kk * 33 + c4;
        d[0] = v[i].x * gg; d[1] = v[i].y * gg; d[2] = v[i].z * gg; d[3] = v[i].w * gg; }
    LDS_WAIT();
    const int c = lane & 7;
#pragma unroll
    for (int j = 0; j < 4; ++j) { const int n = (lane >> 3) + 8 * j; const LAS float* s = scr + (8 * c) * 33 + n;
        u32x4 o; o.x = pk2(s[0 * 33], s[1 * 33]); o.y = pk2(s[2 * 33], s[3 * 33]); o.z = pk2(s[4 * 33], s[5 * 33]); o.w = pk2(s[6 * 33], s[7 * 33]);
        *(u32x4*)(WT + (size_t)(row_off + n0 + n) * K + k0 + 8 * c) = o; }
    LDS_WAIT();
}
DI void rms_row_to_bf16(const float* xrow, bf16_t* orow, int lane) {
    const f32x4* xr = (const f32x4*)xrow + lane;
    f32x4 v[4]; float s = 0.f;
#pragma unroll
    for (int j = 0; j < 4; ++j) { v[j] = xr[64 * j]; s += (v[j].x * v[j].x + v[j].y * v[j].y) + (v[j].z * v[j].z + v[j].w * v[j].w); }
    const float rs = 1.0f / sqrtf(wave_sum(s) * (1.f / D) + EPS);
    unsigned long long* o8 = (unsigned long long*)orow + lane;
#pragma unroll
    for (int j = 0; j < 4; ++j) o8[64 * j] = (unsigned long long)pk2(v[j].x * rs, v[j].y * rs) | ((unsigned long long)pk2(v[j].z * rs, v[j].w * rs) << 32);
}

DI void attn_naive(const bf16_t* Zb, int ldz, int qoff, int goff, const bf16_t* kbf, const bf16_t* vbf, const float* ck, const float* cv, bf16_t* MIX, LAS float* wscr, int gw, int NGW, int lane) {
    LAS float* qs = wscr; LAS float* ps = wscr + 128;
    for (int item = MP * NH + gw; item < M * NH; item += NGW) {
        const int row = item >> 2, h = item & 3;
        const bf16_t* zr = Zb + (size_t)row * ldz;
        { const unsigned qw = *(const unsigned*)(zr + qoff + h * HD + 2 * lane); qs[2 * lane] = __uint_as_float(qw << 16); qs[2 * lane + 1] = __uint_as_float(qw & 0xffff0000u); }
        LDS_WAIT();
        float sc[4];
        if (row < MP) {
            const int b = row >> 11; const bf16_t* kb = kbf + (size_t)(b * NMEM) * XA + h * HD;
#pragma unroll
            for (int kk = 0; kk < 4; ++kk) { const bf16_t* kr = kb + (size_t)(lane + 64 * kk) * XA; float a = 0.f;
#pragma unroll 2
                for (int d8 = 0; d8 < 16; ++d8) { const u32x4 kw = *(const u32x4*)(kr + 8 * d8); const LAS float* q = qs + 8 * d8;
#pragma unroll
                    for (int e = 0; e < 4; ++e) { a += q[2 * e] * __uint_as_float(kw[e] << 16); a += q[2 * e + 1] * __uint_as_float(kw[e] & 0xffff0000u); } }
                sc[kk] = a; }
        } else {
            const int b = (row - MP) >> 2; const float* kb = ck + (size_t)(b * NMEM) * XA + h * HD;
#pragma unroll
            for (int kk = 0; kk < 4; ++kk) { const float* kr = kb + (size_t)(lane + 64 * kk) * XA; float a = 0.f;
#pragma unroll 4
                for (int d4 = 0; d4 < 32; ++d4) { const f32x4 kw = *(const f32x4*)(kr + 4 * d4); const LAS float* q = qs + 4 * d4;
                    a += q[0] * kw.x + q[1] * kw.y + q[2] * kw.z + q[3] * kw.w; }
                sc[kk] = a; }
        }
        const float mx = wave_max(fmaxf(fmaxf(sc[0], sc[1]), fmaxf(sc[2], sc[3])));
        float sum = 0.f;
#pragma unroll
        for (int kk = 0; kk < 4; ++kk) { const float p = __builtin_amdgcn_exp2f((sc[kk] - mx) * 1.4426950408889634f); sum += p; ps[lane + 64 * kk] = p; }
        sum = wave_sum(sum);
        LDS_WAIT();
        float o0 = 0.f, o1 = 0.f;
        if (row < MP) {
            const int b = row >> 11; const bf16_t* vb = vbf + (size_t)(b * NMEM) * XA + h * HD + 2 * lane;
#pragma unroll 8
            for (int m = 0; m < NMEM; ++m) { const unsigned vw = *(const unsigned*)(vb + (size_t)m * XA); const float p = ps[m]; o0 += p * __uint_as_float(vw << 16); o1 += p * __uint_as_float(vw & 0xffff0000u); }
        } else {
            const int b = (row - MP) >> 2; const float* vb = cv + (size_t)(b * NMEM) * XA + h * HD + 2 * lane;
#pragma unroll 8
            for (int m = 0; m < NMEM; ++m) { const f32x2 vw = *(const f32x2*)(vb + (size_t)m * XA); const float p = ps[m]; o0 += p * vw.x; o1 += p * vw.y; }
        }
        const float inv = 1.0f / sum;
        const unsigned gwd = *(const unsigned*)(zr + goff + h * HD + 2 * lane);
        o0 *= inv * __uint_as_float(gwd << 16); o1 *= inv * __uint_as_float(gwd & 0xffff0000u);
        *(unsigned*)(MIX + (size_t)row * MW + BR + h * HD + 2 * lane) = pk2(o0, o1);
        LDS_WAIT();
    }
}


typedef float f32x16 __attribute__((ext_vector_type(16)));
typedef __bf16 bf16x2_t __attribute__((ext_vector_type(2)));
DI unsigned cvtpk(float lo, float hi) { f32x2 v = {lo, hi}; bf16x2_t b = __builtin_convertvector(v, bf16x2_t); return __builtin_bit_cast(unsigned, b); }
DI void attn_prompt_unit(const bf16_t* Zb, const int ldz, const int qoff, const int goff, const bf16_t* Kpl, const bf16_t* VTl, bf16_t* MIXp, LAS unsigned char* lds, const int unit, const int tid_in, const int wave, const int lane_in) {
    const int b = unit >> 5, h = (unit >> 3) & 3, qb = unit & 7;
    __syncthreads();
    {
        int tid_o = tid_in; asm volatile("" : "+v"(tid_o)); const int tid = tid_o;
        const bf16_t* kg = Kpl + (size_t)(b * NMEM) * XA + h * HD;
        const bf16_t* vg = VTl + (size_t)((b * NH + h) * HD) * NMEM;
#pragma unroll
        for (int i = 0; i < 8; ++i) { const int cid = tid + NTHR * i; const int row = cid >> 4, c = cid & 15;
            const u32x4 v = *(const u32x4*)(kg + (size_t)row * XA + c * 8);
            *(LAS u32x4*)(lds + row * 256 + ((c ^ (row & 15)) << 4)) = v; }
#pragma unroll
        for (int i = 0; i < 8; ++i) { const int cid = tid + NTHR * i; const int row = cid >> 5, c = cid & 31;
            const u32x4 v = *(const u32x4*)(vg + (size_t)row * NMEM + c * 8);
            *(LAS u32x4*)(lds + 65536 + row * 512 + ((c ^ (row & 15)) << 4)) = v; }
    }
    __syncthreads();
    int lane_o = lane_in; asm volatile("" : "+v"(lane_o)); const int lane = lane_o;
    const int qi = lane & 31, hh = lane >> 5;
    const int row = b * T_P + qb * 256 + wave * 32 + qi;
    const bf16_t* zr = Zb + (size_t)row * ldz;
    bf16x8 qf[8];
#pragma unroll
    for (int ks = 0; ks < 8; ++ks) qf[ks] = *(const bf16x8*)(zr + qoff + h * HD + 16 * ks + 8 * hh);
    const int pi = (qi & ~12) | ((qi & 4) << 1) | ((qi & 8) >> 1);
    int kb[8];
#pragma unroll
    for (int ks = 0; ks < 8; ++ks) kb[ks] = pi * 256 + (((2 * ks + hh) ^ (pi & 15)) << 4);
    int vb[8];
#pragma unroll
    for (int j = 0; j < 8; ++j) vb[j] = 65536 + qi * 512 + (((2 * j + hh) ^ (qi & 15)) << 4);
    f32x16 sacc[8];
#pragma unroll
    for (int T = 0; T < 8; ++T) {
#pragma unroll
        for (int r = 0; r < 16; ++r) sacc[T][r] = 0.f;
#pragma unroll
        for (int ks = 0; ks < 8; ++ks) { const bf16x8 kf = *(const LAS bf16x8*)(lds + kb[ks] + T * 8192);
            sacc[T] = __builtin_amdgcn_mfma_f32_32x32x16_bf16(kf, qf[ks], sacc[T], 0, 0, 0); }
    }
    float mx = -3.0e38f;
#pragma unroll
    for (int T = 0; T < 8; ++T)
#pragma unroll
        for (int r = 0; r < 16; ++r) mx = fmaxf(mx, sacc[T][r]);
    mx = fmaxf(mx, __shfl_xor(mx, 32));
    float sum = 0.f;
#pragma unroll
    for (int T = 0; T < 8; ++T)
#pragma unroll
        for (int r = 0; r < 16; ++r) { const float p = __builtin_amdgcn_exp2f((sacc[T][r] - mx) * 1.4426950408889634f); sacc[T][r] = p; sum += p; }
    sum += __shfl_xor(sum, 32);
    const float inv = 1.0f / sum;
    f32x16 oacc[4];
#pragma unroll
    for (int dt = 0; dt < 4; ++dt)
#pragma unroll
        for (int r = 0; r < 16; ++r) oacc[dt][r] = 0.f;
#pragma unroll
    for (int T = 0; T < 8; ++T)
#pragma unroll
        for (int s2 = 0; s2 < 2; ++s2) {
            u32x4 pw; pw.x = cvtpk(sacc[T][8 * s2 + 0], sacc[T][8 * s2 + 1]); pw.y = cvtpk(sacc[T][8 * s2 + 2], sacc[T][8 * s2 + 3]);
            pw.z = cvtpk(sacc[T][8 * s2 + 4], sacc[T][8 * s2 + 5]); pw.w = cvtpk(sacc[T][8 * s2 + 6], sacc[T][8 * s2 + 7]);
            const bf16x8 pf = __builtin_bit_cast(bf16x8, pw);
#pragma unroll
            for (int dt = 0; dt < 4; ++dt) {
                const bf16x8 vf = *(const LAS bf16x8*)(lds + vb[(T & 3) * 2 + s2] + (T >> 2) * 256 + dt * 16384);
                oacc[dt] = __builtin_amdgcn_mfma_f32_32x32x16_bf16(vf, pf, oacc[dt], 0, 0, 0); }
        }
    bf16_t* mr = MIXp + (size_t)row * MW + BR + h * HD;
#pragma unroll
    for (int dt = 0; dt < 4; ++dt)
#pragma unroll
        for (int g4 = 0; g4 < 4; ++g4) { const int d0 = 32 * dt + 8 * g4 + 4 * hh;
            const u32x2 gw2 = *(const u32x2*)(zr + goff + h * HD + d0);
            const float o0 = oacc[dt][4 * g4 + 0] * inv * __uint_as_float(gw2.x << 16), o1 = oacc[dt][4 * g4 + 1] * inv * __uint_as_float(gw2.x & 0xffff0000u);
            const float o2 = oacc[dt][4 * g4 + 2] * inv * __uint_as_float(gw2.y << 16), o3 = oacc[dt][4 * g4 + 3] * inv * __uint_as_float(gw2.y & 0xffff0000u);
            u32x2 w; w.x = cvtpk(o0, o1); w.y = cvtpk(o2, o3);
            *(u32x2*)(mr + d0) = w; }
}

DI void team_sync(volatile LAS unsigned* ctr, const unsigned target, const int lane) {
    LDS_WAIT();
    if (lane == 0) __hip_atomic_fetch_add((LAS unsigned*)ctr, 1u, __ATOMIC_RELAXED, __HIP_MEMORY_SCOPE_WORKGROUP);
    while (*ctr < target) { __builtin_amdgcn_s_sleep(1); }
    asm volatile("" ::: "memory");
}
DI void attn_prompt_unit4(const bf16_t* Zb, const int ldz, const int qoff, const int goff, const bf16_t* Kpl, const bf16_t* VTl, bf16_t* MIXp, LAS unsigned char* lds, volatile LAS unsigned* ctr, const unsigned epoch,
                          const int unit, const int t4_in, const int w4, const int lane_in) {
    const int b = unit >> 5, h = (unit >> 3) & 3, qb = unit & 7;
    {
        int t4_o = t4_in; asm volatile("" : "+v"(t4_o)); const int t4 = t4_o;
        const bf16_t* kg = Kpl + (size_t)(b * NMEM) * XA + h * HD;
        const bf16_t* vg = VTl + (size_t)((b * NH + h) * HD) * NMEM;
#pragma unroll
        for (int half = 0; half < 2; ++half) {
            u32x4 v[8];
#pragma unroll
            for (int i = 0; i < 8; ++i) { const int cid = t4 + 256 * (8 * half + i); const int row = cid >> 4, c = cid & 15; v[i] = *(const u32x4*)(kg + (size_t)row * XA + c * 8); }
#pragma unroll
            for (int i = 0; i < 8; ++i) { const int cid = t4 + 256 * (8 * half + i); const int row = cid >> 4, c = cid & 15; *(LAS u32x4*)(lds + row * 256 + ((c ^ (row & 15)) << 4)) = v[i]; }
        }
#pragma unroll
        for (int half = 0; half < 2; ++half) {
            u32x4 v[8];
#pragma unroll
            for (int i = 0; i < 8; ++i) { const int cid = t4 + 256 * (8 * half + i); const int row = cid >> 5, c = cid & 31; v[i] = *(const u32x4*)(vg + (size_t)row * NMEM + c * 8); }
#pragma unroll
            for (int i = 0; i < 8; ++i) { const int cid = t4 + 256 * (8 * half + i); const int row = cid >> 5, c = cid & 31; *(LAS u32x4*)(lds + 65536 + row * 512 + ((c ^ (row & 15)) << 4)) = v[i]; }
        }
    }
    team_sync(ctr, 8u * epoch + 4u, lane_in);
#pragma unroll 1
    for (int j = 0; j < 2; ++j) {
        int lane_o = lane_in; asm volatile("" : "+v"(lane_o)); const int lane = lane_o;
        const int qi = lane & 31, hh = lane >> 5;
        const int row = b * T_P + qb * 256 + (w4 + 4 * j) * 32 + qi;
        const bf16_t* zr = Zb + (size_t)row * ldz;
        bf16x8 qf[8];
#pragma unroll
        for (int ks = 0; ks < 8; ++ks) qf[ks] = *(const bf16x8*)(zr + qoff + h * HD + 16 * ks + 8 * hh);
        const int pi = (qi & ~12) | ((qi & 4) << 1) | ((qi & 8) >> 1);
        const int kbase = pi * 256, kx = pi & 15, vbase = 65536 + qi * 512, vx = qi & 15;
        f32x16 sacc[8];
#define AU_LDK(KF, T) do { _Pragma("unroll") for (int ks = 0; ks < 8; ++ks) KF[ks] = *(const LAS bf16x8*)(lds + kbase + (((2 * ks + hh) ^ kx) << 4) + (T) * 8192); } while (0)
#define AU_QK(KF, T) do { _Pragma("unroll") for (int r = 0; r < 16; ++r) sacc[T][r] = 0.f; \
            _Pragma("unroll") for (int ks = 0; ks < 8; ++ks) sacc[T] = __builtin_amdgcn_mfma_f32_32x32x16_bf16(KF[ks], qf[ks], sacc[T], 0, 0, 0); } while (0)
        { bf16x8 kfA[8], kfB[8];
          AU_LDK(kfA, 0);
#pragma unroll
          for (int T = 0; T < 8; T += 2) {
              AU_LDK(kfB, T + 1); __builtin_amdgcn_sched_barrier(0); AU_QK(kfA, T); __builtin_amdgcn_sched_barrier(0);
              if (T + 2 < 8) AU_LDK(kfA, T + 2);
              __builtin_amdgcn_sched_barrier(0); AU_QK(kfB, T + 1); __builtin_amdgcn_sched_barrier(0);
          } }
#undef AU_QK
#undef AU_LDK
        float mx = -3.0e38f;
#pragma unroll
        for (int T = 0; T < 8; ++T)
#pragma unroll
            for (int r = 0; r < 16; ++r) mx = fmaxf(mx, sacc[T][r]);
        mx = fmaxf(mx, __shfl_xor(mx, 32));
        float sum = 0.f;
#pragma unroll
        for (int T = 0; T < 8; ++T)
#pragma unroll
            for (int r = 0; r < 16; ++r) { const float p = __builtin_amdgcn_exp2f((sacc[T][r] - mx) * 1.4426950408889634f); sacc[T][r] = p; sum += p; }
        sum += __shfl_xor(sum, 32);
        const float inv = 1.0f / sum;
        f32x16 oacc[4];
#pragma unroll
        for (int dt = 0; dt < 4; ++dt)
#pragma unroll
            for (int r = 0; r < 16; ++r) oacc[dt][r] = 0.f;
#define AU_LDV(VF, TS) do { _Pragma("unroll") for (int dt = 0; dt < 4; ++dt) VF[dt] = *(const LAS bf16x8*)(lds + vbase + (((2 * ((((TS) >> 1) & 3) * 2 + ((TS) & 1)) + hh) ^ vx) << 4) + ((TS) >> 3) * 256 + dt * 16384); } while (0)
#define AU_PV(VF, TS) do { const int T_ = (TS) >> 1, s2_ = (TS) & 1; \
            u32x4 pw; pw.x = cvtpk(sacc[T_][8 * s2_ + 0], sacc[T_][8 * s2_ + 1]); pw.y = cvtpk(sacc[T_][8 * s2_ + 2], sacc[T_][8 * s2_ + 3]); \
            pw.z = cvtpk(sacc[T_][8 * s2_ + 4], sacc[T_][8 * s2_ + 5]); pw.w = cvtpk(sacc[T_][8 * s2_ + 6], sacc[T_][8 * s2_ + 7]); \
            const bf16x8 pf = __builtin_bit_cast(bf16x8, pw); \
            _Pragma("unroll") for (int dt = 0; dt < 4; ++dt) oacc[dt] = __builtin_amdgcn_mfma_f32_32x32x16_bf16(VF[dt], pf, oacc[dt], 0, 0, 0); } while (0)
        { bf16x8 vfA[4], vfB[4];
          AU_LDV(vfA, 0);
#pragma unroll
          for (int ts = 0; ts < 16; ts += 2) {
              AU_LDV(vfB, ts + 1); __builtin_amdgcn_sched_barrier(0); AU_PV(vfA, ts); __builtin_amdgcn_sched_barrier(0);
              if (ts + 2 < 16) AU_LDV(vfA, ts + 2);
              __builtin_amdgcn_sched_barrier(0); AU_PV(vfB, ts + 1); __builtin_amdgcn_sched_barrier(0);
          } }
#undef AU_PV
#undef AU_LDV
        bf16_t* mr = MIXp + (size_t)row * MW + BR + h * HD;
#pragma unroll
        for (int dt = 0; dt < 4; ++dt)
#pragma unroll
            for (int g4 = 0; g4 < 4; ++g4) { const int d0 = 32 * dt + 8 * g4 + 4 * hh;
                const u32x2 gw2 = *(const u32x2*)(zr + goff + h * HD + d0);
                const float o0 = oacc[dt][4 * g4 + 0] * inv * __uint_as_float(gw2.x << 16), o1 = oacc[dt][4 * g4 + 1] * inv * __uint_as_float(gw2.x & 0xffff0000u);
                const float o2 = oacc[dt][4 * g4 + 2] * inv * __uint_as_float(gw2.y << 16), o3 = oacc[dt][4 * g4 + 3] * inv * __uint_as_float(gw2.y & 0xffff0000u);
                u32x2 w; w.x = cvtpk(o0, o1); w.y = cvtpk(o2, o3);
                *(u32x2*)(mr + d0) = w; }
    }
    team_sync(ctr, 8u * epoch + 8u, lane_in);
}

DI void attn_prompt_unit_kv(const bf16_t* Zb, const int ldz, const int qoff, const int goff, const bf16_t* Kpl, const bf16_t* VTl, bf16_t* MIXp, LAS unsigned char* buf, volatile LAS unsigned* ctr, const unsigned epoch,
                            const int unit, const int t4_in, const int w4, const int lane_in) {
    const int b = unit >> 6, h = (unit >> 4) & 3, qb = unit & 15;
    int t4_o = t4_in, lane_o = lane_in; asm volatile("" : "+v"(t4_o), "+v"(lane_o)); const int t4 = t4_o, lane = lane_o;
    {   const bf16_t* kg = Kpl + (size_t)(b * NMEM) * XA + h * HD;
#pragma unroll
        for (int half = 0; half < 2; ++half) {
            u32x4 v[8];
#pragma unroll
            for (int i = 0; i < 8; ++i) { const int cid = t4 + 256 * (8 * half + i); const int row = cid >> 4, c = cid & 15; v[i] = *(const u32x4*)(kg + (size_t)row * XA + c * 8); }
#pragma unroll
            for (int i = 0; i < 8; ++i) { const int cid = t4 + 256 * (8 * half + i); const int row = cid >> 4, c = cid & 15; *(LAS u32x4*)(buf + row * 256 + ((c ^ (row & 15)) << 4)) = v[i]; }
        }
    }
    team_sync(ctr, 16u * epoch + 4u, lane);
    const int qi = lane & 31, hh = lane >> 5;
    const int row = b * T_P + qb * 128 + w4 * 32 + qi;
    const bf16_t* zr = Zb + (size_t)row * ldz;
    f32x16 sacc[8];
    {
        bf16x8 qf[8];
#pragma unroll
        for (int ks = 0; ks < 8; ++ks) qf[ks] = *(const bf16x8*)(zr + qoff + h * HD + 16 * ks + 8 * hh);
        const int pi = (qi & ~12) | ((qi & 4) << 1) | ((qi & 8) >> 1);
        const int kbase = pi * 256, kx = pi & 15;
#define AU_LDK(KF, T) do { _Pragma("unroll") for (int ks = 0; ks < 8; ++ks) KF[ks] = *(const LAS bf16x8*)(buf + kbase + (((2 * ks + hh) ^ kx) << 4) + (T) * 8192); } while (0)
#define AU_QK(KF, T) do { _Pragma("unroll") for (int r = 0; r < 16; ++r) sacc[T][r] = 0.f; \
            _Pragma("unroll") for (int ks = 0; ks < 8; ++ks) sacc[T] = __builtin_amdgcn_mfma_f32_32x32x16_bf16(KF[ks], qf[ks], sacc[T], 0, 0, 0); } while (0)
        { bf16x8 kfA[8], kfB[8];
          AU_LDK(kfA, 0);
#pragma unroll
          for (int T = 0; T < 8; T += 2) {
              AU_LDK(kfB, T + 1); __builtin_amdgcn_sched_barrier(0); AU_QK(kfA, T); __builtin_amdgcn_sched_barrier(0);
              if (T + 2 < 8) AU_LDK(kfA, T + 2);
              __builtin_amdgcn_sched_barrier(0); AU_QK(kfB, T + 1); __builtin_amdgcn_sched_barrier(0);
          } }
#undef AU_QK
#undef AU_LDK
    }
    team_sync(ctr, 16u * epoch + 8u, lane);
    {   const bf16_t* vg = VTl + (size_t)((b * NH + h) * HD) * NMEM;
#pragma unroll
        for (int half = 0; half < 2; ++half) {
            u32x4 v[8];
#pragma unroll
            for (int i = 0; i < 8; ++i) { const int cid = t4 + 256 * (8 * half + i); const int rw = cid >> 5, c = cid & 31; v[i] = *(const u32x4*)(vg + (size_t)rw * NMEM + c * 8); }
#pragma unroll
            for (int i = 0; i < 8; ++i) { const int cid = t4 + 256 * (8 * half + i); const int rw = cid >> 5, c = cid & 31; *(LAS u32x4*)(buf + rw * 512 + ((c ^ (rw & 15)) << 4)) = v[i]; }
        }
    }
    float mx = -3.0e38f;
#pragma unroll
    for (int T = 0; T < 8; ++T)
#pragma unroll
        for (int r = 0; r < 16; ++r) mx = fmaxf(mx, sacc[T][r]);
    mx = fmaxf(mx, __shfl_xor(mx, 32));
    float sum = 0.f;
#pragma unroll
    for (int T = 0; T < 8; ++T)
#pragma unroll
        for (int r = 0; r < 16; ++r) { const float p = __builtin_amdgcn_exp2f((sacc[T][r] - mx) * 1.4426950408889634f); sacc[T][r] = p; sum += p; }
    sum += __shfl_xor(sum, 32);
    const float inv = 1.0f / sum;
    team_sync(ctr, 16u * epoch + 12u, lane);
    f32x16 oacc[4];
#pragma unroll
    for (int dt = 0; dt < 4; ++dt)
#pragma unroll
        for (int r = 0; r < 16; ++r) oacc[dt][r] = 0.f;
    const int vbase = qi * 512, vx = qi & 15;
#define AU_LDV(VF, TS) do { _Pragma("unroll") for (int dt = 0; dt < 4; ++dt) VF[dt] = *(const LAS bf16x8*)(buf + vbase + (((2 * ((((TS) >> 1) & 3) * 2 + ((TS) & 1)) + hh) ^ vx) << 4) + ((TS) >> 3) * 256 + dt * 16384); } while (0)
#define AU_PV(VF, TS) do { const int T_ = (TS) >> 1, s2_ = (TS) & 1; \
            u32x4 pw; pw.x = cvtpk(sacc[T_][8 * s2_ + 0], sacc[T_][8 * s2_ + 1]); pw.y = cvtpk(sacc[T_][8 * s2_ + 2], sacc[T_][8 * s2_ + 3]); \
            pw.z = cvtpk(sacc[T_][8 * s2_ + 4], sacc[T_][8 * s2_ + 5]); pw.w = cvtpk(sacc[T_][8 * s2_ + 6], sacc[T_][8 * s2_ + 7]); \
            const bf16x8 pf = __builtin_bit_cast(bf16x8, pw); \
            _Pragma("unroll") for (int dt = 0; dt < 4; ++dt) oacc[dt] = __builtin_amdgcn_mfma_f32_32x32x16_bf16(VF[dt], pf, oacc[dt], 0, 0, 0); } while (0)
        { bf16x8 vfA[4], vfB[4];
          AU_LDV(vfA, 0);
#pragma unroll
          for (int ts = 0; ts < 16; ts += 2) {
              AU_LDV(vfB, ts + 1); __builtin_amdgcn_sched_barrier(0); AU_PV(vfA, ts); __builtin_amdgcn_sched_barrier(0);
              if (ts + 2 < 16) AU_LDV(vfA, ts + 2);
              __builtin_amdgcn_sched_barrier(0); AU_PV(vfB, ts + 1); __builtin_amdgcn_sched_barrier(0);
          } }
#undef AU_PV
#undef AU_LDV
    team_sync(ctr, 16u * epoch + 16u, lane);
    bf16_t* mr = MIXp + (size_t)row * MW + BR + h * HD;
#pragma unroll
    for (int dt = 0; dt < 4; ++dt)
#pragma unroll
        for (int g4 = 0; g4 < 4; ++g4) { const int d0 = 32 * dt + 8 * g4 + 4 * hh;
            const u32x2 gw2 = *(const u32x2*)(zr + goff + h * HD + d0);
            const float o0 = oacc[dt][4 * g4 + 0] * inv * __uint_as_float(gw2.x << 16), o1 = oacc[dt][4 * g4 + 1] * inv * __uint_as_float(gw2.x & 0xffff0000u);
            const float o2 = oacc[dt][4 * g4 + 2] * inv * __uint_as_float(gw2.y << 16), o3 = oacc[dt][4 * g4 + 3] * inv * __uint_as_float(gw2.y & 0xffff0000u);
            u32x2 w; w.x = cvtpk(o0, o1); w.y = cvtpk(o2, o3);
            *(u32x2*)(mr + d0) = w; }
}

typedef short s16x4 __attribute__((ext_vector_type(4)));
DI s16x4 tr_read16(const LAS unsigned char* p) { return __builtin_amdgcn_ds_read_tr16_b64_v4i16((LAS s16x4*)p); }
template <bool SAMPLE>
DI void s5_item(const bf16_t* Z1, const bf16_t* bbt, const bf16_t* ctt, const float* lbt, const float* dvec, const float* h0re, const float* h0im, float* hout_re, float* hout_im, bf16_t* YGp,
                LAS unsigned char* img, const int item, const int lane_in) {
    int lane_o = lane_in; asm volatile("" : "+v"(lane_o)); const int lane = lane_o;
    const int n = lane & 31, hh = lane >> 5, i16 = lane & 15, G4 = lane >> 4;
    const int g = SAMPLE ? item >> 4 : item >> 2, sub = SAMPLE ? (item & 15) : (item & 3);
    bf16x8 bfrag[4], cfrag[4];
#pragma unroll
    for (int j = 0; j < 4; ++j) { bfrag[j] = *(const bf16x8*)(bbt + ((size_t)g * 128 + 32 * j + n) * SC + 8 * hh); cfrag[j] = *(const bf16x8*)(ctt + ((size_t)g * SC + i16) * 128 + 32 * j + 8 * G4); }
    bf16x8 ifrag;
#pragma unroll
    for (int e = 0; e < 8; ++e) ifrag[e] = (n == 8 * hh + e) ? (short)0x3f80 : (short)0;
    bf16x8 dfrag; { const float dv = dvec[g * SC + i16];
#pragma unroll
        for (int e = 0; e < 8; ++e) dfrag[e] = (8 * G4 + e == i16) ? (short)f2bf(dv) : (short)0; }
    const float lbr0 = lbt[2 * (g * SP + n)], lbi0 = lbt[2 * (g * SP + n) + 1], lbr1 = lbt[2 * (g * SP + 32 + n)], lbi1 = lbt[2 * (g * SP + 32 + n) + 1];
    const int ha = (n >> 2) & 1, ra = (n & 3) + 4 * (n >> 3);
    int rowA, rowE[2];
    if (SAMPLE) { rowA = MP + (8 * sub + 4 * ha + (ra >> 2)) * T_S + (ra & 3); }
    else { rowA = (2 * sub + ha) * T_P + ra; }
#pragma unroll
    for (int rt = 0; rt < 2; ++rt) { const int rho = 16 * rt + i16, he = (rho >> 2) & 1, re = (rho & 3) + 4 * (rho >> 3);
        rowE[rt] = SAMPLE ? MP + (8 * sub + 4 * he + (re >> 2)) * T_S + (re & 3) : (2 * sub + he) * T_P + re; }
    const bf16_t* ua = Z1 + (size_t)rowA * NBW + g * SC + 8 * hh;
    bf16_t* yo0 = YGp + (size_t)rowE[0] * BR + g * SC + 4 * G4; bf16_t* yo1 = YGp + (size_t)rowE[1] * BR + g * SC + 4 * G4;
    const LAS unsigned char* trb = img + (8 * G4 + (i16 >> 2)) * 72 + 8 * (i16 & 3);
    LAS unsigned char* wrb = img + n * 72 + 8 * hh;
    float hr0 = 0.f, hi0 = 0.f, hr1 = 0.f, hi1 = 0.f;
    float s0r[4], s0i[4], s1r[4], s1i[4];
    if (SAMPLE) {
#pragma unroll
        for (int q = 0; q < 4; ++q) { const size_t o = ((size_t)(8 * sub + 4 * hh + q) * SG + g) * SP; s0r[q] = h0re[o + n]; s0i[q] = h0im[o + n]; s1r[q] = h0re[o + 32 + n]; s1i[q] = h0im[o + 32 + n]; }
    }
#define S5_STEP(UB, YO) do { \
        f32x16 T[5]; \
        _Pragma("unroll") for (int j = 0; j < 5; ++j) { \
            _Pragma("unroll") for (int r = 0; r < 16; ++r) T[j][r] = 0.f; \
            T[j] = __builtin_amdgcn_mfma_f32_32x32x16_bf16(UB, j < 4 ? bfrag[j] : ifrag, T[j], 0, 0, 0); } \
        _Pragma("unroll") for (int r = 0; r < 16; ++r) { \
            if (SAMPLE && (r & 3) == 0) { hr0 = s0r[r >> 2]; hi0 = s0i[r >> 2]; hr1 = s1r[r >> 2]; hi1 = s1i[r >> 2]; } \
            const float nr0 = fmaf(lbr0, hr0, fmaf(-lbi0, hi0, T[0][r])), ni0 = fmaf(lbr0, hi0, fmaf(lbi0, hr0, T[2][r])); \
            const float nr1 = fmaf(lbr1, hr1, fmaf(-lbi1, hi1, T[1][r])), ni1 = fmaf(lbr1, hi1, fmaf(lbi1, hr1, T[3][r])); \
            hr0 = nr0; hi0 = ni0; hr1 = nr1; hi1 = ni1; T[0][r] = nr0; T[2][r] = ni0; T[1][r] = nr1; T[3][r] = ni1; \
            if (SAMPLE && (r & 3) == 3) { const int b = 8 * sub + 4 * hh + (r >> 2); const size_t o = ((size_t)b * SG + g) * SP; \
                hout_re[o + n] = hr0; hout_im[o + n] = hi0; hout_re[o + 32 + n] = hr1; hout_im[o + 32 + n] = hi1; } \
        } \
        _Pragma("unroll") for (int j = 0; j < 5; ++j) \
            _Pragma("unroll") for (int gq = 0; gq < 4; ++gq) { u32x2 w; w.x = cvtpk(T[j][4 * gq], T[j][4 * gq + 1]); w.y = cvtpk(T[j][4 * gq + 2], T[j][4 * gq + 3]); \
                *(LAS u32x2*)(wrb + j * 2304 + 16 * gq) = w; } \
        LDS_WAIT(); \
        f32x4 ya[2]; \
        _Pragma("unroll") for (int rt = 0; rt < 2; ++rt) ya[rt] = (f32x4){0.f, 0.f, 0.f, 0.f}; \
        _Pragma("unroll") for (int kq = 0; kq < 5; ++kq) \
            _Pragma("unroll") for (int rt = 0; rt < 2; ++rt) { const s16x4 lo = tr_read16(trb + kq * 2304 + rt * 32), hi = tr_read16(trb + kq * 2304 + rt * 32 + 288); \
                const bf16x8 hb = __builtin_shufflevector(lo, hi, 0, 1, 2, 3, 4, 5, 6, 7); \
                ya[rt] = __builtin_amdgcn_mfma_f32_16x16x32_bf16(kq < 4 ? cfrag[kq] : dfrag, hb, ya[rt], 0, 0, 0); } \
        LDS_WAIT(); \
        _Pragma("unroll") for (int rt = 0; rt < 2; ++rt) { \
            const float y0 = gelu_tanh(ya[rt][0]), y1 = gelu_tanh(ya[rt][1]), y2 = gelu_tanh(ya[rt][2]), y3 = gelu_tanh(ya[rt][3]); \
            YO[rt].x = cvtpk(y0, y1); YO[rt].y = cvtpk(y2, y3); } \
    } while (0)
#define S5_LOAD4(U, GI) do { _Pragma("unroll") for (int q4 = 0; q4 < 4; ++q4) U[q4] = *(const bf16x8*)(ua + (size_t)((GI) * 4 + q4) * 16 * NBW); } while (0)
#define S5_STORE4(Y, GI) do { _Pragma("unroll") for (int q4 = 0; q4 < 4; ++q4) { *(u32x2*)(yo0 + (size_t)((GI) * 4 + q4) * 16 * BR) = Y[q4][0]; *(u32x2*)(yo1 + (size_t)((GI) * 4 + q4) * 16 * BR) = Y[q4][1]; } } while (0)
#define S5_GROUP(UC, UN, YP, YC, GI) do { \
        { const int gn = ((GI) + 1 < NGRP) ? (GI) + 1 : NGRP - 1; S5_LOAD4(UN, gn); } \
        if ((GI) > 0) S5_STORE4(YP, (GI) - 1); \
        __builtin_amdgcn_sched_barrier(0); \
        S5_STEP(UC[0], YC[0]); S5_STEP(UC[1], YC[1]); S5_STEP(UC[2], YC[2]); S5_STEP(UC[3], YC[3]); \
    } while (0)
    if (SAMPLE) { bf16x8 u1 = *(const bf16x8*)ua; u32x2 ysmp[2]; S5_STEP(u1, ysmp); *(u32x2*)yo0 = ysmp[0]; *(u32x2*)yo1 = ysmp[1]; }
    else {
        constexpr int NGRP = T_P / 64;
        bf16x8 uA[4], uB[4]; u32x2 yA[4][2], yB[4][2];
        S5_LOAD4(uA, 0);
#pragma unroll 1
        for (int gi = 0; gi < NGRP; gi += 2) { S5_GROUP(uA, uB, yB, yA, gi); S5_GROUP(uB, uA, yA, yB, gi + 1); }
        S5_STORE4(yB, NGRP - 1);
    }
#undef S5_GROUP
#undef S5_STORE4
#undef S5_LOAD4
#undef S5_STEP
    if (!SAMPLE) { const size_t o = ((size_t)(2 * sub + hh) * SG + g) * SP;
        hout_re[o + n] = hr0; hout_im[o + n] = hi0; hout_re[o + 32 + n] = hr1; hout_im[o + 32 + n] = hi1; }
}


DI void s5_item_split(const bf16_t* Z1, const bf16_t* bbt, const bf16_t* ctt, const float* lbt, const float* dvec, float* hout_re, float* hout_im, bf16_t* YGp,
                      LAS unsigned char* img2, volatile LAS unsigned* flags, const int item, const int r, const int lane_in) {
    int lane_o = lane_in; asm volatile("" : "+v"(lane_o)); const int lane = lane_o;
    const int n = lane & 31, hh = lane >> 5, i16 = lane & 15, G4 = lane >> 4;
    const int g = item >> 2, sub = item & 3;
    const bf16x8 bre = *(const bf16x8*)(bbt + ((size_t)g * 128 + 32 * r + n) * SC + 8 * hh), bim = *(const bf16x8*)(bbt + ((size_t)g * 128 + 64 + 32 * r + n) * SC + 8 * hh);
    bf16x8 cfrag[4];
#pragma unroll
    for (int j = 0; j < 4; ++j) cfrag[j] = *(const bf16x8*)(ctt + ((size_t)g * SC + i16) * 128 + 32 * j + 8 * G4);
    bf16x8 ifrag;
#pragma unroll
    for (int e = 0; e < 8; ++e) ifrag[e] = (n == 8 * hh + e) ? (short)0x3f80 : (short)0;
    bf16x8 dfrag; { const float dv = dvec[g * SC + i16];
#pragma unroll
        for (int e = 0; e < 8; ++e) dfrag[e] = (8 * G4 + e == i16) ? (short)f2bf(dv) : (short)0; }
    const float lbr = lbt[2 * (g * SP + 32 * r + n)], lbi = lbt[2 * (g * SP + 32 * r + n) + 1];
    const int ha = (n >> 2) & 1, ra = (n & 3) + 4 * (n >> 3);
    const int rowA = (2 * sub + ha) * T_P + ra;
    const int rho = 16 * r + i16, he = (rho >> 2) & 1, re = (rho & 3) + 4 * (rho >> 3);
    const int rowE = (2 * sub + he) * T_P + re;
    const bf16_t* ua = Z1 + (size_t)rowA * NBW + g * SC + 8 * hh;
    bf16_t* yo = YGp + (size_t)rowE * BR + g * SC + 4 * G4;
    const int trofs = (8 * G4 + (i16 >> 2)) * 72 + 8 * (i16 & 3) + r * 32;
    const int wrre = (32 * r + n) * 72 + 8 * hh, wrim = (64 + 32 * r + n) * 72 + 8 * hh, wru = (128 + n) * 72 + 8 * hh;
    volatile LAS unsigned* fmine = flags + r; volatile LAS unsigned* fother = flags + (1 - r);
    float hr = 0.f, hi = 0.f;
    constexpr int NGRP = T_P / 64;
#define S5S_STEP(UB, YO, SIDX) do { \
        LAS unsigned char* buf = img2 + (((SIDX) & 1) ? 11520 : 0); \
        f32x16 Tr, Ti, Tu; \
        _Pragma("unroll") for (int q = 0; q < 16; ++q) { Tr[q] = 0.f; Ti[q] = 0.f; Tu[q] = 0.f; } \
        Tr = __builtin_amdgcn_mfma_f32_32x32x16_bf16(UB, bre, Tr, 0, 0, 0); Ti = __builtin_amdgcn_mfma_f32_32x32x16_bf16(UB, bim, Ti, 0, 0, 0); \
        if (r == 0) Tu = __builtin_amdgcn_mfma_f32_32x32x16_bf16(UB, ifrag, Tu, 0, 0, 0); \
        _Pragma("unroll") for (int q = 0; q < 16; ++q) { \
            const float nr = fmaf(lbr, hr, fmaf(-lbi, hi, Tr[q])), ni = fmaf(lbr, hi, fmaf(lbi, hr, Ti[q])); hr = nr; hi = ni; Tr[q] = nr; Ti[q] = ni; } \
        _Pragma("unroll") for (int gq = 0; gq < 4; ++gq) { u32x2 w; w.x = cvtpk(Tr[4 * gq], Tr[4 * gq + 1]); w.y = cvtpk(Tr[4 * gq + 2], Tr[4 * gq + 3]); *(LAS u32x2*)(buf + wrre + 16 * gq) = w; \
            w.x = cvtpk(Ti[4 * gq], Ti[4 * gq + 1]); w.y = cvtpk(Ti[4 * gq + 2], Ti[4 * gq + 3]); *(LAS u32x2*)(buf + wrim + 16 * gq) = w; } \
        if (r == 0) { _Pragma("unroll") for (int gq = 0; gq < 4; ++gq) { u32x2 w; w.x = cvtpk(Tu[4 * gq], Tu[4 * gq + 1]); w.y = cvtpk(Tu[4 * gq + 2], Tu[4 * gq + 3]); *(LAS u32x2*)(buf + wru + 16 * gq) = w; } } \
        LDS_WAIT(); \
        *fmine = (unsigned)((SIDX) + 1); \
        while (*fother < (unsigned)((SIDX) + 1)) { __builtin_amdgcn_s_sleep(0); } \
        asm volatile("" ::: "memory"); \
        f32x4 ya = (f32x4){0.f, 0.f, 0.f, 0.f}; \
        _Pragma("unroll") for (int kq = 0; kq < 5; ++kq) { const s16x4 lo = tr_read16(buf + trofs + kq * 2304), hi2 = tr_read16(buf + trofs + kq * 2304 + 288); \
            const bf16x8 hb = __builtin_shufflevector(lo, hi2, 0, 1, 2, 3, 4, 5, 6, 7); \
            ya = __builtin_amdgcn_mfma_f32_16x16x32_bf16(kq < 4 ? cfrag[kq] : dfrag, hb, ya, 0, 0, 0); } \
        LDS_WAIT(); \
        { const float y0 = gelu_tanh(ya[0]), y1 = gelu_tanh(ya[1]), y2 = gelu_tanh(ya[2]), y3 = gelu_tanh(ya[3]); YO.x = cvtpk(y0, y1); YO.y = cvtpk(y2, y3); } \
    } while (0)
#define S5S_LOAD4(U, GI) do { _Pragma("unroll") for (int q4 = 0; q4 < 4; ++q4) U[q4] = *(const bf16x8*)(ua + (size_t)((GI) * 4 + q4) * 16 * NBW); } while (0)
#define S5S_STORE4(Y, GI) do { _Pragma("unroll") for (int q4 = 0; q4 < 4; ++q4) *(u32x2*)(yo + (size_t)((GI) * 4 + q4) * 16 * BR) = Y[q4]; } while (0)
#define S5S_GROUP(UC, UN, YP, YC, GI) do { \
        { const int gn = ((GI) + 1 < NGRP) ? (GI) + 1 : NGRP - 1; S5S_LOAD4(UN, gn); } \
        if ((GI) > 0) S5S_STORE4(YP, (GI) - 1); \
        __builtin_amdgcn_sched_barrier(0); \
        S5S_STEP(UC[0], YC[0], (GI) * 4 + 0); S5S_STEP(UC[1], YC[1], (GI) * 4 + 1); S5S_STEP(UC[2], YC[2], (GI) * 4 + 2); S5S_STEP(UC[3], YC[3], (GI) * 4 + 3); \
    } while (0)
    bf16x8 uA[4], uB[4]; u32x2 yA[4], yB[4];
    S5S_LOAD4(uA, 0);
#pragma unroll 1
    for (int gi = 0; gi < NGRP; gi += 2) { S5S_GROUP(uA, uB, yB, yA, gi); S5S_GROUP(uB, uA, yA, yB, gi + 1); }
    S5S_STORE4(yB, NGRP - 1);
#undef S5S_GROUP
#undef S5S_STORE4
#undef S5S_LOAD4
#undef S5S_STEP
    { const size_t o = ((size_t)(2 * sub + hh) * SG + g) * SP + 32 * r; hout_re[o + n] = hr; hout_im[o + n] = hi; }
}
constexpr int S5_NBUF = 4, S5_IMG = 11520;
template <int r>
DI void s5_prod(const bf16_t* Z1, const bf16_t* bbt, const float* lbt, float* hout_re, float* hout_im,
                LAS unsigned char* img, volatile LAS unsigned* flags, const int item, const int lane_in) {
    int lane_o = lane_in; asm volatile("" : "+v"(lane_o)); const int lane = lane_o;
    const int n = lane & 31, hh = lane >> 5;
    const int g = item >> 2, sub = item & 3;
    const bf16x8 bre = *(const bf16x8*)(bbt + ((size_t)g * 128 + 32 * r + n) * SC + 8 * hh), bim = *(const bf16x8*)(bbt + ((size_t)g * 128 + 64 + 32 * r + n) * SC + 8 * hh);
    bf16x8 ifrag;
#pragma unroll
    for (int e = 0; e < 8; ++e) ifrag[e] = (n == 8 * hh + e) ? (short)0x3f80 : (short)0;
    const float lbr = lbt[2 * (g * SP + 32 * r + n)], lbi = lbt[2 * (g * SP + 32 * r + n) + 1];
    const int ha = (n >> 2) & 1, ra = (n & 3) + 4 * (n >> 3);
    const int rowA = (2 * sub + ha) * T_P + ra;
    const bf16_t* ua = Z1 + (size_t)rowA * NBW + g * SC + 8 * hh;
    const int wrre = (32 * r + n) * 72 + 8 * hh, wrim = (64 + 32 * r + n) * 72 + 8 * hh, wru = (128 + n) * 72 + 8 * hh;
    volatile LAS unsigned* fmine = flags + r; volatile LAS unsigned long long* fcons = (volatile LAS unsigned long long*)(flags + 2);
    float hr = 0.f, hi = 0.f;
    constexpr int NGRP = T_P / 64;
#define S5P_STEP(UB, SIDX, J) do { \
        LAS unsigned char* buf = img + (J) * S5_IMG; \
        f32x16 Tr, Ti, Tu; \
        _Pragma("unroll") for (int q = 0; q < 16; ++q) { Tr[q] = 0.f; Ti[q] = 0.f; Tu[q] = 0.f; } \
        Tr = __builtin_amdgcn_mfma_f32_32x32x16_bf16(UB, bre, Tr, 0, 0, 0); Ti = __builtin_amdgcn_mfma_f32_32x32x16_bf16(UB, bim, Ti, 0, 0, 0); \
        if constexpr (r == 0) Tu = __builtin_amdgcn_mfma_f32_32x32x16_bf16(UB, ifrag, Tu, 0, 0, 0); \
        if (((J) & 1) == 0 && (SIDX) >= S5_NBUF) { const unsigned need = (unsigned)((SIDX) - 2);        \
            for (;;) { const unsigned long long fc = *fcons; if ((unsigned)fc >= need && (unsigned)(fc >> 32) >= need) break; __builtin_amdgcn_s_sleep(0); } \
            asm volatile("" ::: "memory"); } \
        _Pragma("unroll") for (int q = 0; q < 16; ++q) { \
            const float nr = fmaf(lbr, hr, fmaf(-lbi, hi, Tr[q])), ni = fmaf(lbr, hi, fmaf(lbi, hr, Ti[q])); hr = nr; hi = ni; \
            asm volatile("" : "+v"(hr)); asm volatile("" : "+v"(hi));         \
            Tr[q] = hr; Ti[q] = hi; } \
        if ((SIDX) > 0) { LDS_WAIT(); *fmine = (unsigned)(SIDX); }                                     \
        _Pragma("unroll") for (int gq = 0; gq < 4; ++gq) { u32x2 w; w.x = cvtpk(Tr[4 * gq], Tr[4 * gq + 1]); w.y = cvtpk(Tr[4 * gq + 2], Tr[4 * gq + 3]); *(LAS u32x2*)(buf + wrre + 16 * gq) = w; \
            w.x = cvtpk(Ti[4 * gq], Ti[4 * gq + 1]); w.y = cvtpk(Ti[4 * gq + 2], Ti[4 * gq + 3]); *(LAS u32x2*)(buf + wrim + 16 * gq) = w; } \
        if constexpr (r == 0) { _Pragma("unroll") for (int gq = 0; gq < 4; ++gq) { u32x2 w; w.x = cvtpk(Tu[4 * gq], Tu[4 * gq + 1]); w.y = cvtpk(Tu[4 * gq + 2], Tu[4 * gq + 3]); *(LAS u32x2*)(buf + wru + 16 * gq) = w; } } \
    } while (0)
#define S5P_LOAD4(U, GI) do { _Pragma("unroll") for (int q4 = 0; q4 < 4; ++q4) U[q4] = *(const bf16x8*)(ua + (size_t)((GI) * 4 + q4) * 16 * NBW); } while (0)
#define S5P_GROUP(UC, UN, GI) do { \
        { const int gn = ((GI) + 3 < NGRP) ? (GI) + 3 : NGRP - 1; S5P_LOAD4(UN, gn); } \
        __builtin_amdgcn_sched_barrier(0); \
        S5P_STEP(UC[0], (GI) * 4 + 0, 0); S5P_STEP(UC[1], (GI) * 4 + 1, 1); S5P_STEP(UC[2], (GI) * 4 + 2, 2); S5P_STEP(UC[3], (GI) * 4 + 3, 3); \
    } while (0)
    bf16x8 uA[4], uB[4], uC[4], uD[4];
    S5P_LOAD4(uA, 0); S5P_LOAD4(uB, 1); S5P_LOAD4(uC, 2);
#pragma unroll 1
    for (int gi = 0; gi < NGRP; gi += 4) { S5P_GROUP(uA, uD, gi); S5P_GROUP(uB, uA, gi + 1); S5P_GROUP(uC, uB, gi + 2); S5P_GROUP(uD, uC, gi + 3); }
#undef S5P_GROUP
#undef S5P_LOAD4
#undef S5P_STEP
    LDS_WAIT(); *fmine = (unsigned)(NGRP * 4);
    { const size_t o = ((size_t)(2 * sub + hh) * SG + g) * SP + 32 * r; hout_re[o + n] = hr; hout_im[o + n] = hi; }
}
DI void s5_cons(const bf16_t* ctt, const float* dvec, bf16_t* YGp, LAS unsigned char* img, volatile LAS unsigned* flags, const int item, const int c, const int lane_in) {
    int lane_o = lane_in; asm volatile("" : "+v"(lane_o)); const int lane = lane_o;
    const int i16 = lane & 15, G4 = lane >> 4;
    const int g = item >> 2, sub = item & 3;
    bf16x8 cfrag[4];
#pragma unroll
    for (int j = 0; j < 4; ++j) cfrag[j] = *(const bf16x8*)(ctt + ((size_t)g * SC + i16) * 128 + 32 * j + 8 * G4);
    bf16x8 dfrag; { const float dv = dvec[g * SC + i16];
#pragma unroll
        for (int e = 0; e < 8; ++e) dfrag[e] = (8 * G4 + e == i16) ? (short)f2bf(dv) : (short)0; }
    const int rho = 16 * c + i16, he = (rho >> 2) & 1, re = (rho & 3) + 4 * (rho >> 3);
    const int rowE = (2 * sub + he) * T_P + re;
    bf16_t* yo = YGp + (size_t)rowE * BR + g * SC + 4 * G4;
    const int trofs = (8 * G4 + (i16 >> 2)) * 72 + 8 * (i16 & 3) + c * 32;
    volatile LAS unsigned* fmine = flags + 2 + c; volatile LAS unsigned long long* fprod = (volatile LAS unsigned long long*)flags;
    constexpr int NGRP = T_P / 64;
#define S5C_BODY(YA, J) do { \
        const LAS unsigned char* buf = img + (J) * S5_IMG; \
        YA = (f32x4){0.f, 0.f, 0.f, 0.f}; \
        _Pragma("unroll") for (int kq = 0; kq < 5; ++kq) { const s16x4 lo = tr_read16(buf + trofs + kq * 2304), hi2 = tr_read16(buf + trofs + kq * 2304 + 288); \
            const bf16x8 hb = __builtin_shufflevector(lo, hi2, 0, 1, 2, 3, 4, 5, 6, 7); \
            YA = __builtin_amdgcn_mfma_f32_16x16x32_bf16(kq < 4 ? cfrag[kq] : dfrag, hb, YA, 0, 0, 0); } \
    } while (0)
#define S5C_GELU(YO, YA) do { const float y0 = gelu_tanh(YA[0]), y1 = gelu_tanh(YA[1]), y2 = gelu_tanh(YA[2]), y3 = gelu_tanh(YA[3]); YO.x = cvtpk(y0, y1); YO.y = cvtpk(y2, y3); } while (0)
#define S5C_PAIR(YO0, YO1, SIDX, J) do { \
        { const unsigned need = (unsigned)((SIDX) + 2); for (;;) { const unsigned long long fp = *fprod; if ((unsigned)fp >= need && (unsigned)(fp >> 32) >= need) break; __builtin_amdgcn_s_sleep(0); } \
          asm volatile("" ::: "memory"); } \
        f32x4 ya0, ya1; S5C_BODY(ya0, J); S5C_BODY(ya1, (J) + 1); \
        LDS_WAIT(); \
        *fmine = (unsigned)((SIDX) + 2); \
        S5C_GELU(YO0, ya0); S5C_GELU(YO1, ya1); \
    } while (0)
#define S5C_STORE4(Y, GI) do { _Pragma("unroll") for (int q4 = 0; q4 < 4; ++q4) *(u32x2*)(yo + (size_t)((GI) * 4 + q4) * 16 * BR) = Y[q4]; } while (0)
    u32x2 yA[4];
#pragma unroll 1
    for (int gi = 0; gi < NGRP; ++gi) {
        S5C_PAIR(yA[0], yA[1], gi * 4, 0); S5C_PAIR(yA[2], yA[3], gi * 4 + 2, 2);
        S5C_STORE4(yA, gi);
    }
#undef S5C_PAIR
#undef S5C_GELU
#undef S5C_BODY
#undef S5C_STORE4
}
DI void spatial_stage_w(const float* wg, LAS unsigned char* wimg, const int tid) {
#pragma unroll
    for (int i = 0; i < 4; ++i) { const int cid = tid + NTHR * i, t = cid >> 4, c = cid & 15;
        const f32x4 a = *(const f32x4*)(wg + t * CH + 8 * c), b = *(const f32x4*)(wg + t * CH + 8 * c + 4); const int s0 = 8 * c;
        u32x4 w; w.x = cvtpk(s0 + 0 <= t ? a.x : 0.f, s0 + 1 <= t ? a.y : 0.f); w.y = cvtpk(s0 + 2 <= t ? a.z : 0.f, s0 + 3 <= t ? a.w : 0.f);
        w.z = cvtpk(s0 + 4 <= t ? b.x : 0.f, s0 + 5 <= t ? b.y : 0.f); w.w = cvtpk(s0 + 6 <= t ? b.z : 0.f, s0 + 7 <= t ? b.w : 0.f);
        *(LAS u32x4*)(wimg + t * 256 + ((c ^ (t & 15)) << 4)) = w; }
}
DI void spatial_phase(const bf16_t* Zb, const float* vstat, const float* lng, const float* lnb, const float* wsp, const float* bsp, bf16_t* MIXp, LAS unsigned char* lds,
                      const int vcu, const int G, const int tid_in, const int wave, const int lane_in) {
    int tid_o = tid_in, lane_o = lane_in; asm volatile("" : "+v"(tid_o), "+v"(lane_o)); const int tid = tid_o, lane = lane_o;
    LAS unsigned char* wimg = lds; LAS unsigned char* vimg = lds + 32768; LAS unsigned char* oimg = vimg;
    constexpr int NITEM = (MP / CH) * AG;
    const bool act = tid < 504; const int cc = tid % 24, r0 = tid / 24;
    const int a = wave & 3, hf = wave >> 2, n = lane & 31, hh = lane >> 5, i16 = lane & 15, blk = (lane >> 4) & 1;
    const LAS unsigned char* trb = vimg + (8 * hh + (i16 >> 2)) * 448 + 32 * blk + 8 * (i16 & 3);
    u32x4 vw[7]; f32x2 st[7];
    int item = vcu, last_g = -1;
    if (item < NITEM && act) { const int g = item & 7, c = item >> 3;
#pragma unroll
        for (int i = 0; i < 7; ++i) { const int sr = r0 + 21 * i; if (sr < CH) { const int row = c * CH + sr; vw[i] = __builtin_nontemporal_load((const u32x4*)(Zb + (size_t)row * ZA + BR + g * AD + 8 * cc)); st[i] = *(const f32x2*)(vstat + 2 * row); } } }
    for (; item < NITEM; item += G) {
        const int g = item & 7, c = item >> 3;
        __syncthreads();
        if (g != last_g) { spatial_stage_w(wsp + (size_t)g * CH * CH, wimg, tid); last_g = g; }
        if (act) { const int vcol = g * AD + 8 * cc;
            const f32x4 g0 = *(const f32x4*)(lng + vcol), g1 = *(const f32x4*)(lng + vcol + 4), b0 = *(const f32x4*)(lnb + vcol), b1 = *(const f32x4*)(lnb + vcol + 4);
            const float gg[8] = {g0[0], g0[1], g0[2], g0[3], g1[0], g1[1], g1[2], g1[3]}, bv[8] = {b0[0], b0[1], b0[2], b0[3], b1[0], b1[1], b1[2], b1[3]};
#pragma unroll
            for (int i = 0; i < 7; ++i) { const int sr = r0 + 21 * i;
                if (sr < CH) { const float mean = st[i].x * (1.f / BR), var = st[i].y * (1.f / BR) - mean * mean; const float rstd = 1.0f / sqrtf(var + EPS), mr = -mean * rstd;
                    float o[8];
#pragma unroll
                    for (int e = 0; e < 4; ++e) { const float x0 = __uint_as_float(vw[i][e] << 16), x1 = __uint_as_float(vw[i][e] & 0xffff0000u);
                        o[2 * e] = (x0 * rstd + mr) * gg[2 * e] + bv[2 * e]; o[2 * e + 1] = (x1 * rstd + mr) * gg[2 * e + 1] + bv[2 * e + 1]; }
                    u32x4 w; w.x = cvtpk(o[0], o[1]); w.y = cvtpk(o[2], o[3]); w.z = cvtpk(o[4], o[5]); w.w = cvtpk(o[6], o[7]);
                    *(LAS u32x4*)(vimg + sr * 448 + cc * 16) = w; } } }
        __syncthreads();
        u32x4 uq[7];
        if (act) { const int nit = item + G;
            if (nit < NITEM) { const int g2 = nit & 7, c2 = nit >> 3;
#pragma unroll
                for (int i = 0; i < 7; ++i) { const int sr = r0 + 21 * i; if (sr < CH) { const int row = c2 * CH + sr; vw[i] = __builtin_nontemporal_load((const u32x4*)(Zb + (size_t)row * ZA + BR + g2 * AD + 8 * cc)); st[i] = *(const f32x2*)(vstat + 2 * row); } } }
#pragma unroll
            for (int i = 0; i < 7; ++i) { const int sr = r0 + 21 * i; if (sr < CH) { const bf16_t* zr = Zb + (size_t)(c * CH + sr) * ZA + g * AD + 8 * cc; uq[i] = __builtin_nontemporal_load((const u32x4*)zr); } } }
        f32x16 acc[3];
#pragma unroll
        for (int k = 0; k < 3; ++k) {
            const int tt = hf == 0 ? (k < 2 ? a : 3 - a) : (k < 1 ? a : 3 - a);
            const int dt = hf == 0 ? (k < 2 ? k : 3) : (k < 1 ? 2 : 3 + k);
            const int t = 32 * tt + n;
#pragma unroll
            for (int r = 0; r < 16; ++r) acc[k][r] = 0.f;
            const LAS unsigned char* wb = wimg + t * 256; const int tx = t & 15;
            const int nks = 2 * (tt + 1);
#pragma unroll 2
            for (int ks = 0; ks < nks; ++ks) {
                const s16x4 lo = tr_read16(trb + ks * 16 * 448 + dt * 64), hi = tr_read16(trb + ks * 16 * 448 + dt * 64 + 4 * 448);
                const bf16x8 af = __builtin_shufflevector(lo, hi, 0, 1, 2, 3, 4, 5, 6, 7);
                const bf16x8 bfr = *(const LAS bf16x8*)(wb + (((2 * ks + hh) ^ tx) << 4));
                acc[k] = __builtin_amdgcn_mfma_f32_32x32x16_bf16(af, bfr, acc[k], 0, 0, 0);
            }
        }
        __syncthreads();
#pragma unroll
        for (int k = 0; k < 3; ++k) {
            const int tt = hf == 0 ? (k < 2 ? a : 3 - a) : (k < 1 ? a : 3 - a);
            const int dt = hf == 0 ? (k < 2 ? k : 3) : (k < 1 ? 2 : 3 + k);
            const int t = 32 * tt + n; const float bs = bsp[g * CH + t];
#pragma unroll
            for (int q4 = 0; q4 < 4; ++q4) { u32x2 w; w.x = cvtpk(acc[k][4 * q4] + bs, acc[k][4 * q4 + 1] + bs); w.y = cvtpk(acc[k][4 * q4 + 2] + bs, acc[k][4 * q4 + 3] + bs);
                *(LAS u32x2*)(oimg + t * 400 + (32 * dt + 8 * q4 + 4 * hh) * 2) = w; }
        }
        __syncthreads();
        if (act) {
#pragma unroll
            for (int i = 0; i < 7; ++i) { const int sr = r0 + 21 * i;
                if (sr < CH) { const u32x4 mw = *(const LAS u32x4*)(oimg + sr * 400 + cc * 16); u32x4 w;
#pragma unroll
                    for (int e = 0; e < 4; ++e) { const float o0 = __uint_as_float(uq[i][e] << 16) * __uint_as_float(mw[e] << 16);
                        const float o1 = __uint_as_float(uq[i][e] & 0xffff0000u) * __uint_as_float(mw[e] & 0xffff0000u); w[e] = cvtpk(o0, o1); }
                    *(u32x4*)(MIXp + (size_t)(c * CH + sr) * MW + g * AD + 8 * cc) = w; } } }
    }
}

DI float selv(bool c, float a, float b) { asm volatile("" : "+v"(a), "+v"(b)); return c ? a : b; }
DI void attn_sample_seq(const bf16_t* Zb, const int ldz, const int qoff, const int goff, const float* ck, const float* cv, bf16_t* MIXp, LAS unsigned char* lds, const int item, const int wave, const int lane_in) {
    int lane_o = lane_in; asm volatile("" : "+v"(lane_o)); const int lane = lane_o;
    const int b = item >> 1, hb = wave & 1, h = 2 * (item & 1) + hb, kq = wave >> 1, hf = lane >> 5, dl = lane & 31;
    LAS float* sc = (LAS float*)(lds + wave * 1024);
    LAS float* xch = (LAS float*)(lds + 8192 + (hb * 3 + (kq - 1)) * 2176);
    const float L2E = 1.4426950408889634f;
    float q[4][4];
#pragma unroll
    for (int t = 0; t < 4; ++t) { const u32x2 w = *(const u32x2*)(Zb + (size_t)(MP + b * T_S + t) * ldz + qoff + h * HD + 4 * dl);
        q[t][0] = __uint_as_float(w.x << 16); q[t][1] = __uint_as_float(w.x & 0xffff0000u); q[t][2] = __uint_as_float(w.y << 16); q[t][3] = __uint_as_float(w.y & 0xffff0000u); }
    const size_t kvo = ((size_t)(b * NMEM + 64 * kq + hf)) * XA + h * HD + 4 * dl;
    const float* kbase = ck + kvo; const float* vbase = cv + kvo;
    const int t_l = ((lane >> 4) & 1) * 2 + ((lane >> 3) & 1);
    f32x4 kv[32];
#pragma unroll
    for (int mp = 0; mp < 32; ++mp) kv[mp] = __builtin_nontemporal_load((const f32x4*)(kbase + (size_t)mp * 2 * XA));
    f32x4 vv[16];
#pragma unroll
    for (int mp = 0; mp < 16; ++mp) vv[mp] = __builtin_nontemporal_load((const f32x4*)(vbase + (size_t)mp * 2 * XA));
    __builtin_amdgcn_sched_barrier(0);
#pragma unroll
    for (int mp = 0; mp < 32; ++mp) {
        const f32x4 k4 = kv[mp];
        const float s0 = q[0][0] * k4.x + q[0][1] * k4.y + q[0][2] * k4.z + q[0][3] * k4.w, s1 = q[1][0] * k4.x + q[1][1] * k4.y + q[1][2] * k4.z + q[1][3] * k4.w;
        const float s2 = q[2][0] * k4.x + q[2][1] * k4.y + q[2][2] * k4.z + q[2][3] * k4.w, s3 = q[3][0] * k4.x + q[3][1] * k4.y + q[3][2] * k4.z + q[3][3] * k4.w;
        const bool u16 = (lane & 16) != 0, u8 = (lane & 8) != 0;
        const float a = (u16 ? s2 : s0) + __shfl_xor(u16 ? s0 : s2, 16), c = (u16 ? s3 : s1) + __shfl_xor(u16 ? s1 : s3, 16);
        float v = (u8 ? c : a) + __shfl_xor(u8 ? a : c, 8);
        v += __shfl_xor(v, 4); v += __shfl_xor(v, 2); v += __shfl_xor(v, 1);
        if ((lane & 7) == 0) sc[(2 * mp + hf) * 4 + t_l] = v;
    }
    LDS_WAIT();
    float mx[4], l[4];
#pragma unroll
    for (int t = 0; t < 4; ++t) { const float x0 = sc[lane * 4 + t]; mx[t] = wave_max(x0);
        const float p0 = __builtin_amdgcn_exp2f((x0 - mx[t]) * L2E); l[t] = wave_sum(p0); sc[lane * 4 + t] = p0; }
    LDS_WAIT();
    f32x4 o[4];
#pragma unroll
    for (int t = 0; t < 4; ++t) o[t] = (f32x4){0.f, 0.f, 0.f, 0.f};
#pragma unroll
    for (int mp = 0; mp < 16; ++mp) { const f32x4 pv = *(const LAS f32x4*)(sc + (2 * mp + hf) * 4); o[0] += vv[mp] * pv.x; o[1] += vv[mp] * pv.y; o[2] += vv[mp] * pv.z; o[3] += vv[mp] * pv.w; }
#pragma unroll
    for (int mp = 0; mp < 16; ++mp) vv[mp] = __builtin_nontemporal_load((const f32x4*)(vbase + (size_t)(16 + mp) * 2 * XA));
#pragma unroll
    for (int mp = 0; mp < 16; ++mp) { const f32x4 pv = *(const LAS f32x4*)(sc + (2 * (16 + mp) + hf) * 4); o[0] += vv[mp] * pv.x; o[1] += vv[mp] * pv.y; o[2] += vv[mp] * pv.z; o[3] += vv[mp] * pv.w; }
#pragma unroll
    for (int t = 0; t < 4; ++t)
#pragma unroll
        for (int e = 0; e < 4; ++e) o[t][e] += __shfl_xor(o[t][e], 32);
    if (kq != 0) {
        if (lane < 32) {
#pragma unroll
            for (int t = 0; t < 4; ++t) *(LAS f32x4*)(xch + 8 + t * 128 + 4 * dl) = o[t]; }
        if (lane == 0) { *(LAS f32x4*)xch = (f32x4){mx[0], mx[1], mx[2], mx[3]}; *(LAS f32x4*)(xch + 4) = (f32x4){l[0], l[1], l[2], l[3]}; }
    }
    __syncthreads();
    if (kq == 0) {
        const LAS float* x1 = (const LAS float*)(lds + 8192 + (hb * 3 + 0) * 2176); const LAS float* x2 = x1 + 544; const LAS float* x3 = x2 + 544;
        const f32x4 m1 = *(const LAS f32x4*)x1, l1 = *(const LAS f32x4*)(x1 + 4), m2 = *(const LAS f32x4*)x2, l2 = *(const LAS f32x4*)(x2 + 4), m3 = *(const LAS f32x4*)x3, l3 = *(const LAS f32x4*)(x3 + 4);
#pragma unroll
        for (int j = 0; j < 2; ++j) {
            const int t = 2 * hf + j; const bool up = hf != 0;
            const float m0s = selv(up, mx[2 + j], mx[j]), l0s = selv(up, l[2 + j], l[j]), m1s = selv(up, m1[2 + j], m1[j]), l1s = selv(up, l1[2 + j], l1[j]);
            const float m2s = selv(up, m2[2 + j], m2[j]), l2s = selv(up, l2[2 + j], l2[j]), m3s = selv(up, m3[2 + j], m3[j]), l3s = selv(up, l3[2 + j], l3[j]);
            f32x4 o0; o0.x = selv(up, o[2 + j].x, o[j].x); o0.y = selv(up, o[2 + j].y, o[j].y); o0.z = selv(up, o[2 + j].z, o[j].z); o0.w = selv(up, o[2 + j].w, o[j].w);
            const f32x4 o1 = *(const LAS f32x4*)(x1 + 8 + t * 128 + 4 * dl), o2 = *(const LAS f32x4*)(x2 + 8 + t * 128 + 4 * dl), o3 = *(const LAS f32x4*)(x3 + 8 + t * 128 + 4 * dl);
            const float Mx = fmaxf(fmaxf(m0s, m1s), fmaxf(m2s, m3s));
            const float a0 = __builtin_amdgcn_exp2f((m0s - Mx) * L2E), a1 = __builtin_amdgcn_exp2f((m1s - Mx) * L2E), a2 = __builtin_amdgcn_exp2f((m2s - Mx) * L2E), a3 = __builtin_amdgcn_exp2f((m3s - Mx) * L2E);
            const float inv = 1.0f / (l0s * a0 + l1s * a1 + l2s * a2 + l3s * a3);
            const size_t row = (size_t)(MP + b * T_S + t);
            const u32x2 gw2 = *(const u32x2*)(Zb + row * ldz + goff + h * HD + 4 * dl);
            const f32x4 os = (o0 * a0 + o1 * a1 + o2 * a2 + o3 * a3) * inv;
            const float r0 = os.x * __uint_as_float(gw2.x << 16), r1 = os.y * __uint_as_float(gw2.x & 0xffff0000u), r2 = os.z * __uint_as_float(gw2.y << 16), r3 = os.w * __uint_as_float(gw2.y & 0xffff0000u);
            u32x2 w; w.x = cvtpk(r0, r1); w.y = cvtpk(r2, r3);
            *(u32x2*)(MIXp + row * MW + BR + h * HD + 4 * dl) = w;
        }
    }
    __syncthreads();
}

DI void attn_prompt_tile(const bf16_t* Zb, const int ldz, const int qoff, const int goff, const bf16_t* Kpl, const bf16_t* VTl, bf16_t* MIXp, const int tile, const int lane_in) {
    int lane_o = lane_in; asm volatile("" : "+v"(lane_o)); const int lane = lane_o;
    const int unit = tile >> 3, wt = tile & 7, b = unit >> 5, h = (unit >> 3) & 3, qb = unit & 7;
    const int qi = lane & 31, hh = lane >> 5;
    const int row = b * T_P + qb * 256 + wt * 32 + qi;
    const bf16_t* zr = Zb + (size_t)row * ldz;
    bf16x8 qf[8];
#pragma unroll
    for (int ks = 0; ks < 8; ++ks) qf[ks] = *(const bf16x8*)(zr + qoff + h * HD + 16 * ks + 8 * hh);
    const int pi = (qi & ~12) | ((qi & 4) << 1) | ((qi & 8) >> 1);
    const bf16_t* kg = Kpl + (size_t)(b * NMEM + pi) * XA + h * HD + 8 * hh;
    const bf16_t* vg = VTl + (size_t)((b * NH + h) * HD + qi) * NMEM + 8 * hh;
    f32x16 sacc[8];
#pragma unroll
    for (int T = 0; T < 8; ++T) {
#pragma unroll
        for (int r = 0; r < 16; ++r) sacc[T][r] = 0.f;
        bf16x8 kf[8];
#pragma unroll
        for (int ks = 0; ks < 8; ++ks) kf[ks] = *(const bf16x8*)(kg + (size_t)(32 * T) * XA + 16 * ks);
#pragma unroll
        for (int ks = 0; ks < 8; ++ks) sacc[T] = __builtin_amdgcn_mfma_f32_32x32x16_bf16(kf[ks], qf[ks], sacc[T], 0, 0, 0);
    }
    float mx = -3.0e38f;
#pragma unroll
    for (int T = 0; T < 8; ++T)
#pragma unroll
        for (int r = 0; r < 16; ++r) mx = fmaxf(mx, sacc[T][r]);
    mx = fmaxf(mx, __shfl_xor(mx, 32));
    float sum = 0.f;
#pragma unroll
    for (int T = 0; T < 8; ++T)
#pragma unroll
        for (int r = 0; r < 16; ++r) { const float p = __builtin_amdgcn_exp2f((sacc[T][r] - mx) * 1.4426950408889634f); sacc[T][r] = p; sum += p; }
    sum += __shfl_xor(sum, 32);
    const float inv = 1.0f / sum;
    f32x16 oacc[4];
#pragma unroll
    for (int dt = 0; dt < 4; ++dt)
#pragma unroll
        for (int r = 0; r < 16; ++r) oacc[dt][r] = 0.f;
#pragma unroll
    for (int T = 0; T < 8; ++T) {
#pragma unroll
        for (int s2 = 0; s2 < 2; ++s2) {
            bf16x8 vf[2][4];
#pragma unroll
            for (int dt = 0; dt < 4; ++dt) vf[s2][dt] = *(const bf16x8*)(vg + (size_t)(32 * dt) * NMEM + 32 * T + 16 * s2);
            u32x4 pw; pw.x = cvtpk(sacc[T][8 * s2 + 0], sacc[T][8 * s2 + 1]); pw.y = cvtpk(sacc[T][8 * s2 + 2], sacc[T][8 * s2 + 3]);
            pw.z = cvtpk(sacc[T][8 * s2 + 4], sacc[T][8 * s2 + 5]); pw.w = cvtpk(sacc[T][8 * s2 + 6], sacc[T][8 * s2 + 7]);
            const bf16x8 pf = __builtin_bit_cast(bf16x8, pw);
#pragma unroll
            for (int dt = 0; dt < 4; ++dt) oacc[dt] = __builtin_amdgcn_mfma_f32_32x32x16_bf16(vf[s2][dt], pf, oacc[dt], 0, 0, 0);
        }
    }
    bf16_t* mr = MIXp + (size_t)row * MW + BR + h * HD;
#pragma unroll
    for (int dt = 0; dt < 4; ++dt)
#pragma unroll
        for (int g4 = 0; g4 < 4; ++g4) { const int d0 = 32 * dt + 8 * g4 + 4 * hh;
            const u32x2 gw2 = *(const u32x2*)(zr + goff + h * HD + d0);
            const float o0 = oacc[dt][4 * g4 + 0] * inv * __uint_as_float(gw2.x << 16), o1 = oacc[dt][4 * g4 + 1] * inv * __uint_as_float(gw2.x & 0xffff0000u);
            const float o2 = oacc[dt][4 * g4 + 2] * inv * __uint_as_float(gw2.y << 16), o3 = oacc[dt][4 * g4 + 3] * inv * __uint_as_float(gw2.y & 0xffff0000u);
            u32x2 w; w.x = cvtpk(o0, o1); w.y = cvtpk(o2, o3);
            *(u32x2*)(mr + d0) = w; }
}
DI void attn_sample_item(const bf16_t* Zb, const int ldz, const int qoff, const int goff, const float* ck, const float* cv, bf16_t* MIXp, LAS float* sc, const int item, const int lane_in) {
    int lane_o = lane_in; asm volatile("" : "+v"(lane_o)); const int lane = lane_o;
    const int b = item >> 2, h = item & 3, hf = lane >> 5, dl = lane & 31;
    const float L2E = 1.4426950408889634f;
    float q[4][4];
#pragma unroll
    for (int t = 0; t < 4; ++t) { const u32x2 w = *(const u32x2*)(Zb + (size_t)(MP + b * T_S + t) * ldz + qoff + h * HD + 4 * dl);
        q[t][0] = __uint_as_float(w.x << 16); q[t][1] = __uint_as_float(w.x & 0xffff0000u); q[t][2] = __uint_as_float(w.y << 16); q[t][3] = __uint_as_float(w.y & 0xffff0000u); }
    const size_t kvo = ((size_t)(b * NMEM + hf)) * XA + h * HD + 4 * dl;
    const float* kbase = ck + kvo; const float* vbase = cv + kvo;
    const int t_l = ((lane >> 4) & 1) * 2 + ((lane >> 3) & 1);
    constexpr int NBT = 16;
#define SA_KLOAD(KV, BT) do { _Pragma("unroll") for (int mp = 0; mp < 8; ++mp) KV[mp] = __builtin_nontemporal_load((const f32x4*)(kbase + (size_t)((BT) * 8 + mp) * 2 * XA)); } while (0)
#define SA_KRED(KV, BT) do { _Pragma("unroll") for (int mp = 0; mp < 8; ++mp) { \
            const f32x4 k4 = KV[mp]; \
            const float s0 = q[0][0] * k4.x + q[0][1] * k4.y + q[0][2] * k4.z + q[0][3] * k4.w, s1 = q[1][0] * k4.x + q[1][1] * k4.y + q[1][2] * k4.z + q[1][3] * k4.w; \
            const float s2 = q[2][0] * k4.x + q[2][1] * k4.y + q[2][2] * k4.z + q[2][3] * k4.w, s3 = q[3][0] * k4.x + q[3][1] * k4.y + q[3][2] * k4.z + q[3][3] * k4.w; \
            const bool u16 = (lane & 16) != 0, u8 = (lane & 8) != 0; \
            const float a = (u16 ? s2 : s0) + __shfl_xor(u16 ? s0 : s2, 16), c = (u16 ? s3 : s1) + __shfl_xor(u16 ? s1 : s3, 16); \
            float v = (u8 ? c : a) + __shfl_xor(u8 ? a : c, 8); \
            v += __shfl_xor(v, 4); v += __shfl_xor(v, 2); v += __shfl_xor(v, 1); \
            if ((lane & 7) == 0) sc[(2 * ((BT) * 8 + mp) + hf) * 4 + t_l] = v; } } while (0)
    {
        f32x4 kvA[8], kvB[8], kvC[8];
        SA_KLOAD(kvA, 0); SA_KLOAD(kvB, 1);
#pragma unroll 1
        for (int bt = 0; bt < NBT - 1; bt += 3) {
            SA_KLOAD(kvC, bt + 2); __builtin_amdgcn_sched_barrier(0); SA_KRED(kvA, bt);
            SA_KLOAD(kvA, bt + 3); __builtin_amdgcn_sched_barrier(0); SA_KRED(kvB, bt + 1);
            { const int bn = (bt + 4 < NBT) ? bt + 4 : NBT - 1; SA_KLOAD(kvB, bn); } __builtin_amdgcn_sched_barrier(0); SA_KRED(kvC, bt + 2);
        }
        SA_KRED(kvA, NBT - 1);
    }
#undef SA_KRED
#undef SA_KLOAD
    LDS_WAIT();
    float inv[4];
#pragma unroll
    for (int t = 0; t < 4; ++t) { float x[4]; float m = -3.0e38f;
#pragma unroll
        for (int j = 0; j < 4; ++j) { x[j] = sc[(lane + 64 * j) * 4 + t]; m = fmaxf(m, x[j]); }
        m = wave_max(m); float l = 0.f;
#pragma unroll
        for (int j = 0; j < 4; ++j) { const float p = __builtin_amdgcn_exp2f((x[j] - m) * L2E); l += p; sc[(lane + 64 * j) * 4 + t] = p; }
        inv[t] = 1.0f / wave_sum(l); }
    LDS_WAIT();
    f32x4 o[4];
#pragma unroll
    for (int t = 0; t < 4; ++t) o[t] = (f32x4){0.f, 0.f, 0.f, 0.f};
#define SA_VLOAD(VV, BT) do { _Pragma("unroll") for (int mp = 0; mp < 8; ++mp) VV[mp] = __builtin_nontemporal_load((const f32x4*)(vbase + (size_t)((BT) * 8 + mp) * 2 * XA)); } while (0)
#define SA_VACC(VV, BT) do { _Pragma("unroll") for (int mp = 0; mp < 8; ++mp) { const f32x4 pv = *(const LAS f32x4*)(sc + (2 * ((BT) * 8 + mp) + hf) * 4); \
            o[0] += VV[mp] * pv.x; o[1] += VV[mp] * pv.y; o[2] += VV[mp] * pv.z; o[3] += VV[mp] * pv.w; } } while (0)
    {
        f32x4 vvA[8], vvB[8], vvC[8];
        SA_VLOAD(vvA, 0); SA_VLOAD(vvB, 1);
#pragma unroll 1
        for (int bt = 0; bt < NBT - 1; bt += 3) {
            SA_VLOAD(vvC, bt + 2); __builtin_amdgcn_sched_barrier(0); SA_VACC(vvA, bt);
            SA_VLOAD(vvA, bt + 3); __builtin_amdgcn_sched_barrier(0); SA_VACC(vvB, bt + 1);
            { const int bn = (bt + 4 < NBT) ? bt + 4 : NBT - 1; SA_VLOAD(vvB, bn); } __builtin_amdgcn_sched_barrier(0); SA_VACC(vvC, bt + 2);
        }
        SA_VACC(vvA, NBT - 1);
    }
#undef SA_VACC
#undef SA_VLOAD
#pragma unroll
    for (int t = 0; t < 4; ++t)
#pragma unroll
        for (int e = 0; e < 4; ++e) o[t][e] += __shfl_xor(o[t][e], 32);
#pragma unroll
    for (int j = 0; j < 2; ++j) {
        const int t = 2 * hf + j; const bool up = hf != 0;
        const float iv = selv(up, inv[2 + j], inv[j]);
        f32x4 o0; o0.x = selv(up, o[2 + j].x, o[j].x); o0.y = selv(up, o[2 + j].y, o[j].y); o0.z = selv(up, o[2 + j].z, o[j].z); o0.w = selv(up, o[2 + j].w, o[j].w);
        const size_t row = (size_t)(MP + b * T_S + t);
        const u32x2 gw2 = *(const u32x2*)(Zb + row * ldz + goff + h * HD + 4 * dl);
        const float r0 = o0.x * iv * __uint_as_float(gw2.x << 16), r1 = o0.y * iv * __uint_as_float(gw2.x & 0xffff0000u), r2 = o0.z * iv * __uint_as_float(gw2.y << 16), r3 = o0.w * iv * __uint_as_float(gw2.y & 0xffff0000u);
        u32x2 w; w.x = cvtpk(r0, r1); w.y = cvtpk(r2, r3);
        *(u32x2*)(MIXp + row * MW + BR + h * HD + 4 * dl) = w;
    }
    LDS_WAIT();
}

DI void attn_sample_half(const bf16_t* Zb, const int ldz, const int qoff, const float* ck, const float* cv, LAS float* sc, LAS float* part, const int item, const int half, const int lane_in) {
    int lane_o = lane_in; asm volatile("" : "+v"(lane_o)); const int lane = lane_o;
    const int b = item >> 2, h = item & 3, hf = lane >> 5, dl = lane & 31;
    const float L2E = 1.4426950408889634f;
    float q[4][4];
#pragma unroll
    for (int t = 0; t < 4; ++t) { const u32x2 w = *(const u32x2*)(Zb + (size_t)(MP + b * T_S + t) * ldz + qoff + h * HD + 4 * dl);
        q[t][0] = __uint_as_float(w.x << 16); q[t][1] = __uint_as_float(w.x & 0xffff0000u); q[t][2] = __uint_as_float(w.y << 16); q[t][3] = __uint_as_float(w.y & 0xffff0000u); }
    const size_t kvo = ((size_t)(b * NMEM + 128 * half + hf)) * XA + h * HD + 4 * dl;
    const float* kbase = ck + kvo; const float* vbase = cv + kvo;
    const int t_l = ((lane >> 4) & 1) * 2 + ((lane >> 3) & 1);
#pragma unroll 1
    for (int bt = 0; bt < 2; ++bt) {
        f32x4 kv[32];
#pragma unroll
        for (int mp = 0; mp < 32; ++mp) kv[mp] = __builtin_nontemporal_load((const f32x4*)(kbase + (size_t)(bt * 32 + mp) * 2 * XA));
#pragma unroll
        for (int mp = 0; mp < 32; ++mp) {
            const f32x4 k4 = kv[mp];
            const float s0 = q[0][0] * k4.x + q[0][1] * k4.y + q[0][2] * k4.z + q[0][3] * k4.w, s1 = q[1][0] * k4.x + q[1][1] * k4.y + q[1][2] * k4.z + q[1][3] * k4.w;
            const float s2 = q[2][0] * k4.x + q[2][1] * k4.y + q[2][2] * k4.z + q[2][3] * k4.w, s3 = q[3][0] * k4.x + q[3][1] * k4.y + q[3][2] * k4.z + q[3][3] * k4.w;
            const bool u16 = (lane & 16) != 0, u8 = (lane & 8) != 0;
            const float a = (u16 ? s2 : s0) + __shfl_xor(u16 ? s0 : s2, 16), c = (u16 ? s3 : s1) + __shfl_xor(u16 ? s1 : s3, 16);
            float v = (u8 ? c : a) + __shfl_xor(u8 ? a : c, 8);
            v += __shfl_xor(v, 4); v += __shfl_xor(v, 2); v += __shfl_xor(v, 1);
            if ((lane & 7) == 0) sc[(2 * (bt * 32 + mp) + hf) * 4 + t_l] = v;
        }
    }
    LDS_WAIT();
    float mx[4], l[4];
#pragma unroll
    for (int t = 0; t < 4; ++t) { const float x0 = sc[lane * 4 + t], x1 = sc[(lane + 64) * 4 + t]; mx[t] = wave_max(fmaxf(x0, x1));
        const float p0 = __builtin_amdgcn_exp2f((x0 - mx[t]) * L2E), p1 = __builtin_amdgcn_exp2f((x1 - mx[t]) * L2E); l[t] = wave_sum(p0 + p1);
        sc[lane * 4 + t] = p0; sc[(lane + 64) * 4 + t] = p1; }
    LDS_WAIT();
    f32x4 o[4];
#pragma unroll
    for (int t = 0; t < 4; ++t) o[t] = (f32x4){0.f, 0.f, 0.f, 0.f};
#pragma unroll 1
    for (int bt = 0; bt < 2; ++bt) {
        f32x4 vv[32];
#pragma unroll
        for (int mp = 0; mp < 32; ++mp) vv[mp] = __builtin_nontemporal_load((const f32x4*)(vbase + (size_t)(bt * 32 + mp) * 2 * XA));
#pragma unroll
        for (int mp = 0; mp < 32; ++mp) { const f32x4 pv = *(const LAS f32x4*)(sc + (2 * (bt * 32 + mp) + hf) * 4); o[0] += vv[mp] * pv.x; o[1] += vv[mp] * pv.y; o[2] += vv[mp] * pv.z; o[3] += vv[mp] * pv.w; }
    }
#pragma unroll
    for (int t = 0; t < 4; ++t)
#pragma unroll
        for (int e = 0; e < 4; ++e) o[t][e] += __shfl_xor(o[t][e], 32);
    if (lane < 32) {
#pragma unroll
        for (int t = 0; t < 4; ++t) *(LAS f32x4*)(part + 8 + t * 128 + 4 * dl) = o[t]; }
    if (lane == 0) { *(LAS f32x4*)part = (f32x4){mx[0], mx[1], mx[2], mx[3]}; *(LAS f32x4*)(part + 4) = (f32x4){l[0], l[1], l[2], l[3]}; }
    LDS_WAIT();
}
DI void attn_sample_merge(const bf16_t* Zb, const int ldz, const int goff, bf16_t* MIXp, const LAS float* p0, const LAS float* p1, const int item, const int lane) {
    const int b = item >> 2, h = item & 3, hf = lane >> 5, dl = lane & 31; const float L2E = 1.4426950408889634f;
#pragma unroll
    for (int j = 0; j < 2; ++j) {
        const int t = 2 * hf + j;
        const float m0 = p0[t], l0 = p0[4 + t], m1 = p1[t], l1 = p1[4 + t];
        const f32x4 o0 = *(const LAS f32x4*)(p0 + 8 + t * 128 + 4 * dl), o1 = *(const LAS f32x4*)(p1 + 8 + t * 128 + 4 * dl);
        const float Mx = fmaxf(m0, m1), a0 = __builtin_amdgcn_exp2f((m0 - Mx) * L2E), a1 = __builtin_amdgcn_exp2f((m1 - Mx) * L2E);
        const float inv = 1.0f / (l0 * a0 + l1 * a1);
        const f32x4 os = (o0 * a0 + o1 * a1) * inv;
        const size_t row = (size_t)(MP + b * T_S + t);
        const u32x2 gw2 = *(const u32x2*)(Zb + row * ldz + goff + h * HD + 4 * dl);
        const float r0 = os.x * __uint_as_float(gw2.x << 16), r1 = os.y * __uint_as_float(gw2.x & 0xffff0000u), r2 = os.z * __uint_as_float(gw2.y << 16), r3 = os.w * __uint_as_float(gw2.y & 0xffff0000u);
        u32x2 w; w.x = cvtpk(r0, r1); w.y = cvtpk(r2, r3);
        *(u32x2*)(MIXp + row * MW + BR + h * HD + 4 * dl) = w;
    }
}
template <int LO, int HI> __global__ void __launch_bounds__(NTHR, 2) mega(Args args) {
    extern __shared__ __attribute__((aligned(16))) unsigned char lds_raw[];
    LAS unsigned char* lds = (LAS unsigned char*)lds_raw;
    const int tid = threadIdx.x, lane = tid & 63, wave = __builtin_amdgcn_readfirstlane(tid >> 6);
    const int G = gridDim.x, bx = blockIdx.x;
    const int vcu = (G % 8 == 0) ? (bx % 8) * (G / 8) + bx / 8 : bx;
    const int gw = vcu * NWAVES + wave, NGW = G * NWAVES;
    unsigned char* ws = args.ws;
    unsigned* ctl = (unsigned*)(ws + WS_CTL);
    volatile LAS unsigned* MISC = (volatile LAS unsigned*)(lds + MISC_OFF);
    for (int u = tid; u < (LDS_BYTES - RING_BYTES) / 4; u += NTHR) ((LAS unsigned*)(lds + RING_BYTES))[u] = 0u;
    __syncthreads();
    XcdBarrier bar; bar.bar = ctl + CW_BAR; bar.x = 0; bar.st = nullptr;
    if constexpr (HI - LO > 1) bar = xcd_barrier_post(ctl + CW_BAR, MISC + 8);
#define IN(k) (LO <= (k) && (k) < HI)
#define SEAM(k) do { if constexpr (IN(k) && IN((k) + 1)) xcd_barrier(bar); } while (0)

#define x_prompt (args.in[0])
#define x_sample (args.in[1])
#define cache_k (args.in[2])
#define cache_v (args.in[3])
#define st_re (args.in[4])
#define st_im (args.in[5])
#define mem_prompt (args.in[6])
#define w_in_a (args.in[7])
#define ln_v_g (args.in[8])
#define ln_v_b (args.in[9])
#define w_spatial (args.in[10])
#define b_spatial (args.in[11])
#define w_in_b (args.in[12])
#define lam_re (args.in[13])
#define lam_im (args.in[14])
#define log_dt (args.in[15])
#define sb_re (args.in[16])
#define sb_im (args.in[17])
#define sc_re (args.in[18])
#define sc_im (args.in[19])
#define ssm_d (args.in[20])
#define w_glu (args.in[21])
#define b_glu (args.in[22])
#define mem_norm_g (args.in[23])
#define w_mem_k (args.in[24])
#define w_mem_v (args.in[25])
#define w_out (args.in[26])
#define pre_g (args.in[27])
#define post_g (args.in[28])
#define out (args.out)
#define WinA ((bf16_t*)(ws + WS_WINA))
#define WinB ((bf16_t*)(ws + WS_WINB))
#define Wglu ((bf16_t*)(ws + WS_WGLU))
#define Wout0 ((bf16_t*)(ws + WS_WOUT0))
#define Wout1 ((bf16_t*)(ws + WS_WOUT1))
#define Wmem ((bf16_t*)(ws + WS_WMEM))
#define MEMN ((bf16_t*)(ws + WS_MEMN))
#define KVBF ((bf16_t*)(ws + WS_KVBF))
#define VTB ((bf16_t*)(ws + WS_VT))
#define SMALL ((float*)(ws + WS_SMALL))
#define XN ((bf16_t*)(ws + WS_XN))
#define Z ((bf16_t*)(ws + WS_Z))
#define YG ((bf16_t*)(ws + WS_YG))
#define MIX ((bf16_t*)(ws + WS_MIX))
#define OUT ((bf16_t*)(ws + WS_OUT))
#define PART ((float*)(ws + WS_PART))
#define Y1 ((bf16_t*)(ws + WS_Y1))
#define VSTAT (SMALL + SM_VSTAT)
#define SS0 (SMALL + SM_SS0)
#define SS1 (SMALL + SM_SS1)
#define SS2 (SMALL + SM_SS2)
#define LB (SMALL + SM_LB)
#define BB (SMALL + SM_BB)
#define BBT ((bf16_t*)(SMALL + SM_BBT))
#define CTT ((bf16_t*)(SMALL + SM_CT))

    if constexpr (IN(0)) {
        LAS float* scr = (LAS float*)(lds + wave * 16384);
        constexpr int I_A = (D / 64) * (NA / 32), I_B = (D / 64) * (NBW / 32), I_G = (BR / 64) * (BR / 32), I_O = (MW / 64) * (D / 32), I_M = (D / 64) * (XA / 32);
        constexpr int NITEMS = I_A + I_B + I_O + 4 * I_M;
        for (int it = gw; it < NITEMS; it += NGW) {
            int r = it;
            if (r < I_A) { const int nb = r % (NA / 32), n_src = 32 * nb;
                const int n_dst = (n_src < BR) ? (n_src >> 7) * 256 + (n_src & 127)
                                : (n_src < 2 * BR) ? 2 * BR + (n_src - BR)
                                : (n_src < 2 * BR + XA) ? 3 * BR + (n_src - 2 * BR)
                                : (n_src < 3 * BR + XA) ? ((n_src - 2 * BR - XA) >> 7) * 256 + 128 + ((n_src - 2 * BR - XA) & 127)
                                : n_src;
                p0_transpose_item(w_in_a, pre_g, D, NA, WinA, n_dst - n_src, scr, r, lane); continue; } r -= I_A;
            if (r < I_B) { p0_transpose_item(w_in_b, pre_g + D, D, NBW, WinB, 0, scr, r, lane); continue; } r -= I_B;
            if (r < I_O) { p0_transpose_item(w_out, nullptr, MW, D, Wout0, 0, scr, r, lane); continue; } r -= I_O;
            const int which = r / I_M; r -= which * I_M;
            const int layer = which >> 1; const float* wsrc = ((which & 1) ? w_mem_v : w_mem_k) + (size_t)layer * D * XA;
            p0_transpose_item(wsrc, mem_norm_g + layer * D, D, XA, Wmem, which * XA, scr, r, lane);
        }
        for (int m0 = gw; m0 < M + MMEM; m0 += 2 * NGW) {
            const float* src[2]; bf16_t* dst[2]; f32x4 v[2][4]; float ss[2];
#pragma unroll
            for (int q = 0; q < 2; ++q) { int m = m0 + q * NGW; if (m >= M + MMEM) m = m0;
                src[q] = (m < MP) ? x_prompt + (size_t)m * D : (m < M) ? x_sample + (size_t)(m - MP) * D : mem_prompt + (size_t)(m - M) * D;
                dst[q] = (m < M) ? XN + (size_t)m * D : MEMN + (size_t)(m - M) * D; }
#pragma unroll
            for (int q = 0; q < 2; ++q)
#pragma unroll
                for (int j = 0; j < 4; ++j) v[q][j] = __builtin_nontemporal_load((const f32x4*)src[q] + lane + 64 * j);
#pragma unroll
            for (int q = 0; q < 2; ++q) { float s2 = 0.f;
#pragma unroll
                for (int j = 0; j < 4; ++j) s2 += (v[q][j].x * v[q][j].x + v[q][j].y * v[q][j].y) + (v[q][j].z * v[q][j].z + v[q][j].w * v[q][j].w);
                ss[q] = 1.0f / sqrtf(wave_sum(s2) * (1.f / D) + EPS); }
#pragma unroll
            for (int q = 0; q < 2; ++q) { unsigned long long* o8 = (unsigned long long*)dst[q] + lane;
#pragma unroll
                for (int j = 0; j < 4; ++j) o8[64 * j] = (unsigned long long)pk2(v[q][j].x * ss[q], v[q][j].y * ss[q]) | ((unsigned long long)pk2(v[q][j].z * ss[q], v[q][j].w * ss[q]) << 32); }
        }
        for (size_t i = (size_t)bx * NTHR + tid; i < SM_ZERO_END; i += (size_t)G * NTHR) SMALL[i] = 0.f;
        for (int e = bx * NTHR + tid; e < SG * SP * SC; e += G * NTHR) {
            const int i = e / SC, c = e % SC, g = i / SP, p = i % SP; const float dt = expf(log_dt[g]); const float lr = lam_re[i], li = lam_im[i];
            const float ar = lr * dt, ai = li * dt; const float ex = expf(ar), cs = cosf(ai), sn = sinf(ai);
            const float lbr = ex * cs, lbi = ex * sn; if (c == 0) { LB[2 * i] = lbr; LB[2 * i + 1] = lbi; }
            const float sh = sinf(0.5f * ai); const float nr = expm1f(ar) * cs - 2.0f * sh * sh, ni = lbi;
            const float den = lr * lr + li * li; const float qr = (nr * lr + ni * li) / den, qi = (ni * lr - nr * li) / den;
            const float br = sb_re[(size_t)i * SC + c], bi = sb_im[(size_t)i * SC + c];
            const float xr = qr * br - qi * bi, xi = qr * bi + qi * br;
            BB[((size_t)i * SC + c) * 2] = xr; BB[((size_t)i * SC + c) * 2 + 1] = xi;
            BBT[((size_t)g * 128 + p) * SC + c] = (bf16_t)f2bf(xr); BBT[((size_t)g * 128 + 64 + p) * SC + c] = (bf16_t)f2bf(xi);
            CTT[((size_t)g * SC + c) * 128 + p] = (bf16_t)f2bf(sc_re[((size_t)g * SC + c) * SP + p]); CTT[((size_t)g * SC + c) * 128 + 64 + p] = (bf16_t)f2bf(-sc_im[((size_t)g * SC + c) * SP + p]);
        }
    }
    SEAM(0);

    if constexpr (IN(1)) {
        pg8::MultiOrder S; S.init(XN, WinA, M, NA, MEMN, Wmem, MMEM, 2 * 2 * XA, D, G, bx);
        EpiInProj E{Z, ZA, VSTAT, 12, 18, 20, 0, 0.08838834764831845f, out + O_MK, out + O_MV, KVBF, VTB, 1};
        pg8::gemm_phase<EpiInProj, pg8::MultiOrder, PG8_ALIGN, PG8_SP2>(lds, D, S, E);
    }
    SEAM(1);

    if constexpr (IN(2)) {
        spatial_phase(Z, VSTAT, ln_v_g, ln_v_b, w_spatial, b_spatial, MIX, lds, vcu, G, tid, wave, lane);
        __syncthreads();
        for (int i = bx * NTHR + tid; i < NB_S * BR; i += G * NTHR) {
            const int b = i / BR, col = i % BR, g = col / AD; float vn[4];
#pragma unroll
            for (int t = 0; t < 4; ++t) { const int row = MP + b * 4 + t; const float v = bf2f(Z[(size_t)row * ZA + BR + col]); const float mean = VSTAT[2 * row] * (1.f / BR); const float var = VSTAT[2 * row + 1] * (1.f / BR) - mean * mean;
                vn[t] = (v - mean) * (1.0f / sqrtf(var + EPS)) * ln_v_g[col] + ln_v_b[col]; out[O_CV + (size_t)(b * 4 + t) * BR + col] = vn[t]; }
#pragma unroll
            for (int t = 0; t < 4; ++t) { float mx = b_spatial[g * CH + t];
#pragma unroll
                for (int s = 0; s < 4; ++s) if (s <= t) mx += w_spatial[(size_t)g * CH * CH + t * CH + s] * vn[s];
                const int row = MP + b * 4 + t; const bf16_t* zr = Z + (size_t)row * ZA;
                MIX[(size_t)row * MW + col] = (bf16_t)f2bf(bf2f(zr[col]) * mx); }
        }
        __syncthreads();
        {
            LAS float* parts = (LAS float*)(lds + RING_BYTES + 4096);
            if (wave < 4) { const int item = 2 * vcu + (wave >> 1); if (item < NB_S * NH) attn_sample_half(Z, ZA, 2 * BR, cache_k, cache_v, parts + wave * 576, parts + wave * 576, item, wave & 1, lane); }
            else { unsigned ep = 0; for (int u = vcu; u < NB_P * NH * 8; u += G, ++ep)
                       attn_prompt_unit4(Z, ZA, 2 * BR, 2 * BR + XA, KVBF, VTB, MIX, lds, (volatile LAS unsigned*)(lds + RING_BYTES + 2048 + 256), ep, u, tid - 256, wave - 4, lane); }
            __syncthreads();
            if (wave < 2) { const int item = 2 * vcu + wave; if (item < NB_S * NH) attn_sample_merge(Z, ZA, 2 * BR + XA, MIX, parts + (2 * wave) * 576, parts + (2 * wave + 1) * 576, item, lane); }
        }
    }
    SEAM(2);

    if constexpr (IN(3)) {
        pg8::MultiOrder S; S.init(MIX, Wout0, MP, D, MIX + (size_t)MP * MW, Wout0, MS, D, MW, G, bx, KSPLIT);
        EpiOutFused2 E{x_prompt, post_g, Y1, XN, SS0, SS2, ctl + CW_PANEL + 4096, ctl + CW_PANEL + 8192, PART, ctl + CW_SUB};
        pg8::gemm_phase<EpiOutFused2, pg8::MultiOrder, PG8_ALIGN, PG8_SP2>(lds, MW, S, E);
    }
    const bool fastseam = (G == 256);
    if constexpr (IN(3) && IN(4)) { if (!fastseam) xcd_barrier(bar); else if (bx < 64) { publish_wg(ctl + CW_SUB + 64 * (bx >> 5)); wait_subunits(ctl + CW_SUB + 64 * (bx >> 5), (D / 256) * KSPLIT); } } else SEAM(3);

    if constexpr (IN(4)) {
        constexpr int NR = 1;
        const int m_first = fastseam ? ((bx < 64) ? MP + (bx >> 5) * 256 + (bx & 31) * 8 + wave : M) : MP + gw, m_step = fastseam ? M : NR * NGW;
        for (int m0 = m_first; m0 < M; m0 += m_step) {
            f32x4 ov[NR][4], xv[NR][4]; float so[NR]; int mm[NR];
#pragma unroll
            for (int q = 0; q < NR; ++q) { const int m = m0 + q * NGW; mm[q] = m;
                if (m >= M) {
#pragma unroll
                    for (int j = 0; j < 4; ++j) { xv[q][j] = (f32x4){0.f, 0.f, 0.f, 0.f}; ov[q][j] = xv[q][j]; }
                    continue; }
                const float* xr = (m < MP) ? x_prompt + (size_t)m * D : x_sample + (size_t)(m - MP) * D;
#pragma unroll
                for (int j = 0; j < 4; ++j) { xv[q][j] = ((const f32x4*)xr)[lane + 64 * j];
                    if (m < MP) { const u32x2 w = ((const u32x2*)(OUT + (size_t)m * D))[lane + 64 * j]; ov[q][j] = (f32x4){__uint_as_float(w.x << 16), __uint_as_float(w.x & 0xffff0000u), __uint_as_float(w.y << 16), __uint_as_float(w.y & 0xffff0000u)}; }
                    else { ov[q][j] = (f32x4){0.f, 0.f, 0.f, 0.f};
#pragma unroll
                        for (int ks = 0; ks < KSPLIT; ++ks) ov[q][j] += ((const f32x4*)(PART + ((size_t)ks * MS + (m - MP)) * D))[lane + 64 * j]; } } }
#pragma unroll
            for (int q = 0; q < NR; ++q) { float a = 0.f;
#pragma unroll
                for (int j = 0; j < 4; ++j) a += (ov[q][j].x * ov[q][j].x + ov[q][j].y * ov[q][j].y) + (ov[q][j].z * ov[q][j].z + ov[q][j].w * ov[q][j].w);
                so[q] = a; }
#pragma unroll
            for (int q = 0; q < NR; ++q) so[q] = wave_sum(so[q]);
            float s1[NR];
#pragma unroll
            for (int q = 0; q < NR; ++q) { const float rs = 1.0f / sqrtf(so[q] * (1.f / D) + EPS); float a = 0.f;
#pragma unroll
                for (int j = 0; j < 4; ++j) { const f32x4 gv = ((const f32x4*)post_g)[lane + 64 * j]; const f32x4 v = xv[q][j] + ov[q][j] * rs * gv; xv[q][j] = v;
                    u32x2 w; w.x = pk2(v.x, v.y); w.y = pk2(v.z, v.w); if (mm[q] < M) ((u32x2*)(Y1 + (size_t)mm[q] * D))[lane + 64 * j] = w;
                    a += (v.x * v.x + v.y * v.y) + (v.z * v.z + v.w * v.w); }
                s1[q] = a; }
#pragma unroll
            for (int q = 0; q < NR; ++q) s1[q] = wave_sum(s1[q]);
#pragma unroll
            for (int q = 0; q < NR; ++q) { if (mm[q] >= M) continue; const float rs1 = 1.0f / sqrtf(s1[q] * (1.f / D) + EPS); unsigned long long* o8 = (unsigned long long*)(XN + (size_t)mm[q] * D) + lane;
#pragma unroll
                for (int j = 0; j < 4; ++j) o8[64 * j] = (unsigned long long)pk2(xv[q][j].x * rs1, xv[q][j].y * rs1) | ((unsigned long long)pk2(xv[q][j].z * rs1, xv[q][j].w * rs1) << 32); }
        }
    }
    SEAM(4);

    if constexpr (IN(5)) {
        pg8::MultiOrder S; S.init(XN, WinB, M, NBW, XN, WinB, 0, 0, D, G, bx);
        EpiInProj E{Z, NBW, VSTAT, BR / 256, BR / 256, (BR + XA) / 256, 1, 0.08838834764831845f, out + O_MK, out + O_MV, KVBF, VTB, 0};
        pg8::gemm_phase<EpiInProj, pg8::MultiOrder, PG8_ALIGN, PG8_SP2>(lds, D, S, E);
    }
    SEAM(5);

    if constexpr (IN(6)) {
        constexpr int NCA = SG * 4 - 256, NCB = 256 - NCA;
        const int slot = wave >> 2, pitem = vcu + 256 * slot, role = (slot == 0) ? (wave & 3) : ((wave + 2) & 3);
        LAS unsigned char* half = lds + slot * 65536;
        LAS unsigned char* wl = half + (wave & 3) * ((slot == 0) ? S5_IMG : 16384);
        volatile LAS unsigned* fl = (volatile LAS unsigned*)(lds + RING_BYTES + 2048 + slot * 64);
        if (pitem < SG * 4) {
            if (role == 0) { __builtin_amdgcn_s_setprio(3); s5_prod<0>(Z, BBT, LB, out + O_HPR, out + O_HPI, half, fl, pitem, lane); }
            else if (role == 1) { __builtin_amdgcn_s_setprio(3); s5_prod<1>(Z, BBT, LB, out + O_HPR, out + O_HPI, half, fl, pitem, lane); }
            else { __builtin_amdgcn_s_setprio(1); s5_cons(CTT, ssm_d, YG, half, fl, pitem, role - 2, lane); }
            __builtin_amdgcn_s_setprio(0);
        } else {
            for (int it = (vcu - NCA) + NCB * (wave - 4); it < NB_S * NH; it += 4 * NCB)
                attn_sample_item(Z, NBW, BR, BR + XA + BR, cache_k + (size_t)NB_S * NMEM * XA, cache_v + (size_t)NB_S * NMEM * XA, MIX, (LAS float*)wl, it, lane);
        }
        team_sync(fl + 8, 4u, lane);
        attn_prompt_unit_kv(Z, NBW, BR, BR + XA + BR, KVBF + 2ull * MMEM * XA, VTB + (size_t)NB_P * NH * HD * NMEM, MIX, half, fl + 9, 0u, vcu + 256 * slot, tid & 255, wave & 3, lane);
        {
            constexpr int N_SS = SG * 16 / 2, N_TG = (BR / 64) * (BR / 32) / 4, N_TO = (MW / 64) * (D / 32) / 4;
            LAS unsigned* wq = (LAS unsigned*)(lds + RING_BYTES + 2048 + 128);
            for (;;) {
                unsigned tk = 0; if (lane == 0) tk = __hip_atomic_fetch_add(wq, 1u, __ATOMIC_RELAXED, __HIP_MEMORY_SCOPE_WORKGROUP);
                const int it = __builtin_amdgcn_readfirstlane((int)tk) * 256 + vcu;
                if (it >= N_SS + N_TG + N_TO) break;
                if (it < N_SS) {
#pragma unroll 1
                    for (int q = 0; q < 2; ++q) s5_item<true>(Z, BBT, CTT, LB, ssm_d, st_re, st_im, out + O_HSR, out + O_HSI, YG, wl, 2 * it + q, lane); }
                else if (it < N_SS + N_TG) {
#pragma unroll 1
                    for (int q = 0; q < 4; ++q) p0_transpose_item(w_glu, nullptr, BR, BR, Wglu, 0, (LAS float*)wl, 4 * (it - N_SS) + q, lane); }
                else {
#pragma unroll 1
                    for (int q = 0; q < 4; ++q) p0_transpose_item(w_out + (size_t)MW * D, nullptr, MW, D, Wout1, 0, (LAS float*)wl, 4 * (it - N_SS - N_TG) + q, lane); }
            }
        }
    }
    SEAM(6);

    if constexpr (IN(8)) {
        pg8::MultiOrder S; S.init(YG, Wglu, M, BR, YG, Wglu, 0, 0, BR, G, bx);
        EpiGlu E{YG, Z, b_glu, MIX};
        pg8::gemm_phase<EpiGlu, pg8::MultiOrder, PG8_ALIGN, PG8_SP2>(lds, BR, S, E);
    }
    SEAM(8);

    if constexpr (IN(9)) {
        pg8::MultiOrder S; S.init(MIX, Wout1, MP, D, MIX + (size_t)MP * MW, Wout1, MS, D, MW, G, bx, KSPLIT);
        EpiOutFused E{Y1, post_g + D, out + O_Y, SS1, ctl + CW_PANEL, PART, ctl + CW_SUB + 128};
        pg8::gemm_phase<EpiOutFused, pg8::MultiOrder, PG8_ALIGN, PG8_SP2>(lds, MW, S, E);
    }
    if constexpr (IN(9) && IN(10)) { if (!fastseam) xcd_barrier(bar); else if (bx < 64) { publish_wg(ctl + CW_SUB + 128 + 64 * (bx >> 5)); wait_subunits(ctl + CW_SUB + 128 + 64 * (bx >> 5), (D / 256) * KSPLIT); } } else SEAM(9);

    if constexpr (IN(10)) {
        constexpr int NR = 1;
        const int m_first = fastseam ? ((bx < 64) ? MP + (bx >> 5) * 256 + (bx & 31) * 8 + wave : M) : MP + gw, m_step = fastseam ? M : NR * NGW;
        for (int m0 = m_first; m0 < M; m0 += m_step) {
            f32x4 ov[NR][4]; u32x2 yw[NR][4]; float so[NR]; int mm[NR];
#pragma unroll
            for (int q = 0; q < NR; ++q) { const int m = m0 + q * NGW; mm[q] = m;
                if (m >= M) {
#pragma unroll
                    for (int j = 0; j < 4; ++j) { ov[q][j] = (f32x4){0.f, 0.f, 0.f, 0.f}; yw[q][j] = (u32x2){0u, 0u}; }
                    continue; }
#pragma unroll
                for (int j = 0; j < 4; ++j) { yw[q][j] = ((const u32x2*)(Y1 + (size_t)m * D))[lane + 64 * j];
                    if (m < MP) { const u32x2 w = ((const u32x2*)(OUT + (size_t)m * D))[lane + 64 * j]; ov[q][j] = (f32x4){__uint_as_float(w.x << 16), __uint_as_float(w.x & 0xffff0000u), __uint_as_float(w.y << 16), __uint_as_float(w.y & 0xffff0000u)}; }
                    else { ov[q][j] = (f32x4){0.f, 0.f, 0.f, 0.f};
#pragma unroll
                        for (int ks = 0; ks < KSPLIT; ++ks) ov[q][j] += ((const f32x4*)(PART + ((size_t)ks * MS + (m - MP)) * D))[lane + 64 * j]; } } }
#pragma unroll
            for (int q = 0; q < NR; ++q) { float a = 0.f;
#pragma unroll
                for (int j = 0; j < 4; ++j) a += (ov[q][j].x * ov[q][j].x + ov[q][j].y * ov[q][j].y) + (ov[q][j].z * ov[q][j].z + ov[q][j].w * ov[q][j].w);
                so[q] = a; }
#pragma unroll
            for (int q = 0; q < NR; ++q) so[q] = wave_sum(so[q]);
#pragma unroll
            for (int q = 0; q < NR; ++q) { if (mm[q] >= M) continue; const float rs = 1.0f / sqrtf(so[q] * (1.f / D) + EPS);
#pragma unroll
                for (int j = 0; j < 4; ++j) { const f32x4 yv = {__uint_as_float(yw[q][j].x << 16), __uint_as_float(yw[q][j].x & 0xffff0000u), __uint_as_float(yw[q][j].y << 16), __uint_as_float(yw[q][j].y & 0xffff0000u)}, gv = ((const f32x4*)(post_g + D))[lane + 64 * j];
                    ((f32x4*)(out + O_Y + (size_t)mm[q] * D))[lane + 64 * j] = yv + ov[q][j] * rs * gv; } }
        }
    }
#undef IN
#undef SEAM
}
#undef x_prompt
#undef x_sample
#undef cache_k
#undef cache_v
#undef st_re
#undef st_im
#undef mem_prompt
#undef w_in_a
#undef ln_v_g
#undef ln_v_b
#undef w_spatial
#undef b_spatial
#undef w_in_b
#undef lam_re
#undef lam_im
#undef log_dt
#undef sb_re
#undef sb_im
#undef sc_re
#undef sc_im
#undef ssm_d
#undef w_glu
#undef b_glu
#undef mem_norm_g
#undef w_mem_k
#undef w_mem_v
#undef w_out
#undef pre_g
#undef post_g
#undef out
#undef WinA
#undef WinB
#undef Wglu
#undef Wout0
#undef Wout1
#undef Wmem
#undef MEMN
#undef KVBF
#undef VTB
#undef SMALL
#undef XN
#undef Z
#undef YG
#undef MIX
#undef OUT
#undef PART
#undef Y1
#undef VSTAT
#undef SS0
#undef SS1
#undef SS2
#undef LB
#undef BB
#undef BBT
#undef CTT

template <int LO, int HI> static bool prep_kernel() {
    return hipFuncSetAttribute((const void*)mega<LO, HI>, hipFuncAttributeMaxDynamicSharedMemorySize, LDS_BYTES) == hipSuccess;
}
template <int LO, int HI> static void launch_ph(int grid, hipStream_t stream, const Args& a) { hipLaunchKernelGGL((mega<LO, HI>), dim3(grid), dim3(NTHR), LDS_BYTES, stream, a); }
extern "C" void kernel_launch(void* const* d_in, const int* in_sizes, int n_in, void* d_out, int out_size, void* d_ws, size_t ws_size, hipStream_t stream) {
    static int grid = 0;
    if (grid == 0) {
        if (n_in != 29 || (size_t)out_size != O_END || ws_size < WS_END) { fprintf(stderr, "kernel_launch: unexpected shapes (n_in %d out %d ws %zu)\n", n_in, out_size, ws_size); grid = -1; return; }
        int dev = 0, cus = 0;
        if (hipGetDevice(&dev) != hipSuccess || hipDeviceGetAttribute(&cus, hipDeviceAttributeMultiprocessorCount, dev) != hipSuccess) { grid = -1; return; }
        bool ok = true;
#if MK_N_LAUNCHES == 1
        ok = prep_kernel<0, 11>();
        int per_cu = 0;
        if (hipOccupancyMaxActiveBlocksPerMultiprocessor(&per_cu, (const void*)mega<0, 11>, NTHR, LDS_BYTES) != hipSuccess || per_cu < 1) { fprintf(stderr, "kernel_launch: occupancy query says %d blocks per CU\n", per_cu); }
#else
        ok = prep_kernel<0, 1>() && prep_kernel<1, 2>() && prep_kernel<2, 3>() && prep_kernel<3, 4>() && prep_kernel<4, 5>() && prep_kernel<5, 6>() && prep_kernel<6, 7>() && prep_kernel<7, 8>() && prep_kernel<8, 9>() && prep_kernel<9, 10>() && prep_kernel<10, 11>();
#endif
        if (!ok) { fprintf(stderr, "kernel_launch: hipFuncSetAttribute failed\n"); grid = -1; return; }
        (void)hipGetLastError();
        grid = cus;
    }
    if (grid < 0) return;
    (void)hipMemsetAsync((char*)d_ws + WS_CTL, 0, CTL_ZERO_BYTES, stream);
    Args a{};
    for (int i = 0; i < 29; ++i) a.in[i] = (const float*)d_in[i];
    a.out = (float*)d_out; a.ws = (unsigned char*)d_ws;
#if MK_N_LAUNCHES == 1
    launch_ph<0, 11>(grid, stream, a);
#else
    launch_ph<0, 1>(grid, stream, a); launch_ph<1, 2>(grid, stream, a); launch_ph<2, 3>(grid, stream, a); launch_ph<3, 4>(grid, stream, a); launch_ph<4, 5>(grid, stream, a);
    launch_ph<5, 6>(grid, stream, a); launch_ph<6, 7>(grid, stream, a); launch_ph<7, 8>(grid, stream, a); launch_ph<8, 9>(grid, stream, a); launch_ph<9, 10>(grid, stream, a); launch_ph<10, 11>(grid, stream, a);
#endif
}
```

```cpp
#include <hip/hip_runtime.h>
#include <cstdio>
#include <cstdint>

#ifndef MK_N_LAUNCHES
#define MK_N_LAUNCHES 1
#endif

#define DI __device__ __forceinline__
#define GAS __attribute__((address_space(1)))
#define LAS __attribute__((address_space(3)))
typedef unsigned short bf16_t;
typedef short bf16x8 __attribute__((ext_vector_type(8)));
typedef float f32x4 __attribute__((ext_vector_type(4)));
typedef float f32x2 __attribute__((ext_vector_type(2)));
typedef unsigned u32x4 __attribute__((ext_vector_type(4)));
typedef unsigned u32x2 __attribute__((ext_vector_type(2)));

constexpr int D = 1024, NB_P = 8, T_P = 2048, MP = NB_P * T_P, NB_S = 128, T_S = 4, MS = NB_S * T_S, M = MP + MS;
constexpr int BR = 1536, XA = 512, MW = 2048, NA = 2 * BR + XA + MW  , NBW = BR + XA + MW  ;
constexpr int ZA = 2 * BR + 2 * XA;
constexpr int NMEM = 256, CH = 128, AG = 8, AD = 192, SG = 96, SC = 16, SP = 64, NH = 4, HD = 128;
constexpr int MMEM = NB_P * NMEM;
constexpr float EPS = 1e-6f;
constexpr size_t O_Y = 0, O_MK = (size_t)M * D, O_MV = O_MK + 2ull * MMEM * XA, O_HPR = O_MV + 2ull * MMEM * XA, O_HPI = O_HPR + (size_t)NB_P * SG * SP,
                 O_HSR = O_HPI + (size_t)NB_P * SG * SP, O_HSI = O_HSR + (size_t)NB_S * SG * SP, O_CV = O_HSI + (size_t)NB_S * SG * SP, O_END = O_CV + (size_t)MS * BR;
static_assert(O_END == 23953408ull, "output size");

constexpr size_t MiB = 1u << 20;
constexpr size_t WS_CTL = 0, CTL_ZERO_BYTES = 1 * MiB;
constexpr size_t WS_WINA = 2 * MiB;
constexpr size_t WS_WINB = 13 * MiB;
constexpr size_t WS_WGLU = 21 * MiB;
constexpr size_t WS_WOUT0 = 26 * MiB, WS_WOUT1 = 30 * MiB;
constexpr size_t WS_WMEM = 34 * MiB;
constexpr size_t WS_MEMN = 38 * MiB;
constexpr size_t WS_KVBF = 42 * MiB;
constexpr size_t WS_SMALL = 50 * MiB;
constexpr size_t WS_XN = 52 * MiB;
constexpr size_t WS_Z = 86 * MiB;
constexpr size_t WS_YG = WS_Z + (size_t)M * NBW * 2;
constexpr size_t WS_MIX = 268 * MiB;
constexpr size_t WS_OUT = 334 * MiB;
constexpr size_t WS_Y1 = 400 * MiB;
constexpr size_t WS_VT = 466 * MiB;
constexpr size_t WS_PART = 470 * MiB;
constexpr size_t WS_UG = 334 * MiB;
constexpr size_t WS_END = 486 * MiB;
static_assert(WS_Z + (size_t)M * NA * 2 <= WS_MIX && WS_YG + (size_t)M * BR * 2 <= WS_MIX && WS_XN + (size_t)M * D * 2 <= WS_Z, "ws map");
constexpr size_t SM_VSTAT = 0;
constexpr size_t SM_SS0 = SM_VSTAT + 2 * (size_t)M;
constexpr size_t SM_SS1 = SM_SS0 + M;
constexpr size_t SM_SS2 = SM_SS1 + M;
constexpr size_t SM_ZERO_END = SM_SS2 + M;
constexpr size_t SM_LB = SM_ZERO_END;
constexpr size_t SM_BB = SM_LB + (size_t)SG * SP * 2;
constexpr size_t SM_BBT = SM_BB + (size_t)SG * SP * SC * 2;
constexpr size_t SM_CT = SM_BBT + (size_t)SG * 128 * SC / 2;
constexpr size_t SM_END = SM_CT + (size_t)SG * 128 * SC / 2;
static_assert(SM_END * 4 <= 2 * MiB, "small region");
constexpr int CW_BAR = 4096;
constexpr int CW_SUB = 30720;
constexpr int CW_PANEL = 16384;
constexpr int KSPLIT = 8;

DI float bf2f(bf16_t v) { return __uint_as_float(((unsigned)v) << 16); }
DI unsigned f2bf(float f) { unsigned u = __float_as_uint(f); return (u + 0x7fffu + ((u >> 16) & 1u)) >> 16; }
DI unsigned pk2(float lo, float hi) { return f2bf(lo) | (f2bf(hi) << 16); }
DI float wave_sum(float v) {
#pragma unroll
    for (int o = 1; o < 64; o <<= 1) v += __shfl_xor(v, o);
    return v;
}
DI float wave_max(float v) {
#pragma unroll
    for (int o = 1; o < 64; o <<= 1) v = fmaxf(v, __shfl_xor(v, o));
    return v;
}
DI float gelu_tanh(float x) {
    const float t = x * (1.0f + 0.044715f * x * x);
    const float e = __builtin_amdgcn_exp2f(t * (-2.0f * 0.7978845608028654f * 1.4426950408889634f));
    return x * __builtin_amdgcn_rcpf(1.0f + e);
}
DI float silu_f(float x) { return x * __builtin_amdgcn_rcpf(1.0f + __builtin_amdgcn_exp2f(x * -1.4426950408889634f)); }
DI float sigmoid_f(float x) { return __builtin_amdgcn_rcpf(1.0f + __builtin_amdgcn_exp2f(x * -1.4426950408889634f)); }
#define LDS_WAIT() asm volatile("s_waitcnt lgkmcnt(0)" ::: "memory")
#define VM_WAIT() asm volatile("s_waitcnt vmcnt(0)" ::: "memory")

namespace pg8 {
constexpr int BM = 256, BK = 64, HALF = 128, HTB = HALF * BK * 2, STAGE_BYTES = 8 * HTB, NXCD = 8, WGM = 8;
__host__ __device__ __forceinline__ int lds_byte(int r, int c) { const int st = (r >> 4) * 2 + (c >> 5), rr = r & 15, cc = c & 31, ob = rr * 64 + cc * 2; return st * 1024 + (ob ^ (((ob >> 9) & 1) << 5)); }
__host__ __device__ __forceinline__ void stage_rc(int b, int& R, int& C) { const int st = b / 1024, sb = b % 1024, swz = sb ^ (((sb >> 9) & 1) << 5); R = (st >> 1) * 16 + swz / 64; C = (st & 1) * 32 + (swz % 64) / 2; }
__host__ __device__ __forceinline__ int perm32(int rho) { const int n = rho >> 4, i = rho & 15; return 8 * (i >> 2) + 4 * n + (i & 3); }

struct Unit { int pm, pn, gi, ks; };

struct MultiOrder {
    const bf16_t* A0; const bf16_t* B0; const bf16_t* A1; const bf16_t* B1;
    int nM0, nN0, nM1, nN1, n0, n1, ntot, G, c, KS, nt0, nt1, sf; size_t tstep, tstep1, tstepA;
    DI void init(const bf16_t* a0, const bf16_t* b0, int M0, int N0, const bf16_t* a1, const bf16_t* b1, int M1, int N1, int K, int G_, int c_, int KS1 = 1) {
        A0 = a0; B0 = b0; A1 = a1; B1 = b1; nM0 = M0 / BM; nN0 = N0 / BM; nM1 = M1 / BM; nN1 = N1 / BM; n0 = nM0 * nN0; KS = KS1; n1 = nM1 * nN1 * KS1; ntot = n0 + n1; G = G_; c = c_; tstep = (size_t)BM * K * 2; tstep1 = tstep; tstepA = tstep;
        nt0 = K / BK; nt1 = K / BK / KS1; sf = 0;
    }
    DI void init2k(const bf16_t* a0, const bf16_t* b0, int M0, int N0, int K0, const bf16_t* a1, const bf16_t* b1, int M1, int N1, int K1, int G_, int c_) {
        A0 = a0; B0 = b0; A1 = a1; B1 = b1; nM0 = M0 / BM; nN0 = N0 / BM; nM1 = M1 / BM; nN1 = N1 / BM; n0 = nM0 * nN0; KS = 1; n1 = nM1 * nN1; ntot = n0 + n1; G = G_; c = c_;
        tstep = (size_t)BM * K0 * 2; tstep1 = (size_t)BM * K1 * 2; tstepA = tstep; nt0 = K0 / BK; nt1 = K1 / BK; sf = 1;
    }
    DI bool next(int i, Unit& u) const {
        const long L = (long)i * G + c; if (L >= ntot) return false;
        const int gi = sf ? ((L < n1) ? 1 : 0) : ((L >= n0) ? 1 : 0);
        const int w = gi ? (sf ? (int)L : (int)L - n0) : 0; const int ks1 = w % KS, t1 = w / KS, pn1 = t1 % (nN1 > 0 ? nN1 : 1), pm1 = t1 / (nN1 > 0 ? nN1 : 1);
        int wgid = gi ? 0 : (sf ? (int)L - n1 : (int)L); const int nM = nM0, nN = nN0, nwg = n0;
        { const int q = nwg / NXCD, r = nwg % NXCD, xcd = wgid % NXCD, off = wgid / NXCD; wgid = (xcd < r ? xcd * (q + 1) : r * (q + 1) + (xcd - r) * q) + off; }
        const int nig = WGM * nN, gid = wgid / nig, fm = gid * WGM, gsz = (nM - fm) < WGM ? (nM - fm) : WGM;
        const int pm0 = fm + ((wgid % nig) % gsz), pn0 = (wgid % nig) / gsz;
        u.pm = gi ? pm1 : pm0; u.pn = gi ? pn1 : pn0; u.gi = gi; u.ks = gi ? ks1 : 0; return true;
    }
    DI const char* baseA(const Unit& u) const { return (const char*)(u.gi ? A1 : A0) + (size_t)u.pm * (u.gi ? tstep1 : tstepA) + (size_t)(u.ks * nt1) * (BK * 2); }
    DI const char* baseB(const Unit& u) const { return (const char*)(u.gi ? B1 : B0) + (size_t)u.pn * (u.gi ? tstep1 : tstep) + (size_t)(u.ks * nt1) * (BK * 2); }
    DI int ktiles(const Unit& u) const { return u.gi ? nt1 : nt0; }
};

DI unsigned cvt_pk_bf16(float lo, float hi) { unsigned r; asm volatile("v_cvt_pk_bf16_f32 %0, %1, %2" : "=v"(r) : "v"(lo), "v"(hi)); return r; }

template <class Epi, class Sched, bool ALIGN_EPI = false, bool SP2 = false, int AGM_ROWS = 0>
DI void gemm_phase(LAS unsigned char* lds, const int K, const Sched& S, const Epi& E) {
    int tid_o = threadIdx.x; asm volatile("" : "+v"(tid_o));
    const int tid = tid_o, wid = __builtin_amdgcn_readfirstlane(tid >> 6), lane = tid & 63, wr = wid >> 2, wc = wid & 3, fr = lane & 15, fq = lane >> 4;
    unsigned voffA[2], voffB[2];
#pragma unroll
    for (int i = 0; i < 2; ++i) { int R, C; stage_rc(tid * 16 + i * 8192, R, C); const int Rb = Epi::PERM ? ((R & ~31) + perm32(R & 31)) : R;
        voffA[i] = AGM_ROWS ? (unsigned)(((C >> 4) * AGM_ROWS + R) * 16 + (C & 15)) * 2u : (unsigned)(R * K + C) * 2u; voffB[i] = (unsigned)(Rb * K + C) * 2u; }
    const size_t kstep = (size_t)(BK * 2);
    const size_t hstep = (size_t)HALF * K * 2;
    const size_t kstepA = AGM_ROWS ? (size_t)4 * AGM_ROWS * 32 : kstep, hstepA = AGM_ROWS ? (size_t)HALF * 32 : hstep;
    const unsigned ldsw = (unsigned)wid * 1024u;
    const int aoff = lds_byte(wr * 64 + fr, fq * 8), boff = lds_byte(wc * 32 + fr, fq * 8);
#define PG8_SA(b, h) (((b) * 2 + (h)) * HTB)
#define PG8_SB(b, h) ((4 + (b) * 2 + (h)) * HTB)
#define PG8_STAGE(bufoff, gbase, voff) do { _Pragma("unroll") for (int _i = 0; _i < 2; ++_i) \
        __builtin_amdgcn_global_load_lds((const unsigned*)((const char*)(gbase) + (voff)[_i]), (LAS unsigned*)(lds + (bufoff) + ldsw + _i * 8192), 16, 0, 0); } while (0)
#define PG8_LDA(dst, b, h) do { _Pragma("unroll") for (int m = 0; m < 4; ++m) _Pragma("unroll") for (int k = 0; k < 2; ++k) dst[m][k] = *(const LAS bf16x8*)(lds + PG8_SA(b, h) + aoff + m * 2048 + k * 1024); } while (0)
#define PG8_LDB(dst, b, h) do { _Pragma("unroll") for (int n = 0; n < 2; ++n) _Pragma("unroll") for (int k = 0; k < 2; ++k) dst[n][k] = *(const LAS bf16x8*)(lds + PG8_SB(b, h) + boff + n * 2048 + k * 1024); } while (0)
#define PG8_MMA(ai, bj, At, Bt) do { __builtin_amdgcn_s_setprio(1); _Pragma("unroll") for (int m = 0; m < 4; ++m) _Pragma("unroll") for (int n = 0; n < 2; ++n) _Pragma("unroll") for (int k = 0; k < 2; ++k) \
        acc[ai][bj][m][n] = __builtin_amdgcn_mfma_f32_16x16x32_bf16(Bt[n][k], At[m][k], acc[ai][bj][m][n], 0, 0, 0); __builtin_amdgcn_s_setprio(0); } while (0)
#define PG8_WAIT_V(n) asm volatile("s_waitcnt vmcnt(" #n ")" ::: "memory")
#define PG8_WAIT_L(n) asm volatile("s_waitcnt lgkmcnt(" #n ")" ::: "memory")
#define PG8_BAR __builtin_amdgcn_s_barrier()
#define PG8_SCHED __builtin_amdgcn_sched_barrier(0)
    Unit cur, nxt; int ui = 0;
    if (!S.next(0, cur)) return;
    int nt = S.ktiles(cur);
    f32x4 acc[2][2][4][2];
#pragma unroll
    for (int a = 0; a < 2; ++a)
#pragma unroll
        for (int b = 0; b < 2; ++b)
#pragma unroll
            for (int m = 0; m < 4; ++m)
#pragma unroll
                for (int n = 0; n < 2; ++n) acc[a][b][m][n] = (f32x4){0.f, 0.f, 0.f, 0.f};
    bf16x8 At[4][2], B0[2][2], B1[2][2];
    const char* cA = S.baseA(cur); const char* cB = S.baseB(cur);
    if constexpr (SP2) {
        PG8_STAGE(PG8_SB(0, 0), cB, voffB); PG8_STAGE(PG8_SB(0, 1), cB + hstep, voffB); PG8_STAGE(PG8_SA(0, 0), cA, voffA); PG8_STAGE(PG8_SA(0, 1), cA + hstepA, voffA);
        if (wr == 1) PG8_BAR;
        PG8_WAIT_V(2); PG8_BAR;
        PG8_STAGE(PG8_SB(1, 0), cB + kstep, voffB); PG8_STAGE(PG8_SA(1, 0), cA + kstepA, voffA); PG8_STAGE(PG8_SB(1, 1), cB + hstep + kstep, voffB);
        PG8_WAIT_V(6); PG8_BAR;
    } else {
        PG8_STAGE(PG8_SB(0, 0), cB, voffB); PG8_STAGE(PG8_SA(0, 0), cA, voffA); PG8_STAGE(PG8_SB(0, 1), cB + hstep, voffB); PG8_STAGE(PG8_SA(0, 1), cA + hstepA, voffA);
        if (wr == 1) PG8_BAR;
        PG8_WAIT_V(4); PG8_BAR;
        PG8_STAGE(PG8_SB(1, 0), cB + kstep, voffB); PG8_STAGE(PG8_SA(1, 0), cA + kstepA, voffA); PG8_STAGE(PG8_SB(1, 1), cB + hstep + kstep, voffB);
        PG8_WAIT_V(6); PG8_BAR;
    }
    for (;;) {
        const bool has_next = S.next(ui + 1, nxt);
        const char* nA = has_next ? S.baseA(nxt) : cA; const char* nB = has_next ? S.baseB(nxt) : cB;
        for (int t = 0; t < nt; t += 2) {
            const bool last = (t == nt - 2);
            const char* a1 = cA + (size_t)(t + 1) * kstepA;
            const char* a2 = last ? nA : cA + (size_t)(t + 2) * kstepA; const char* b2 = last ? nB : cB + (size_t)(t + 2) * kstep;
            const char* a3 = a2 + kstepA; const char* b3 = b2 + kstep;
            if constexpr (SP2) {
            PG8_LDB(B0, 0, 0); PG8_LDB(B1, 0, 1); PG8_SCHED; PG8_LDA(At, 0, 0); PG8_STAGE(PG8_SA(1, 1), a1 + hstepA, voffA);
            PG8_WAIT_V(8); PG8_WAIT_L(0); PG8_BAR; PG8_MMA(0, 0, At, B0); PG8_MMA(0, 1, At, B1); PG8_BAR; PG8_SCHED;
            PG8_LDA(At, 0, 1); PG8_STAGE(PG8_SB(0, 0), b2, voffB); PG8_STAGE(PG8_SB(0, 1), b2 + hstep, voffB); PG8_STAGE(PG8_SA(0, 0), a2, voffA);
            PG8_WAIT_V(8); PG8_WAIT_L(0); PG8_BAR; PG8_MMA(1, 0, At, B0); PG8_MMA(1, 1, At, B1); PG8_BAR; PG8_SCHED;
            PG8_LDB(B0, 1, 0); PG8_LDB(B1, 1, 1); PG8_SCHED; PG8_LDA(At, 1, 0); PG8_STAGE(PG8_SA(0, 1), a2 + hstepA, voffA);
            PG8_WAIT_V(8); PG8_WAIT_L(0); PG8_BAR; PG8_MMA(0, 0, At, B0); PG8_MMA(0, 1, At, B1); PG8_BAR; PG8_SCHED;
            PG8_LDA(At, 1, 1); PG8_STAGE(PG8_SB(1, 0), b3, voffB); PG8_STAGE(PG8_SB(1, 1), b3 + hstep, voffB); PG8_STAGE(PG8_SA(1, 0), a3, voffA);
            PG8_WAIT_V(8); PG8_WAIT_L(0); PG8_BAR; PG8_MMA(1, 0, At, B0); PG8_MMA(1, 1, At, B1); PG8_BAR; PG8_SCHED;
            } else {
            PG8_LDB(B0, 0, 0); PG8_SCHED; PG8_LDA(At, 0, 0); PG8_STAGE(PG8_SA(1, 1), a1 + hstepA, voffA);
            PG8_WAIT_L(8); PG8_BAR; PG8_WAIT_L(0); PG8_MMA(0, 0, At, B0); PG8_BAR; PG8_SCHED;
            PG8_LDB(B1, 0, 1); PG8_STAGE(PG8_SB(0, 0), b2, voffB);
            PG8_BAR; PG8_WAIT_L(0); PG8_MMA(0, 1, At, B1); PG8_BAR;
            PG8_LDA(At, 0, 1); PG8_STAGE(PG8_SA(0, 0), a2, voffA);
            PG8_BAR; PG8_WAIT_L(0); PG8_MMA(1, 0, At, B0); PG8_BAR; PG8_SCHED;
            PG8_STAGE(PG8_SB(0, 1), b2 + hstep, voffB);
            PG8_WAIT_V(6); PG8_BAR; PG8_MMA(1, 1, At, B1); PG8_BAR;
            PG8_LDB(B0, 1, 0); PG8_SCHED; PG8_LDA(At, 1, 0); PG8_STAGE(PG8_SA(0, 1), a2 + hstepA, voffA);
            PG8_WAIT_L(8); PG8_BAR; PG8_WAIT_L(0); PG8_MMA(0, 0, At, B0); PG8_BAR; PG8_SCHED;
            PG8_LDB(B1, 1, 1); PG8_STAGE(PG8_SB(1, 0), b3, voffB);
            PG8_BAR; PG8_WAIT_L(0); PG8_MMA(0, 1, At, B1); PG8_BAR;
            PG8_LDA(At, 1, 1); PG8_STAGE(PG8_SA(1, 0), a3, voffA);
            PG8_BAR; PG8_WAIT_L(0); PG8_MMA(1, 0, At, B0); PG8_BAR; PG8_SCHED;
            PG8_STAGE(PG8_SB(1, 1), b3 + hstep, voffB);
            PG8_WAIT_V(6); PG8_BAR; PG8_MMA(1, 1, At, B1); PG8_BAR;
            }
        }
        if constexpr (ALIGN_EPI) { if (wr == 0) PG8_BAR; }
        { int fr_ = fr, fq_ = fq; asm volatile("" : "+v"(fr_), "+v"(fq_)); E(acc, cur, wr, wc, fr_, fq_); }
        if (!has_next) break;
#pragma unroll
        for (int a = 0; a < 2; ++a)
#pragma unroll
            for (int b = 0; b < 2; ++b)
#pragma unroll
                for (int m = 0; m < 4; ++m)
#pragma unroll
                    for (int n = 0; n < 2; ++n) acc[a][b][m][n] = (f32x4){0.f, 0.f, 0.f, 0.f};
        cur = nxt; cA = nA; cB = nB; ++ui; nt = S.ktiles(cur);
        if constexpr (ALIGN_EPI) { if (wr == 1) PG8_BAR; }
    }
    PG8_WAIT_V(0);
    if constexpr (!ALIGN_EPI) { if (wr == 0) PG8_BAR; }
    PG8_BAR;
#undef PG8_SA
#undef PG8_SB
#undef PG8_STAGE
#undef PG8_LDA
#undef PG8_LDB
#undef PG8_MMA
#undef PG8_WAIT_V
#undef PG8_WAIT_L
#undef PG8_BAR
#undef PG8_SCHED
}
}
#ifndef PG8_SP2
#define PG8_SP2 true
#endif
#ifndef PG8_ALIGN
#define PG8_ALIGN true
#endif

struct EpiInProj {
    static constexpr bool PERM = true;
    bf16_t* Z; int ldz; float* vstat;
    int e_gelu, e_stat, e_q, q_is_raw;
    float qscale;
    float* out_mk; float* out_mv; bf16_t* kvbf; bf16_t* vtb; int fused_ug; bf16_t* ug;
    DI void operator()(const f32x4 (&acc)[2][2][4][2], const pg8::Unit& u, int wr, int wc, int fr, int fq) const {
        const int row0 = u.pm * 256 + wr * 64 + fr, col0_ = u.pn * 256 + wc * 32 + 8 * fq;
        if (u.gi == 1) {
            const int n0 = u.pn * 256; const int layer = n0 >> 10, kv = (n0 >> 9) & 1, cb = (n0 & 511) + wc * 32 + 8 * fq;
            float* ob = (kv ? out_mv : out_mk) + (size_t)layer * MMEM * XA; bf16_t* kb = kvbf + (size_t)(layer * 2 + kv) * MMEM * XA;
#pragma unroll
            for (int ai = 0; ai < 2; ++ai)
#pragma unroll
                for (int m = 0; m < 4; ++m) { const size_t ro = (size_t)(row0 + ai * 128 + m * 16) * XA + cb;
#pragma unroll
                    for (int bj = 0; bj < 2; ++bj) { const f32x4 v0 = acc[ai][bj][m][0], v1 = acc[ai][bj][m][1];
                        *(f32x4*)(ob + ro + bj * 128) = v0; *(f32x4*)(ob + ro + bj * 128 + 4) = v1;
                        u32x4 w; w.x = pg8::cvt_pk_bf16(v0[0], v0[1]); w.y = pg8::cvt_pk_bf16(v0[2], v0[3]); w.z = pg8::cvt_pk_bf16(v1[0], v1[1]); w.w = pg8::cvt_pk_bf16(v1[2], v1[3]);
                        *(u32x4*)(kb + ro + bj * 128) = w;
                        if (kv) { const int rr = row0 + ai * 128 + m * 16, bb = rr >> 8, mm = rr & 255, cc = cb + bj * 128, hh = cc >> 7, d0 = cc & 127;
                            bf16_t* vt = vtb + ((size_t)((layer * NB_P + bb) * NH + hh) * HD + d0) * NMEM + mm;
#pragma unroll
                            for (int e = 0; e < 4; ++e) { vt[(size_t)e * NMEM] = (bf16_t)f2bf(v0[e]); vt[(size_t)(e + 4) * NMEM] = (bf16_t)f2bf(v1[e]); } } } }
            return;
        }
        if (fused_ug && u.pn < 12) {
            const int oc = u.pn * 128 + wc * 32 + 8 * fq;
#pragma unroll
            for (int ai = 0; ai < 2; ++ai)
#pragma unroll
                for (int m = 0; m < 4; ++m) { const int row = row0 + ai * 128 + m * 16; float o[8];
#pragma unroll
                    for (int e = 0; e < 4; ++e) { o[e] = gelu_tanh(acc[ai][0][m][0][e]) * silu_f(acc[ai][1][m][0][e]); o[4 + e] = gelu_tanh(acc[ai][0][m][1][e]) * silu_f(acc[ai][1][m][1][e]); }
                    u32x4 w; w.x = pg8::cvt_pk_bf16(o[0], o[1]); w.y = pg8::cvt_pk_bf16(o[2], o[3]); w.z = pg8::cvt_pk_bf16(o[4], o[5]); w.w = pg8::cvt_pk_bf16(o[6], o[7]);
                    *(u32x4*)(Z + (size_t)row * ldz + oc) = w; }
            return; }
        const int kind = (u.pn < e_gelu) ? (q_is_raw ? 0 : 1) : (u.pn < e_stat) ? 2 : (u.pn < e_q) ? 3 : 4;
        const int col0 = fused_ug ? (u.pn - 6) * 256 + wc * 32 + 8 * fq : col0_;
#pragma unroll
        for (int ai = 0; ai < 2; ++ai)
#pragma unroll
            for (int m = 0; m < 4; ++m) { const int row = row0 + ai * 128 + m * 16; bf16_t* rowp = Z + (size_t)row * ldz + col0; float s1 = 0.f, s2 = 0.f;
#pragma unroll
                for (int bj = 0; bj < 2; ++bj) { f32x4 v0 = acc[ai][bj][m][0], v1 = acc[ai][bj][m][1];
                    if (kind == 1 || kind == 2) {
#pragma unroll
                        for (int e = 0; e < 4; ++e) { v0[e] = gelu_tanh(v0[e]); v1[e] = gelu_tanh(v1[e]); }
                    } else if (kind == 3) { v0 = v0 * qscale; v1 = v1 * qscale; }
                    else if (kind == 4) {
#pragma unroll
                        for (int e = 0; e < 4; ++e) { v0[e] = silu_f(v0[e]); v1[e] = silu_f(v1[e]); }
                    }
                    if (kind == 2) {
#pragma unroll
                        for (int e = 0; e < 4; ++e) { s1 += v0[e] + v1[e]; s2 += v0[e] * v0[e] + v1[e] * v1[e]; }
                    }
                    u32x4 w; w.x = pg8::cvt_pk_bf16(v0[0], v0[1]); w.y = pg8::cvt_pk_bf16(v0[2], v0[3]); w.z = pg8::cvt_pk_bf16(v1[0], v1[1]); w.w = pg8::cvt_pk_bf16(v1[2], v1[3]);
                    if (ug && u.pn < BR / 256) { const int c = col0 + bj * 128; *(u32x4*)(ug + ((size_t)(c >> 4) * M + row) * SC + (c & 8)) = w; }
                    else *(u32x4*)(rowp + bj * 128) = w; }
                if (kind == 2) { s1 += __shfl_xor(s1, 16); s1 += __shfl_xor(s1, 32); s2 += __shfl_xor(s2, 16); s2 += __shfl_xor(s2, 32);
                    if (fq == 0) { atomicAdd(vstat + 2 * (size_t)row, s1); atomicAdd(vstat + 2 * (size_t)row + 1, s2); } }
            }
    }
};
struct EpiOut {
    static constexpr bool PERM = true;
    bf16_t* O; float* part;
    DI void operator()(const f32x4 (&acc)[2][2][4][2], const pg8::Unit& u, int wr, int wc, int fr, int fq) const {
        const int row0 = u.pm * 256 + wr * 64 + fr, col0 = u.pn * 256 + wc * 32 + 8 * fq;
        if (u.gi) { float* base = part + (size_t)u.ks * MS * D;
#pragma unroll
            for (int ai = 0; ai < 2; ++ai)
#pragma unroll
                for (int m = 0; m < 4; ++m) { const int row = row0 + ai * 128 + m * 16; float* rowp = base + (size_t)row * D + col0;
#pragma unroll
                    for (int bj = 0; bj < 2; ++bj) { *(f32x4*)(rowp + bj * 128) = acc[ai][bj][m][0]; *(f32x4*)(rowp + bj * 128 + 4) = acc[ai][bj][m][1]; } }
        } else {
#pragma unroll
            for (int ai = 0; ai < 2; ++ai)
#pragma unroll
                for (int m = 0; m < 4; ++m) { const int row = row0 + ai * 128 + m * 16; bf16_t* rowp = O + (size_t)row * D + col0;
#pragma unroll
                    for (int bj = 0; bj < 2; ++bj) { const f32x4 v0 = acc[ai][bj][m][0], v1 = acc[ai][bj][m][1];
                        u32x4 w; w.x = pg8::cvt_pk_bf16(v0[0], v0[1]); w.y = pg8::cvt_pk_bf16(v0[2], v0[3]); w.z = pg8::cvt_pk_bf16(v1[0], v1[1]); w.w = pg8::cvt_pk_bf16(v1[2], v1[3]);
                        *(u32x4*)(rowp + bj * 128) = w; } }
        }
    }
};
DI void st_wt(float* p, const f32x4 v) {
    __hip_atomic_store((unsigned long long*)p, (unsigned long long)__float_as_uint(v.x) | ((unsigned long long)__float_as_uint(v.y) << 32), __ATOMIC_RELAXED, __HIP_MEMORY_SCOPE_AGENT);
    __hip_atomic_store((unsigned long long*)(p + 2), (unsigned long long)__float_as_uint(v.z) | ((unsigned long long)__float_as_uint(v.w) << 32), __ATOMIC_RELAXED, __HIP_MEMORY_SCOPE_AGENT);
}
struct EpiOutFused {
    static constexpr bool PERM = true;
    const bf16_t* base; const float* gain; float* yout; float* ss; unsigned* cnt; float* part; unsigned* subdone;
    DI void operator()(const f32x4 (&acc)[2][2][4][2], const pg8::Unit& u, int wr, int wc, int fr, int fq) const {
        const int row0 = u.pm * 256 + wr * 64 + fr, col0 = u.pn * 256 + wc * 32 + 8 * fq;
        if (u.gi) { float* pb = part + (size_t)u.ks * MS * D;
#pragma unroll
            for (int ai = 0; ai < 2; ++ai)
#pragma unroll
                for (int m = 0; m < 4; ++m) { const int row = row0 + ai * 128 + m * 16; float* rowp = pb + (size_t)row * D + col0;
#pragma unroll
                    for (int bj = 0; bj < 2; ++bj) { *(f32x4*)(rowp + bj * 128) = acc[ai][bj][m][0]; *(f32x4*)(rowp + bj * 128 + 4) = acc[ai][bj][m][1]; } }
            return; }
#pragma unroll
        for (int ai = 0; ai < 2; ++ai)
#pragma unroll
            for (int m = 0; m < 4; ++m) { float s2 = 0.f;
#pragma unroll
                for (int bj = 0; bj < 2; ++bj) { const f32x4 v0 = acc[ai][bj][m][0], v1 = acc[ai][bj][m][1];
#pragma unroll
                    for (int e = 0; e < 4; ++e) s2 += v0[e] * v0[e] + v1[e] * v1[e]; }
                s2 += __shfl_xor(s2, 16); s2 += __shfl_xor(s2, 32);
                if (fq == 0) atomicAdd(ss + row0 + ai * 128 + m * 16, s2); }
        asm volatile("s_waitcnt vmcnt(0)" ::: "memory");
        unsigned* pc = cnt + 64 * u.pm;
        if (fr == 0 && fq == 0) __hip_atomic_fetch_add(pc, 1u, __ATOMIC_RELAXED, __HIP_MEMORY_SCOPE_AGENT);
        { unsigned sp = 0; while ((unsigned)__builtin_amdgcn_readfirstlane((int)__hip_atomic_load(pc, __ATOMIC_RELAXED, __HIP_MEMORY_SCOPE_AGENT)) < 32u) { __builtin_amdgcn_s_sleep(2); if (++sp > (1u << 22)) break; } }
        __builtin_amdgcn_fence(__ATOMIC_ACQUIRE, "agent");
        asm volatile("s_waitcnt vmcnt(0)" ::: "memory");
        f32x4 gv[2][2];
#pragma unroll
        for (int bj = 0; bj < 2; ++bj)
#pragma unroll
            for (int n = 0; n < 2; ++n) gv[bj][n] = *(const f32x4*)(gain + col0 + bj * 128 + 4 * n);
        float rsv[8];
#pragma unroll
        for (int k = 0; k < 8; ++k) rsv[k] = __hip_atomic_load(ss + row0 + (k >> 2) * 128 + (k & 3) * 16, __ATOMIC_RELAXED, __HIP_MEMORY_SCOPE_AGENT);
#pragma unroll
        for (int ai = 0; ai < 2; ++ai)
#pragma unroll
            for (int m = 0; m < 4; ++m) { const int row = row0 + ai * 128 + m * 16;
                const float rs = 1.0f / sqrtf(rsv[ai * 4 + m] * (1.f / D) + EPS);
#pragma unroll
                for (int bj = 0; bj < 2; ++bj) { const u32x4 bw = __builtin_nontemporal_load((const u32x4*)(base + (size_t)(u.pm * 4 + u.pn) * 65536 + (size_t)((wr * 4 + wc) * 512 + (fq * 16 + fr) * 8) + (size_t)(((ai * 4 + m) * 2 + bj) * 4096)));
                    const f32x4 b0 = {__uint_as_float(bw.x << 16), __uint_as_float(bw.x & 0xffff0000u), __uint_as_float(bw.y << 16), __uint_as_float(bw.y & 0xffff0000u)};
                    const f32x4 b1 = {__uint_as_float(bw.z << 16), __uint_as_float(bw.z & 0xffff0000u), __uint_as_float(bw.w << 16), __uint_as_float(bw.w & 0xffff0000u)};
                    float* op = yout + (size_t)row * D + col0 + bj * 128;
                    *(f32x4*)op = b0 + acc[ai][bj][m][0] * rs * gv[bj][0]; *(f32x4*)(op + 4) = b1 + acc[ai][bj][m][1] * rs * gv[bj][1]; } }
    }
};
struct EpiOutFused2 {
    static constexpr bool PERM = true;
    const float* xin; const float* gain; bf16_t* y1o; bf16_t* xn; float* ssa; float* ssb; unsigned* cnta; unsigned* cntb; float* part; unsigned* subdone;
    DI void operator()(const f32x4 (&accin)[2][2][4][2], const pg8::Unit& u, int wr, int wc, int fr, int fq) const {
        const int row0 = u.pm * 256 + wr * 64 + fr, col0 = u.pn * 256 + wc * 32 + 8 * fq;
        if (u.gi) { float* pb = part + (size_t)u.ks * MS * D;
#pragma unroll
            for (int ai = 0; ai < 2; ++ai)
#pragma unroll
                for (int m = 0; m < 4; ++m) { const int row = row0 + ai * 128 + m * 16; float* rowp = pb + (size_t)row * D + col0;
#pragma unroll
                    for (int bj = 0; bj < 2; ++bj) { *(f32x4*)(rowp + bj * 128) = accin[ai][bj][m][0]; *(f32x4*)(rowp + bj * 128 + 4) = accin[ai][bj][m][1]; } }
            return; }
        const size_t y1blk = (size_t)(u.pm * 4 + u.pn) * 65536 + (size_t)((wr * 4 + wc) * 512 + (fq * 16 + fr) * 8);
        f32x4 acc[2][2][4][2];
#pragma unroll
        for (int ai = 0; ai < 2; ++ai)
#pragma unroll
            for (int bj = 0; bj < 2; ++bj)
#pragma unroll
                for (int m = 0; m < 4; ++m)
#pragma unroll
                    for (int n = 0; n < 2; ++n) acc[ai][bj][m][n] = accin[ai][bj][m][n];
#pragma unroll
        for (int ai = 0; ai < 2; ++ai)
#pragma unroll
            for (int m = 0; m < 4; ++m) { float s2 = 0.f;
#pragma unroll
                for (int bj = 0; bj < 2; ++bj) { const f32x4 v0 = acc[ai][bj][m][0], v1 = acc[ai][bj][m][1];
#pragma unroll
                    for (int e = 0; e < 4; ++e) s2 += v0[e] * v0[e] + v1[e] * v1[e]; }
                s2 += __shfl_xor(s2, 16); s2 += __shfl_xor(s2, 32);
                if (fq == 0) atomicAdd(ssa + row0 + ai * 128 + m * 16, s2); }
        asm volatile("s_waitcnt vmcnt(0)" ::: "memory");
        unsigned* pa = cnta + 64 * u.pm; unsigned* pb2 = cntb + 64 * u.pm;
        if (fr == 0 && fq == 0) __hip_atomic_fetch_add(pa, 1u, __ATOMIC_RELAXED, __HIP_MEMORY_SCOPE_AGENT);
        { unsigned sp = 0; while ((unsigned)__builtin_amdgcn_readfirstlane((int)__hip_atomic_load(pa, __ATOMIC_RELAXED, __HIP_MEMORY_SCOPE_AGENT)) < 32u) { __builtin_amdgcn_s_sleep(2); if (++sp > (1u << 22)) break; } }
        __builtin_amdgcn_fence(__ATOMIC_ACQUIRE, "agent");
        asm volatile("s_waitcnt vmcnt(0)" ::: "memory");
        f32x4 gv[2][2];
#pragma unroll
        for (int bj = 0; bj < 2; ++bj)
#pragma unroll
            for (int n = 0; n < 2; ++n) gv[bj][n] = *(const f32x4*)(gain + col0 + bj * 128 + 4 * n);
        float rsv[8];
#pragma unroll
        for (int k = 0; k < 8; ++k) rsv[k] = __hip_atomic_load(ssa + row0 + (k >> 2) * 128 + (k & 3) * 16, __ATOMIC_RELAXED, __HIP_MEMORY_SCOPE_AGENT);
#pragma unroll
        for (int ai = 0; ai < 2; ++ai)
#pragma unroll
            for (int m = 0; m < 4; ++m) { const int row = row0 + ai * 128 + m * 16;
                const float rs = 1.0f / sqrtf(rsv[ai * 4 + m] * (1.f / D) + EPS);
                float s2 = 0.f;
#pragma unroll
                for (int bj = 0; bj < 2; ++bj) { const float* xp = xin + (size_t)row * D + col0 + bj * 128;
                    const f32x4 y0 = __builtin_nontemporal_load((const f32x4*)xp) + acc[ai][bj][m][0] * rs * gv[bj][0], y1v = __builtin_nontemporal_load((const f32x4*)(xp + 4)) + acc[ai][bj][m][1] * rs * gv[bj][1];
                    acc[ai][bj][m][0] = y0; acc[ai][bj][m][1] = y1v;
                    u32x4 w; w.x = pg8::cvt_pk_bf16(y0[0], y0[1]); w.y = pg8::cvt_pk_bf16(y0[2], y0[3]); w.z = pg8::cvt_pk_bf16(y1v[0], y1v[1]); w.w = pg8::cvt_pk_bf16(y1v[2], y1v[3]);
                    *(u32x4*)(y1o + y1blk + (size_t)(((ai * 4 + m) * 2 + bj) * 4096)) = w;
#pragma unroll
                    for (int e = 0; e < 4; ++e) s2 += y0[e] * y0[e] + y1v[e] * y1v[e]; }
                s2 += __shfl_xor(s2, 16); s2 += __shfl_xor(s2, 32);
                if (fq == 0) atomicAdd(ssb + row, s2); }
        asm volatile("s_waitcnt vmcnt(0)" ::: "memory");
        if (fr == 0 && fq == 0) __hip_atomic_fetch_add(pb2, 1u, __ATOMIC_RELAXED, __HIP_MEMORY_SCOPE_AGENT);
        { unsigned sp = 0; while ((unsigned)__builtin_amdgcn_readfirstlane((int)__hip_atomic_load(pb2, __ATOMIC_RELAXED, __HIP_MEMORY_SCOPE_AGENT)) < 32u) { __builtin_amdgcn_s_sleep(2); if (++sp > (1u << 22)) break; } }
#pragma unroll
        for (int k = 0; k < 8; ++k) rsv[k] = __hip_atomic_load(ssb + row0 + (k >> 2) * 128 + (k & 3) * 16, __ATOMIC_RELAXED, __HIP_MEMORY_SCOPE_AGENT);
#pragma unroll
        for (int ai = 0; ai < 2; ++ai)
#pragma unroll
            for (int m = 0; m < 4; ++m) { const int row = row0 + ai * 128 + m * 16;
                const float rs1 = 1.0f / sqrtf(rsv[ai * 4 + m] * (1.f / D) + EPS);
#pragma unroll
                for (int bj = 0; bj < 2; ++bj) { const f32x4 y0 = acc[ai][bj][m][0] * rs1, y1v = acc[ai][bj][m][1] * rs1;
                    u32x4 w; w.x = pg8::cvt_pk_bf16(y0[0], y0[1]); w.y = pg8::cvt_pk_bf16(y0[2], y0[3]); w.z = pg8::cvt_pk_bf16(y1v[0], y1v[1]); w.w = pg8::cvt_pk_bf16(y1v[2], y1v[3]);
                    *(u32x4*)(xn + (size_t)row * D + col0 + bj * 128) = w; } }
    }
};
struct EpiGlu {
    static constexpr bool PERM = true;
    const bf16_t* YG; const bf16_t* Z1; const float* bglu; bf16_t* MIX;
    DI void operator()(const f32x4 (&acc)[2][2][4][2], const pg8::Unit& u, int wr, int wc, int fr, int fq) const {
        const int row0 = u.pm * 256 + wr * 64 + fr, col0 = u.pn * 256 + wc * 32 + 8 * fq;
        f32x4 bv[2][2];
#pragma unroll
        for (int bj = 0; bj < 2; ++bj)
#pragma unroll
            for (int n = 0; n < 2; ++n) bv[bj][n] = *(const f32x4*)(bglu + col0 + bj * 128 + 4 * n);
#pragma unroll
        for (int ai = 0; ai < 2; ++ai)
#pragma unroll
            for (int m = 0; m < 4; ++m) { const int row = row0 + ai * 128 + m * 16;
#pragma unroll
                for (int bj = 0; bj < 2; ++bj) { const int col = col0 + bj * 128;
                    const u32x4 yg = *(const u32x4*)(YG + ((size_t)(col >> 4) * M + row) * SC + (col & 8)); const u32x4 sg = *(const u32x4*)(Z1 + (size_t)row * NBW + (BR + XA) + col);
                    const f32x4 v0 = acc[ai][bj][m][0] + bv[bj][0], v1 = acc[ai][bj][m][1] + bv[bj][1];
                    float o[8]; const float a8[8] = {v0[0], v0[1], v0[2], v0[3], v1[0], v1[1], v1[2], v1[3]};
#pragma unroll
                    for (int e = 0; e < 4; ++e) { const unsigned yw = yg[e], sw = sg[e];
                        const float y0 = __uint_as_float(yw << 16), y1 = __uint_as_float(yw & 0xffff0000u), g0 = __uint_as_float(sw << 16), g1 = __uint_as_float(sw & 0xffff0000u);
                        o[2 * e] = y0 * sigmoid_f(a8[2 * e]) * g0; o[2 * e + 1] = y1 * sigmoid_f(a8[2 * e + 1]) * g1; }
                    u32x4 w; w.x = pg8::cvt_pk_bf16(o[0], o[1]); w.y = pg8::cvt_pk_bf16(o[2], o[3]); w.z = pg8::cvt_pk_bf16(o[4], o[5]); w.w = pg8::cvt_pk_bf16(o[6], o[7]);
                    *(u32x4*)(MIX + (size_t)row * MW + col) = w; } }
    }
};

#define XB_TMO      128
#define XB_XCNT(j)  (256  + 64 * (j))
#define XB_XSUB(j)  (1280 + 64 * (j))
#define XB_XGEN(j)  (2304 + 64 * (j))
#define XB_TOP      3328
#define XB_TOPGEN   3392
#define XCD_BAR_WORDS 3456
#define XB_SPIN_CAP (1u << 18)
DI unsigned xb_ld(unsigned* p)              { return __hip_atomic_load(p, __ATOMIC_RELAXED, __HIP_MEMORY_SCOPE_AGENT); }
DI unsigned xb_add(unsigned* p, unsigned v) { return __hip_atomic_fetch_add(p, v, __ATOMIC_RELAXED, __HIP_MEMORY_SCOPE_AGENT); }
DI unsigned xb_xcc_id() { return (unsigned)__builtin_amdgcn_s_getreg((3 << 11) | 20) & 0xFu; }
#define XB_SPIN(cond, bar) do { unsigned _sp = 0; while (cond) { __builtin_amdgcn_s_sleep(1); \
    if ((++_sp & 255u) == 0u) { if (xb_ld(&(bar)[XB_TMO])) break; if (_sp > XB_SPIN_CAP) { atomicAdd(&(bar)[XB_TMO], 1u); break; } } } } while (0)
struct XcdBarrier { unsigned* bar; unsigned x; volatile LAS unsigned* st; };
DI XcdBarrier xcd_barrier_post(unsigned* bar, volatile LAS unsigned* st) {
    XcdBarrier b; b.bar = bar; b.x = xb_xcc_id(); b.st = st;
    if (threadIdx.x == 0) (void)xb_add(&bar[XB_XCNT(b.x)], 1u);
    return b;
}
DI void xcd_barrier_complete(unsigned* bar, unsigned x, unsigned& nloc, unsigned& nx) {
    const unsigned G = gridDim.x * gridDim.y * gridDim.z;
    unsigned sum, cnt, mine, sp = 0u;
    for (;;) {
        sum = 0u; cnt = 0u; mine = 0u;
#pragma unroll
        for (unsigned j = 0; j < 16; ++j) { const unsigned c = xb_ld(&bar[XB_XCNT(j)]); sum += c; cnt += (c > 0u) ? 1u : 0u; mine = (j == x) ? c : mine; }
        if (sum == G) break;
        __builtin_amdgcn_s_sleep(1);
        if ((++sp & 255u) == 0u) { if (xb_ld(&bar[XB_TMO])) break; if (sp > XB_SPIN_CAP) { atomicAdd(&bar[XB_TMO], 1u); break; } }
    }
    nloc = mine > 0u ? mine : 1u; nx = cnt > 0u ? cnt : 1u;
}
DI void xcd_barrier(const XcdBarrier& b) {
    asm volatile("s_waitcnt vmcnt(0)" ::: "memory");
    __syncthreads();
    if (threadIdx.x == 0) {
        unsigned* bar = b.bar;
        __builtin_amdgcn_s_waitcnt(0);
        unsigned nloc = b.st[0], nx = b.st[1];
        if (nloc == 0u) { xcd_barrier_complete(bar, b.x, nloc, nx); b.st[0] = nloc; b.st[1] = nx; }
        const unsigned old = xb_add(&bar[XB_XSUB(b.x)], 1u);
        const unsigned gen = old / nloc;
        if (old + 1u == (gen + 1u) * nloc) {
            __builtin_amdgcn_fence(__ATOMIC_RELEASE, "agent");
            asm volatile("s_waitcnt vmcnt(0)" ::: "memory");
            const unsigned og = xb_add(&bar[XB_TOP], 1u);
            const unsigned tg = og / nx;
            if (og + 1u == (tg + 1u) * nx) xb_add(&bar[XB_TOPGEN], 1u);
            else XB_SPIN(xb_ld(&bar[XB_TOPGEN]) == tg, bar);
            __builtin_amdgcn_fence(__ATOMIC_ACQUIRE, "agent");
            xb_add(&bar[XB_XGEN(b.x)], 1u);
            asm volatile("s_waitcnt vmcnt(0)" ::: "memory");
        } else {
            XB_SPIN(xb_ld(&bar[XB_XGEN(b.x)]) == gen, bar);
            __builtin_amdgcn_fence(__ATOMIC_ACQUIRE, "agent");
            asm volatile("s_waitcnt vmcnt(0)" ::: "memory");
        }
    }
    __syncthreads();
}

DI void publish_wg(unsigned* cnt) {
    if (threadIdx.x == 0) {
        __builtin_amdgcn_fence(__ATOMIC_RELEASE, "agent");
        asm volatile("s_waitcnt vmcnt(0)" ::: "memory");
        __hip_atomic_fetch_add(cnt, 1u, __ATOMIC_RELAXED, __HIP_MEMORY_SCOPE_AGENT);
    }
}
DI void wait_subunits(unsigned* cnt, const unsigned need) {
    if (threadIdx.x == 0) { unsigned sp = 0;
        while (__hip_atomic_load(cnt, __ATOMIC_RELAXED, __HIP_MEMORY_SCOPE_AGENT) < need) { __builtin_amdgcn_s_sleep(2); if (++sp > (1u << 22)) break; }
        __builtin_amdgcn_fence(__ATOMIC_ACQUIRE, "agent");
        asm volatile("s_waitcnt vmcnt(0)" ::: "memory"); }
    __syncthreads();
}
struct Args {
    const float* in[29]; float* out; unsigned char* ws; int ph_lo, ph_hi, li, pad;
};
constexpr int NWAVES = 8, NTHR = NWAVES * 64;
constexpr int RING_BYTES = 131072, MISC_OFF = RING_BYTES + 320, LDS_BYTES = 147456;

DI void p0_transpose_item(const float* W, const float* gk, int K, int N, bf16_t* WT, int row_off, LAS float* scr, int item, int lane_in) {
    int lane_o = lane_in; asm volatile("" : "+v"(lane_o)); const int lane = lane_o;
    const int nblk = N / 32, kb = item / nblk, nb = item % nblk, k0 = 64 * kb, n0 = 32 * nb;
    const int kq = lane >> 3, c4 = 4 * (lane & 7);
    f32x4 v[8];
#pragma unroll
    for (int i = 0; i < 8; ++i) v[i] = __builtin_nontemporal_load((const f32x4*)(W + (size_t)(k0 + 8 * i + kq) * N + n0 + c4));
#pragma unroll
    for (int i = 0; i < 8; ++i) { const int kk = 8 * i + kq; const float gg = gk ? gk[k0 + kk] : 1.0f; LAS float* d = scr + kk * 33 + c4;
        d[0] = v[i].x * gg; d[1] = v[i].y * gg; d[2] = v[i].z * gg; d[3] = v[i].w * gg; }
    LDS_WAIT();
    const int c = lane & 7;
#pragma unroll
    for (int j = 0; j < 4; ++j) { const int n = (lane >> 3) + 8 * j; const LAS float* s = scr + (8 * c) * 33 + n;
        u32x4 o; o.x = pk2(s[0 * 33], s[1 * 33]); o.y = pk2(s[2 * 33], s[3 * 33]); o.z = pk2(s[4 * 33], s[5 * 33]); o.w = pk2(s[6 * 33], s[7 * 33]);
        *(u32x4*)(WT + (size_t)(row_off + n0 + n) * K + k0 + 8 * c) = o; }
    LDS_WAIT();
}
DI void rms_row_to_bf16(const float* xrow, bf16_t* orow, int lane) {
    const f32x4* xr = (const f32x4*)xrow + lane;
    f32x4 v[4]; float s = 0.f;
#pragma unroll
    for (int j = 0; j < 4; ++j) { v[j] = xr[64 * j]; s += (v[j].x * v[j].x + v[j].y * v[j].y) + (v[j].z * v[j].z + v[j].w * v[j].w); }
    const float rs = 1.0f / sqrtf(wave_sum(s) * (1.f / D) + EPS);
    unsigned long long* o8 = (unsigned long long*)orow + lane;
#pragma unroll
    for (int j = 0; j < 4; ++j) o8[64 * j] = (unsigned long long)pk2(v[j].x * rs, v[j].y * rs) | ((unsigned long long)pk2(v[j].z * rs, v[j].w * rs) << 32);
}

DI void attn_naive(const bf16_t* Zb, int ldz, int qoff, int goff, const bf16_t* kbf, const bf16_t* vbf, const float* ck, const float* cv, bf16_t* MIX, LAS float* wscr, int gw, int NGW, int lane) {
    LAS float* qs = wscr; LAS float* ps = wscr + 128;
    for (int item = MP * NH + gw; item < M * NH; item += NGW) {
        const int row = item >> 2, h = item & 3;
        const bf16_t* zr = Zb + (size_t)row * ldz;
        { const unsigned qw = *(const unsigned*)(zr + qoff + h * HD + 2 * lane); qs[2 * lane] = __uint_as_float(qw << 16); qs[2 * lane + 1] = __uint_as_float(qw & 0xffff0000u); }
        LDS_WAIT();
        float sc[4];
        if (row < MP) {
            const int b = row >> 11; const bf16_t* kb = kbf + (size_t)(b * NMEM) * XA + h * HD;
#pragma unroll
            for (int kk = 0; kk < 4; ++kk) { const bf16_t* kr = kb + (size_t)(lane + 64 * kk) * XA; float a = 0.f;
#pragma unroll 2
                for (int d8 = 0; d8 < 16; ++d8) { const u32x4 kw = *(const u32x4*)(kr + 8 * d8); const LAS float* q = qs + 8 * d8;
#pragma unroll
                    for (int e = 0; e < 4; ++e) { a += q[2 * e] * __uint_as_float(kw[e] << 16); a += q[2 * e + 1] * __uint_as_float(kw[e] & 0xffff0000u); } }
                sc[kk] = a; }
        } else {
            const int b = (row - MP) >> 2; const float* kb = ck + (size_t)(b * NMEM) * XA + h * HD;
#pragma unroll
            for (int kk = 0; kk < 4; ++kk) { const float* kr = kb + (size_t)(lane + 64 * kk) * XA; float a = 0.f;
#pragma unroll 4
                for (int d4 = 0; d4 < 32; ++d4) { const f32x4 kw = *(const f32x4*)(kr + 4 * d4); const LAS float* q = qs + 4 * d4;
                    a += q[0] * kw.x + q[1] * kw.y + q[2] * kw.z + q[3] * kw.w; }
                sc[kk] = a; }
        }
        const float mx = wave_max(fmaxf(fmaxf(sc[0], sc[1]), fmaxf(sc[2], sc[3])));
        float sum = 0.f;
#pragma unroll
        for (int kk = 0; kk < 4; ++kk) { const float p = __builtin_amdgcn_exp2f((sc[kk] - mx) * 1.4426950408889634f); sum += p; ps[lane + 64 * kk] = p; }
        sum = wave_sum(sum);
        LDS_WAIT();
        float o0 = 0.f, o1 = 0.f;
        if (row < MP) {
            const int b = row >> 11; const bf16_t* vb = vbf + (size_t)(b * NMEM) * XA + h * HD + 2 * lane;
#pragma unroll 8
            for (int m = 0; m < NMEM; ++m) { const unsigned vw = *(const unsigned*)(vb + (size_t)m * XA); const float p = ps[m]; o0 += p * __uint_as_float(vw << 16); o1 += p * __uint_as_float(vw & 0xffff0000u); }
        } else {
            const int b = (row - MP) >> 2; const float* vb = cv + (size_t)(b * NMEM) * XA + h * HD + 2 * lane;
#pragma unroll 8
            for (int m = 0; m < NMEM; ++m) { const f32x2 vw = *(const f32x2*)(vb + (size_t)m * XA); const float p = ps[m]; o0 += p * vw.x; o1 += p * vw.y; }
        }
        const float inv = 1.0f / sum;
        const unsigned gwd = *(const unsigned*)(zr + goff + h * HD + 2 * lane);
        o0 *= inv * __uint_as_float(gwd << 16); o1 *= inv * __uint_as_float(gwd & 0xffff0000u);
        *(unsigned*)(MIX + (size_t)row * MW + BR + h * HD + 2 * lane) = pk2(o0, o1);
        LDS_WAIT();
    }
}


typedef float f32x16 __attribute__((ext_vector_type(16)));
typedef __bf16 bf16x2_t __attribute__((ext_vector_type(2)));
DI unsigned cvtpk(float lo, float hi) { f32x2 v = {lo, hi}; bf16x2_t b = __builtin_convertvector(v, bf16x2_t); return __builtin_bit_cast(unsigned, b); }
DI void attn_prompt_unit(const bf16_t* Zb, const int ldz, const int qoff, const int goff, const bf16_t* Kpl, const bf16_t* VTl, bf16_t* MIXp, LAS unsigned char* lds, const int unit, const int tid_in, const int wave, const int lane_in) {
    const int b = unit >> 5, h = (unit >> 3) & 3, qb = unit & 7;
    __syncthreads();
    {
        int tid_o = tid_in; asm volatile("" : "+v"(tid_o)); const int tid = tid_o;
        const bf16_t* kg = Kpl + (size_t)(b * NMEM) * XA + h * HD;
        const bf16_t* vg = VTl + (size_t)((b * NH + h) * HD) * NMEM;
#pragma unroll
        for (int i = 0; i < 8; ++i) { const int cid = tid + NTHR * i; const int row = cid >> 4, c = cid & 15;
            const u32x4 v = *(const u32x4*)(kg + (size_t)row * XA + c * 8);
            *(LAS u32x4*)(lds + row * 256 + ((c ^ (row & 15)) << 4)) = v; }
#pragma unroll
        for (int i = 0; i < 8; ++i) { const int cid = tid + NTHR * i; const int row = cid >> 5, c = cid & 31;
            const u32x4 v = *(const u32x4*)(vg + (size_t)row * NMEM + c * 8);
            *(LAS u32x4*)(lds + 65536 + row * 512 + ((c ^ (row & 15)) << 4)) = v; }
    }
    __syncthreads();
    int lane_o = lane_in; asm volatile("" : "+v"(lane_o)); const int lane = lane_o;
    const int qi = lane & 31, hh = lane >> 5;
    const int row = b * T_P + qb * 256 + wave * 32 + qi;
    const bf16_t* zr = Zb + (size_t)row * ldz;
    bf16x8 qf[8];
#pragma unroll
    for (int ks = 0; ks < 8; ++ks) qf[ks] = *(const bf16x8*)(zr + qoff + h * HD + 16 * ks + 8 * hh);
    const int pi = (qi & ~12) | ((qi & 4) << 1) | ((qi & 8) >> 1);
    int kb[8];
#pragma unroll
    for (int ks = 0; ks < 8; ++ks) kb[ks] = pi * 256 + (((2 * ks + hh) ^ (pi & 15)) << 4);
    int vb[8];
#pragma unroll
    for (int j = 0; j < 8; ++j) vb[j] = 65536 + qi * 512 + (((2 * j + hh) ^ (qi & 15)) << 4);
    f32x16 sacc[8];
#pragma unroll
    for (int T = 0; T < 8; ++T) {
#pragma unroll
        for (int r = 0; r < 16; ++r) sacc[T][r] = 0.f;
#pragma unroll
        for (int ks = 0; ks < 8; ++ks) { const bf16x8 kf = *(const LAS bf16x8*)(lds + kb[ks] + T * 8192);
            sacc[T] = __builtin_amdgcn_mfma_f32_32x32x16_bf16(kf, qf[ks], sacc[T], 0, 0, 0); }
    }
    float mx = -3.0e38f;
#pragma unroll
    for (int T = 0; T < 8; ++T)
#pragma unroll
        for (int r = 0; r < 16; ++r) mx = fmaxf(mx, sacc[T][r]);
    mx = fmaxf(mx, __shfl_xor(mx, 32));
    float sum = 0.f;
#pragma unroll
    for (int T = 0; T < 8; ++T)
#pragma unroll
        for (int r = 0; r < 16; ++r) { const float p = __builtin_amdgcn_exp2f((sacc[T][r] - mx) * 1.4426950408889634f); sacc[T][r] = p; sum += p; }
    sum += __shfl_xor(sum, 32);
    const float inv = 1.0f / sum;
    f32x16 oacc[4];
#pragma unroll
    for (int dt = 0; dt < 4; ++dt)
#pragma unroll
        for (int r = 0; r < 16; ++r) oacc[dt][r] = 0.f;
#pragma unroll
    for (int T = 0; T < 8; ++T)
#pragma unroll
        for (int s2 = 0; s2 < 2; ++s2) {
            u32x4 pw; pw.x = cvtpk(sacc[T][8 * s2 + 0], sacc[T][8 * s2 + 1]); pw.y = cvtpk(sacc[T][8 * s2 + 2], sacc[T][8 * s2 + 3]);
            pw.z = cvtpk(sacc[T][8 * s2 + 4], sacc[T][8 * s2 + 5]); pw.w = cvtpk(sacc[T][8 * s2 + 6], sacc[T][8 * s2 + 7]);
            const bf16x8 pf = __builtin_bit_cast(bf16x8, pw);
#pragma unroll
            for (int dt = 0; dt < 4; ++dt) {
                const bf16x8 vf = *(const LAS bf16x8*)(lds + vb[(T & 3) * 2 + s2] + (T >> 2) * 256 + dt * 16384);
                oacc[dt] = __builtin_amdgcn_mfma_f32_32x32x16_bf16(vf, pf, oacc[dt], 0, 0, 0); }
        }
    bf16_t* mr = MIXp + (size_t)row * MW + BR + h * HD;
#pragma unroll
    for (int dt = 0; dt < 4; ++dt)
#pragma unroll
        for (int g4 = 0; g4 < 4; ++g4) { const int d0 = 32 * dt + 8 * g4 + 4 * hh;
            const u32x2 gw2 = *(const u32x2*)(zr + goff + h * HD + d0);
            const float o0 = oacc[dt][4 * g4 + 0] * inv * __uint_as_float(gw2.x << 16), o1 = oacc[dt][4 * g4 + 1] * inv * __uint_as_float(gw2.x & 0xffff0000u);
            const float o2 = oacc[dt][4 * g4 + 2] * inv * __uint_as_float(gw2.y << 16), o3 = oacc[dt][4 * g4 + 3] * inv * __uint_as_float(gw2.y & 0xffff0000u);
            u32x2 w; w.x = cvtpk(o0, o1); w.y = cvtpk(o2, o3);
            *(u32x2*)(mr + d0) = w; }
}

DI void team_sync(volatile LAS unsigned* ctr, const unsigned target, const int lane) {
    LDS_WAIT();
    if (lane == 0) __hip_atomic_fetch_add((LAS unsigned*)ctr, 1u, __ATOMIC_RELAXED, __HIP_MEMORY_SCOPE_WORKGROUP);
    while (*ctr < target) { __builtin_amdgcn_s_sleep(1); }
    asm volatile("" ::: "memory");
}
DI void attn_prompt_unit4(const bf16_t* Zb, const int ldz, const int qoff, const int goff, const bf16_t* Kpl, const bf16_t* VTl, bf16_t* MIXp, LAS unsigned char* lds, volatile LAS unsigned* ctr, const unsigned epoch,
                          const int unit, const int t4_in, const int w4, const int lane_in) {
    const int b = unit >> 5, h = (unit >> 3) & 3, qb = unit & 7;
    {
        int t4_o = t4_in; asm volatile("" : "+v"(t4_o)); const int t4 = t4_o;
        const bf16_t* kg = Kpl + (size_t)(b * NMEM) * XA + h * HD;
        const bf16_t* vg = VTl + (size_t)((b * NH + h) * HD) * NMEM;
#pragma unroll
        for (int half = 0; half < 2; ++half) {
            u32x4 v[8];
#pragma unroll
            for (int i = 0; i < 8; ++i) { const int cid = t4 + 256 * (8 * half + i); const int row = cid >> 4, c = cid & 15; v[i] = *(const u32x4*)(kg + (size_t)row * XA + c * 8); }
#pragma unroll
            for (int i = 0; i < 8; ++i) { const int cid = t4 + 256 * (8 * half + i); const int row = cid >> 4, c = cid & 15; *(LAS u32x4*)(lds + row * 256 + ((c ^ (row & 15)) << 4)) = v[i]; }
        }
#pragma unroll
        for (int half = 0; half < 2; ++half) {
            u32x4 v[8];
#pragma unroll
            for (int i = 0; i < 8; ++i) { const int cid = t4 + 256 * (8 * half + i); const int row = cid >> 5, c = cid & 31; v[i] = *(const u32x4*)(vg + (size_t)row * NMEM + c * 8); }
#pragma unroll
            for (int i = 0; i < 8; ++i) { const int cid = t4 + 256 * (8 * half + i); const int row = cid >> 5, c = cid & 31; *(LAS u32x4*)(lds + 65536 + row * 512 + ((c ^ (row & 15)) << 4)) = v[i]; }
        }
    }
    team_sync(ctr, 8u * epoch + 4u, lane_in);
#pragma unroll 1
    for (int j = 0; j < 2; ++j) {
        int lane_o = lane_in; asm volatile("" : "+v"(lane_o)); const int lane = lane_o;
        const int qi = lane & 31, hh = lane >> 5;
        const int row = b * T_P + qb * 256 + (w4 + 4 * j) * 32 + qi;
        const bf16_t* zr = Zb + (size_t)row * ldz;
        bf16x8 qf[8];
#pragma unroll
        for (int ks = 0; ks < 8; ++ks) qf[ks] = *(const bf16x8*)(zr + qoff + h * HD + 16 * ks + 8 * hh);
        const int pi = (qi & ~12) | ((qi & 4) << 1) | ((qi & 8) >> 1);
        const int kbase = pi * 256, kx = pi & 15, vbase = 65536 + qi * 512, vx = qi & 15;
        f32x16 sacc[8];
#define AU_LDK(KF, T) do { _Pragma("unroll") for (int ks = 0; ks < 8; ++ks) KF[ks] = *(const LAS bf16x8*)(lds + kbase + (((2 * ks + hh) ^ kx) << 4) + (T) * 8192); } while (0)
#define AU_QK(KF, T) do { _Pragma("unroll") for (int r = 0; r < 16; ++r) sacc[T][r] = 0.f; \
            _Pragma("unroll") for (int ks = 0; ks < 8; ++ks) sacc[T] = __builtin_amdgcn_mfma_f32_32x32x16_bf16(KF[ks], qf[ks], sacc[T], 0, 0, 0); } while (0)
        { bf16x8 kfA[8], kfB[8];
          AU_LDK(kfA, 0);
#pragma unroll
          for (int T = 0; T < 8; T += 2) {
              AU_LDK(kfB, T + 1); __builtin_amdgcn_sched_barrier(0); AU_QK(kfA, T); __builtin_amdgcn_sched_barrier(0);
              if (T + 2 < 8) AU_LDK(kfA, T + 2);
              __builtin_amdgcn_sched_barrier(0); AU_QK(kfB, T + 1); __builtin_amdgcn_sched_barrier(0);
          } }
#undef AU_QK
#undef AU_LDK
        float mx = -3.0e38f;
#pragma unroll
        for (int T = 0; T < 8; ++T)
#pragma unroll
            for (int r = 0; r < 16; ++r) mx = fmaxf(mx, sacc[T][r]);
        mx = fmaxf(mx, __shfl_xor(mx, 32));
        float sum = 0.f;
#pragma unroll
        for (int T = 0; T < 8; ++T)
#pragma unroll
            for (int r = 0; r < 16; ++r) { const float p = __builtin_amdgcn_exp2f((sacc[T][r] - mx) * 1.4426950408889634f); sacc[T][r] = p; sum += p; }
        sum += __shfl_xor(sum, 32);
        const float inv = 1.0f / sum;
        f32x16 oacc[4];
#pragma unroll
        for (int dt = 0; dt < 4; ++dt)
#pragma unroll
            for (int r = 0; r < 16; ++r) oacc[dt][r] = 0.f;
#define AU_LDV(VF, TS) do { _Pragma("unroll") for (int dt = 0; dt < 4; ++dt) VF[dt] = *(const LAS bf16x8*)(lds + vbase + (((2 * ((((TS) >> 1) & 3) * 2 + ((TS) & 1)) + hh) ^ vx) << 4) + ((TS) >> 3) * 256 + dt * 16384); } while (0)
#define AU_PV(VF, TS) do { const int T_ = (TS) >> 1, s2_ = (TS) & 1; \
            u32x4 pw; pw.x = cvtpk(sacc[T_][8 * s2_ + 0], sacc[T_][8 * s2_ + 1]); pw.y = cvtpk(sacc[T_][8 * s2_ + 2], sacc[T_][8 * s2_ + 3]); \
            pw.z = cvtpk(sacc[T_][8 * s2_ + 4], sacc[T_][8 * s2_ + 5]); pw.w = cvtpk(sacc[T_][8 * s2_ + 6], sacc[T_][8 * s2_ + 7]); \
            const bf16x8 pf = __builtin_bit_cast(bf16x8, pw); \
            _Pragma("unroll") for (int dt = 0; dt < 4; ++dt) oacc[dt] = __builtin_amdgcn_mfma_f32_32x32x16_bf16(VF[dt], pf, oacc[dt], 0, 0, 0); } while (0)
        { bf16x8 vfA[4], vfB[4];
          AU_LDV(vfA, 0);
#pragma unroll
          for (int ts = 0; ts < 16; ts += 2) {
              AU_LDV(vfB, ts + 1); __builtin_amdgcn_sched_barrier(0); AU_PV(vfA, ts); __builtin_amdgcn_sched_barrier(0);
              if (ts + 2 < 16) AU_LDV(vfA, ts + 2);
              __builtin_amdgcn_sched_barrier(0); AU_PV(vfB, ts + 1); __builtin_amdgcn_sched_barrier(0);
          } }
#undef AU_PV
#undef AU_LDV
        bf16_t* mr = MIXp + (size_t)row * MW + BR + h * HD;
#pragma unroll
        for (int dt = 0; dt < 4; ++dt)
#pragma unroll
            for (int g4 = 0; g4 < 4; ++g4) { const int d0 = 32 * dt + 8 * g4 + 4 * hh;
                const u32x2 gw2 = *(const u32x2*)(zr + goff + h * HD + d0);
                const float o0 = oacc[dt][4 * g4 + 0] * inv * __uint_as_float(gw2.x << 16), o1 = oacc[dt][4 * g4 + 1] * inv * __uint_as_float(gw2.x & 0xffff0000u);
                const float o2 = oacc[dt][4 * g4 + 2] * inv * __uint_as_float(gw2.y << 16), o3 = oacc[dt][4 * g4 + 3] * inv * __uint_as_float(gw2.y & 0xffff0000u);
                u32x2 w; w.x = cvtpk(o0, o1); w.y = cvtpk(o2, o3);
                *(u32x2*)(mr + d0) = w; }
    }
    team_sync(ctr, 8u * epoch + 8u, lane_in);
}

DI void attn_prompt_unit_kv(const bf16_t* Zb, const int ldz, const int qoff, const int goff, const bf16_t* Kpl, const bf16_t* VTl, bf16_t* MIXp, LAS unsigned char* buf, volatile LAS unsigned* ctr, const unsigned epoch,
                            const int unit, const int t4_in, const int w4, const int lane_in) {
    const int b = unit >> 6, h = (unit >> 4) & 3, qb = unit & 15;
    int t4_o = t4_in, lane_o = lane_in; asm volatile("" : "+v"(t4_o), "+v"(lane_o)); const int t4 = t4_o, lane = lane_o;
    {   const bf16_t* kg = Kpl + (size_t)(b * NMEM) * XA + h * HD;
#pragma unroll
        for (int half = 0; half < 2; ++half) {
            u32x4 v[8];
#pragma unroll
            for (int i = 0; i < 8; ++i) { const int cid = t4 + 256 * (8 * half + i); const int row = cid >> 4, c = cid & 15; v[i] = *(const u32x4*)(kg + (size_t)row * XA + c * 8); }
#pragma unroll
            for (int i = 0; i < 8; ++i) { const int cid = t4 + 256 * (8 * half + i); const int row = cid >> 4, c = cid & 15; *(LAS u32x4*)(buf + row * 256 + ((c ^ (row & 15)) << 4)) = v[i]; }
        }
    }
    team_sync(ctr, 16u * epoch + 4u, lane);
    const int qi = lane & 31, hh = lane >> 5;
    const int row = b * T_P + qb * 128 + w4 * 32 + qi;
    const bf16_t* zr = Zb + (size_t)row * ldz;
    f32x16 sacc[8];
    {
        bf16x8 qf[8];
#pragma unroll
        for (int ks = 0; ks < 8; ++ks) qf[ks] = *(const bf16x8*)(zr + qoff + h * HD + 16 * ks + 8 * hh);
        const int pi = (qi & ~12) | ((qi & 4) << 1) | ((qi & 8) >> 1);
        const int kbase = pi * 256, kx = pi & 15;
#define AU_LDK(KF, T) do { _Pragma("unroll") for (int ks = 0; ks < 8; ++ks) KF[ks] = *(const LAS bf16x8*)(buf + kbase + (((2 * ks + hh) ^ kx) << 4) + (T) * 8192); } while (0)
#define AU_QK(KF, T) do { _Pragma("unroll") for (int r = 0; r < 16; ++r) sacc[T][r] = 0.f; \
            _Pragma("unroll") for (int ks = 0; ks < 8; ++ks) sacc[T] = __builtin_amdgcn_mfma_f32_32x32x16_bf16(KF[ks], qf[ks], sacc[T], 0, 0, 0); } while (0)
        { bf16x8 kfA[8], kfB[8];
          AU_LDK(kfA, 0);
#pragma unroll
          for (int T = 0; T < 8; T += 2) {
              AU_LDK(kfB, T + 1); __builtin_amdgcn_sched_barrier(0); AU_QK(kfA, T); __builtin_amdgcn_sched_barrier(0);
              if (T + 2 < 8) AU_LDK(kfA, T + 2);
              __builtin_amdgcn_sched_barrier(0); AU_QK(kfB, T + 1); __builtin_amdgcn_sched_barrier(0);
          } }
#undef AU_QK
#undef AU_LDK
    }
    team_sync(ctr, 16u * epoch + 8u, lane);
    {   const bf16_t* vg = VTl + (size_t)((b * NH + h) * HD) * NMEM;
#pragma unroll
        for (int half = 0; half < 2; ++half) {
            u32x4 v[8];
#pragma unroll
            for (int i = 0; i < 8; ++i) { const int cid = t4 + 256 * (8 * half + i); const int rw = cid >> 5, c = cid & 31; v[i] = *(const u32x4*)(vg + (size_t)rw * NMEM + c * 8); }
#pragma unroll
            for (int i = 0; i < 8; ++i) { const int cid = t4 + 256 * (8 * half + i); const int rw = cid >> 5, c = cid & 31; *(LAS u32x4*)(buf + rw * 512 + ((c ^ (rw & 15)) << 4)) = v[i]; }
        }
    }
    float mx = -3.0e38f;
#pragma unroll
    for (int T = 0; T < 8; ++T)
#pragma unroll
        for (int r = 0; r < 16; ++r) mx = fmaxf(mx, sacc[T][r]);
    mx = fmaxf(mx, __shfl_xor(mx, 32));
    float sum = 0.f;
#pragma unroll
    for (int T = 0; T < 8; ++T)
#pragma unroll
        for (int r = 0; r < 16; ++r) { const float p = __builtin_amdgcn_exp2f((sacc[T][r] - mx) * 1.4426950408889634f); sacc[T][r] = p; sum += p; }
    sum += __shfl_xor(sum, 32);
    const float inv = 1.0f / sum;
    team_sync(ctr, 16u * epoch + 12u, lane);
    f32x16 oacc[4];
#pragma unroll
    for (int dt = 0; dt < 4; ++dt)
#pragma unroll
        for (int r = 0; r < 16; ++r) oacc[dt][r] = 0.f;
    const int vbase = qi * 512, vx = qi & 15;
#define AU_LDV(VF, TS) do { _Pragma("unroll") for (int dt = 0; dt < 4; ++dt) VF[dt] = *(const LAS bf16x8*)(buf + vbase + (((2 * ((((TS) >> 1) & 3) * 2 + ((TS) & 1)) + hh) ^ vx) << 4) + ((TS) >> 3) * 256 + dt * 16384); } while (0)
#define AU_PV(VF, TS) do { const int T_ = (TS) >> 1, s2_ = (TS) & 1; \
            u32x4 pw; pw.x = cvtpk(sacc[T_][8 * s2_ + 0], sacc[T_][8 * s2_ + 1]); pw.y = cvtpk(sacc[T_][8 * s2_ + 2], sacc[T_][8 * s2_ + 3]); \
            pw.z = cvtpk(sacc[T_][8 * s2_ + 4], sacc[T_][8 * s2_ + 5]); pw.w = cvtpk(sacc[T_][8 * s2_ + 6], sacc[T_][8 * s2_ + 7]); \
            const bf16x8 pf = __builtin_bit_cast(bf16x8, pw); \
            _Pragma("unroll") for (int dt = 0; dt < 4; ++dt) oacc[dt] = __builtin_amdgcn_mfma_f32_32x32x16_bf16(VF[dt], pf, oacc[dt], 0, 0, 0); } while (0)
        { bf16x8 vfA[4], vfB[4];
          AU_LDV(vfA, 0);
#pragma unroll
          for (int ts = 0; ts < 16; ts += 2) {
              AU_LDV(vfB, ts + 1); __builtin_amdgcn_sched_barrier(0); AU_PV(vfA, ts); __builtin_amdgcn_sched_barrier(0);
              if (ts + 2 < 16) AU_LDV(vfA, ts + 2);
              __builtin_amdgcn_sched_barrier(0); AU_PV(vfB, ts + 1); __builtin_amdgcn_sched_barrier(0);
          } }
#undef AU_PV
#undef AU_LDV
    team_sync(ctr, 16u * epoch + 16u, lane);
    bf16_t* mr = MIXp + (size_t)row * MW + BR + h * HD;
#pragma unroll
    for (int dt = 0; dt < 4; ++dt)
#pragma unroll
        for (int g4 = 0; g4 < 4; ++g4) { const int d0 = 32 * dt + 8 * g4 + 4 * hh;
            const u32x2 gw2 = *(const u32x2*)(zr + goff + h * HD + d0);
            const float o0 = oacc[dt][4 * g4 + 0] * inv * __uint_as_float(gw2.x << 16), o1 = oacc[dt][4 * g4 + 1] * inv * __uint_as_float(gw2.x & 0xffff0000u);
            const float o2 = oacc[dt][4 * g4 + 2] * inv * __uint_as_float(gw2.y << 16), o3 = oacc[dt][4 * g4 + 3] * inv * __uint_as_float(gw2.y & 0xffff0000u);
            u32x2 w; w.x = cvtpk(o0, o1); w.y = cvtpk(o2, o3);
            *(u32x2*)(mr + d0) = w; }
}

typedef short s16x4 __attribute__((ext_vector_type(4)));
DI s16x4 tr_read16(const LAS unsigned char* p) { return __builtin_amdgcn_ds_read_tr16_b64_v4i16((LAS s16x4*)p); }
template <bool SAMPLE>
DI void s5_item(const bf16_t* Z1, const bf16_t* bbt, const bf16_t* ctt, const float* lbt, const float* dvec, const float* h0re, const float* h0im, float* hout_re, float* hout_im, bf16_t* YGp,
                LAS unsigned char* img, const int item, const int lane_in) {
    int lane_o = lane_in; asm volatile("" : "+v"(lane_o)); const int lane = lane_o;
    const int n = lane & 31, hh = lane >> 5, i16 = lane & 15, G4 = lane >> 4;
    const int g = SAMPLE ? item >> 4 : item >> 2, sub = SAMPLE ? (item & 15) : (item & 3);
    bf16x8 bfrag[4], cfrag[4];
#pragma unroll
    for (int j = 0; j < 4; ++j) { bfrag[j] = *(const bf16x8*)(bbt + ((size_t)g * 128 + 32 * j + n) * SC + 8 * hh); cfrag[j] = *(const bf16x8*)(ctt + ((size_t)g * SC + i16) * 128 + 32 * j + 8 * G4); }
    bf16x8 ifrag;
#pragma unroll
    for (int e = 0; e < 8; ++e) ifrag[e] = (n == 8 * hh + e) ? (short)0x3f80 : (short)0;
    bf16x8 dfrag; { const float dv = dvec[g * SC + i16];
#pragma unroll
        for (int e = 0; e < 8; ++e) dfrag[e] = (8 * G4 + e == i16) ? (short)f2bf(dv) : (short)0; }
    const float lbr0 = lbt[2 * (g * SP + n)], lbi0 = lbt[2 * (g * SP + n) + 1], lbr1 = lbt[2 * (g * SP + 32 + n)], lbi1 = lbt[2 * (g * SP + 32 + n) + 1];
    const int ha = (n >> 2) & 1, ra = (n & 3) + 4 * (n >> 3);
    int rowA, rowE[2];
    if (SAMPLE) { rowA = MP + (8 * sub + 4 * ha + (ra >> 2)) * T_S + (ra & 3); }
    else { rowA = (2 * sub + ha) * T_P + ra; }
#pragma unroll
    for (int rt = 0; rt < 2; ++rt) { const int rho = 16 * rt + i16, he = (rho >> 2) & 1, re = (rho & 3) + 4 * (rho >> 3);
        rowE[rt] = SAMPLE ? MP + (8 * sub + 4 * he + (re >> 2)) * T_S + (re & 3) : (2 * sub + he) * T_P + re; }
    const bf16_t* ua = Z1 + ((size_t)g * M + rowA) * SC + 8 * hh;
    bf16_t* yo0 = YGp + ((size_t)g * M + rowE[0]) * SC + 4 * G4; bf16_t* yo1 = YGp + ((size_t)g * M + rowE[1]) * SC + 4 * G4;
    const LAS unsigned char* trb = img + (8 * G4 + (i16 >> 2)) * 72 + 8 * (i16 & 3);
    LAS unsigned char* wrb = img + n * 72 + 8 * hh;
    float hr0 = 0.f, hi0 = 0.f, hr1 = 0.f, hi1 = 0.f;
    float s0r[4], s0i[4], s1r[4], s1i[4];
    if (SAMPLE) {
#pragma unroll
        for (int q = 0; q < 4; ++q) { const size_t o = ((size_t)(8 * sub + 4 * hh + q) * SG + g) * SP; s0r[q] = h0re[o + n]; s0i[q] = h0im[o + n]; s1r[q] = h0re[o + 32 + n]; s1i[q] = h0im[o + 32 + n]; }
    }
#define S5_STEP(UB, YO) do { \
        f32x16 T[5]; \
        _Pragma("unroll") for (int j = 0; j < 5; ++j) { \
            _Pragma("unroll") for (int r = 0; r < 16; ++r) T[j][r] = 0.f; \
            T[j] = __builtin_amdgcn_mfma_f32_32x32x16_bf16(UB, j < 4 ? bfrag[j] : ifrag, T[j], 0, 0, 0); } \
        _Pragma("unroll") for (int r = 0; r < 16; ++r) { \
            if (SAMPLE && (r & 3) == 0) { hr0 = s0r[r >> 2]; hi0 = s0i[r >> 2]; hr1 = s1r[r >> 2]; hi1 = s1i[r >> 2]; } \
            const float nr0 = fmaf(lbr0, hr0, fmaf(-lbi0, hi0, T[0][r])), ni0 = fmaf(lbr0, hi0, fmaf(lbi0, hr0, T[2][r])); \
            const float nr1 = fmaf(lbr1, hr1, fmaf(-lbi1, hi1, T[1][r])), ni1 = fmaf(lbr1, hi1, fmaf(lbi1, hr1, T[3][r])); \
            hr0 = nr0; hi0 = ni0; hr1 = nr1; hi1 = ni1; T[0][r] = nr0; T[2][r] = ni0; T[1][r] = nr1; T[3][r] = ni1; \
            if (SAMPLE && (r & 3) == 3) { const int b = 8 * sub + 4 * hh + (r >> 2); const size_t o = ((size_t)b * SG + g) * SP; \
                hout_re[o + n] = hr0; hout_im[o + n] = hi0; hout_re[o + 32 + n] = hr1; hout_im[o + 32 + n] = hi1; } \
        } \
        _Pragma("unroll") for (int j = 0; j < 5; ++j) \
            _Pragma("unroll") for (int gq = 0; gq < 4; ++gq) { u32x2 w; w.x = cvtpk(T[j][4 * gq], T[j][4 * gq + 1]); w.y = cvtpk(T[j][4 * gq + 2], T[j][4 * gq + 3]); \
                *(LAS u32x2*)(wrb + j * 2304 + 16 * gq) = w; } \
        LDS_WAIT(); \
        f32x4 ya[2]; \
        _Pragma("unroll") for (int rt = 0; rt < 2; ++rt) ya[rt] = (f32x4){0.f, 0.f, 0.f, 0.f}; \
        _Pragma("unroll") for (int kq = 0; kq < 5; ++kq) \
            _Pragma("unroll") for (int rt = 0; rt < 2; ++rt) { const s16x4 lo = tr_read16(trb + kq * 2304 + rt * 32), hi = tr_read16(trb + kq * 2304 + rt * 32 + 288); \
                const bf16x8 hb = __builtin_shufflevector(lo, hi, 0, 1, 2, 3, 4, 5, 6, 7); \
                ya[rt] = __builtin_amdgcn_mfma_f32_16x16x32_bf16(kq < 4 ? cfrag[kq] : dfrag, hb, ya[rt], 0, 0, 0); } \
        LDS_WAIT(); \
        _Pragma("unroll") for (int rt = 0; rt < 2; ++rt) { \
            const float y0 = gelu_tanh(ya[rt][0]), y1 = gelu_tanh(ya[rt][1]), y2 = gelu_tanh(ya[rt][2]), y3 = gelu_tanh(ya[rt][3]); \
            YO[rt].x = cvtpk(y0, y1); YO[rt].y = cvtpk(y2, y3); } \
    } while (0)
#define S5_LOAD4(U, GI) do { _Pragma("unroll") for (int q4 = 0; q4 < 4; ++q4) U[q4] = *(const bf16x8*)(ua + (size_t)((GI) * 4 + q4) * 16 * SC); } while (0)
#define S5_STORE4(Y, GI) do { _Pragma("unroll") for (int q4 = 0; q4 < 4; ++q4) { *(u32x2*)(yo0 + (size_t)((GI) * 4 + q4) * 16 * SC) = Y[q4][0]; *(u32x2*)(yo1 + (size_t)((GI) * 4 + q4) * 16 * SC) = Y[q4][1]; } } while (0)
#define S5_GROUP(UC, UN, YP, YC, GI) do { \
        { const int gn = ((GI) + 1 < NGRP) ? (GI) + 1 : NGRP - 1; S5_LOAD4(UN, gn); } \
        if ((GI) > 0) S5_STORE4(YP, (GI) - 1); \
        __builtin_amdgcn_sched_barrier(0); \
        S5_STEP(UC[0], YC[0]); S5_STEP(UC[1], YC[1]); S5_STEP(UC[2], YC[2]); S5_STEP(UC[3], YC[3]); \
    } while (0)
    if (SAMPLE) { bf16x8 u1 = *(const bf16x8*)ua; u32x2 ysmp[2]; S5_STEP(u1, ysmp); *(u32x2*)yo0 = ysmp[0]; *(u32x2*)yo1 = ysmp[1]; }
    else {
        constexpr int NGRP = T_P / 64;
        bf16x8 uA[4], uB[4]; u32x2 yA[4][2], yB[4][2];
        S5_LOAD4(uA, 0);
#pragma unroll 1
        for (int gi = 0; gi < NGRP; gi += 2) { S5_GROUP(uA, uB, yB, yA, gi); S5_GROUP(uB, uA, yA, yB, gi + 1); }
        S5_STORE4(yB, NGRP - 1);
    }
#undef S5_GROUP
#undef S5_STORE4
#undef S5_LOAD4
#undef S5_STEP
    if (!SAMPLE) { const size_t o = ((size_t)(2 * sub + hh) * SG + g) * SP;
        hout_re[o + n] = hr0; hout_im[o + n] = hi0; hout_re[o + 32 + n] = hr1; hout_im[o + 32 + n] = hi1; }
}


DI void s5_item_split(const bf16_t* Z1, const bf16_t* bbt, const bf16_t* ctt, const float* lbt, const float* dvec, float* hout_re, float* hout_im, bf16_t* YGp,
                      LAS unsigned char* img2, volatile LAS unsigned* flags, const int item, const int r, const int lane_in) {
    int lane_o = lane_in; asm volatile("" : "+v"(lane_o)); const int lane = lane_o;
    const int n = lane & 31, hh = lane >> 5, i16 = lane & 15, G4 = lane >> 4;
    const int g = item >> 2, sub = item & 3;
    const bf16x8 bre = *(const bf16x8*)(bbt + ((size_t)g * 128 + 32 * r + n) * SC + 8 * hh), bim = *(const bf16x8*)(bbt + ((size_t)g * 128 + 64 + 32 * r + n) * SC + 8 * hh);
    bf16x8 cfrag[4];
#pragma unroll
    for (int j = 0; j < 4; ++j) cfrag[j] = *(const bf16x8*)(ctt + ((size_t)g * SC + i16) * 128 + 32 * j + 8 * G4);
    bf16x8 ifrag;
#pragma unroll
    for (int e = 0; e < 8; ++e) ifrag[e] = (n == 8 * hh + e) ? (short)0x3f80 : (short)0;
    bf16x8 dfrag; { const float dv = dvec[g * SC + i16];
#pragma unroll
        for (int e = 0; e < 8; ++e) dfrag[e] = (8 * G4 + e == i16) ? (short)f2bf(dv) : (short)0; }
    const float lbr = lbt[2 * (g * SP + 32 * r + n)], lbi = lbt[2 * (g * SP + 32 * r + n) + 1];
    const int ha = (n >> 2) & 1, ra = (n & 3) + 4 * (n >> 3);
    const int rowA = (2 * sub + ha) * T_P + ra;
    const int rho = 16 * r + i16, he = (rho >> 2) & 1, re = (rho & 3) + 4 * (rho >> 3);
    const int rowE = (2 * sub + he) * T_P + re;
    const bf16_t* ua = Z1 + (size_t)rowA * NBW + g * SC + 8 * hh;
    bf16_t* yo = YGp + (size_t)rowE * BR + g * SC + 4 * G4;
    const int trofs = (8 * G4 + (i16 >> 2)) * 72 + 8 * (i16 & 3) + r * 32;
    const int wrre = (32 * r + n) * 72 + 8 * hh, wrim = (64 + 32 * r + n) * 72 + 8 * hh, wru = (128 + n) * 72 + 8 * hh;
    volatile LAS unsigned* fmine = flags + r; volatile LAS unsigned* fother = flags + (1 - r);
    float hr = 0.f, hi = 0.f;
    constexpr int NGRP = T_P / 64;
#define S5S_STEP(UB, YO, SIDX) do { \
        LAS unsigned char* buf = img2 + (((SIDX) & 1) ? 11520 : 0); \
        f32x16 Tr, Ti, Tu; \
        _Pragma("unroll") for (int q = 0; q < 16; ++q) { Tr[q] = 0.f; Ti[q] = 0.f; Tu[q] = 0.f; } \
        Tr = __builtin_amdgcn_mfma_f32_32x32x16_bf16(UB, bre, Tr, 0, 0, 0); Ti = __builtin_amdgcn_mfma_f32_32x32x16_bf16(UB, bim, Ti, 0, 0, 0); \
        if (r == 0) Tu = __builtin_amdgcn_mfma_f32_32x32x16_bf16(UB, ifrag, Tu, 0, 0, 0); \
        _Pragma("unroll") for (int q = 0; q < 16; ++q) { \
            const float nr = fmaf(lbr, hr, fmaf(-lbi, hi, Tr[q])), ni = fmaf(lbr, hi, fmaf(lbi, hr, Ti[q])); hr = nr; hi = ni; Tr[q] = nr; Ti[q] = ni; } \
        _Pragma("unroll") for (int gq = 0; gq < 4; ++gq) { u32x2 w; w.x = cvtpk(Tr[4 * gq], Tr[4 * gq + 1]); w.y = cvtpk(Tr[4 * gq + 2], Tr[4 * gq + 3]); *(LAS u32x2*)(buf + wrre + 16 * gq) = w; \
            w.x = cvtpk(Ti[4 * gq], Ti[4 * gq + 1]); w.y = cvtpk(Ti[4 * gq + 2], Ti[4 * gq + 3]); *(LAS u32x2*)(buf + wrim + 16 * gq) = w; } \
        if (r == 0) { _Pragma("unroll") for (int gq = 0; gq < 4; ++gq) { u32x2 w; w.x = cvtpk(Tu[4 * gq], Tu[4 * gq + 1]); w.y = cvtpk(Tu[4 * gq + 2], Tu[4 * gq + 3]); *(LAS u32x2*)(buf + wru + 16 * gq) = w; } } \
        LDS_WAIT(); \
        *fmine = (unsigned)((SIDX) + 1); \
        while (*fother < (unsigned)((SIDX) + 1)) { __builtin_amdgcn_s_sleep(0); } \
        asm volatile("" ::: "memory"); \
        f32x4 ya = (f32x4){0.f, 0.f, 0.f, 0.f}; \
        _Pragma("unroll") for (int kq = 0; kq < 5; ++kq) { const s16x4 lo = tr_read16(buf + trofs + kq * 2304), hi2 = tr_read16(buf + trofs + kq * 2304 + 288); \
            const bf16x8 hb = __builtin_shufflevector(lo, hi2, 0, 1, 2, 3, 4, 5, 6, 7); \
            ya = __builtin_amdgcn_mfma_f32_16x16x32_bf16(kq < 4 ? cfrag[kq] : dfrag, hb, ya, 0, 0, 0); } \
        LDS_WAIT(); \
        { const float y0 = gelu_tanh(ya[0]), y1 = gelu_tanh(ya[1]), y2 = gelu_tanh(ya[2]), y3 = gelu_tanh(ya[3]); YO.x = cvtpk(y0, y1); YO.y = cvtpk(y2, y3); } \
    } while (0)
#define S5S_LOAD4(U, GI) do { _Pragma("unroll") for (int q4 = 0; q4 < 4; ++q4) U[q4] = *(const bf16x8*)(ua + (size_t)((GI) * 4 + q4) * 16 * NBW); } while (0)
#define S5S_STORE4(Y, GI) do { _Pragma("unroll") for (int q4 = 0; q4 < 4; ++q4) *(u32x2*)(yo + (size_t)((GI) * 4 + q4) * 16 * BR) = Y[q4]; } while (0)
#define S5S_GROUP(UC, UN, YP, YC, GI) do { \
        { const int gn = ((GI) + 1 < NGRP) ? (GI) + 1 : NGRP - 1; S5S_LOAD4(UN, gn); } \
        if ((GI) > 0) S5S_STORE4(YP, (GI) - 1); \
        __builtin_amdgcn_sched_barrier(0); \
        S5S_STEP(UC[0], YC[0], (GI) * 4 + 0); S5S_STEP(UC[1], YC[1], (GI) * 4 + 1); S5S_STEP(UC[2], YC[2], (GI) * 4 + 2); S5S_STEP(UC[3], YC[3], (GI) * 4 + 3); \
    } while (0)
    bf16x8 uA[4], uB[4]; u32x2 yA[4], yB[4];
    S5S_LOAD4(uA, 0);
#pragma unroll 1
    for (int gi = 0; gi < NGRP; gi += 2) { S5S_GROUP(uA, uB, yB, yA, gi); S5S_GROUP(uB, uA, yA, yB, gi + 1); }
    S5S_STORE4(yB, NGRP - 1);
#undef S5S_GROUP
#undef S5S_STORE4
#undef S5S_LOAD4
#undef S5S_STEP
    { const size_t o = ((size_t)(2 * sub + hh) * SG + g) * SP + 32 * r; hout_re[o + n] = hr; hout_im[o + n] = hi; }
}
constexpr int S5_NBUF = 4, S5_IMG = 11520;
template <int r>
DI void s5_prod(const bf16_t* Z1, const bf16_t* bbt, const float* lbt, float* hout_re, float* hout_im,
                LAS unsigned char* img, volatile LAS unsigned* flags, const int item, const int lane_in) {
    int lane_o = lane_in; asm volatile("" : "+v"(lane_o)); const int lane = lane_o;
    const int n = lane & 31, hh = lane >> 5;
    const int g = item >> 2, sub = item & 3;
    const bf16x8 bre = *(const bf16x8*)(bbt + ((size_t)g * 128 + 32 * r + n) * SC + 8 * hh), bim = *(const bf16x8*)(bbt + ((size_t)g * 128 + 64 + 32 * r + n) * SC + 8 * hh);
    bf16x8 ifrag;
#pragma unroll
    for (int e = 0; e < 8; ++e) ifrag[e] = (n == 8 * hh + e) ? (short)0x3f80 : (short)0;
    const float lbr = lbt[2 * (g * SP + 32 * r + n)], lbi = lbt[2 * (g * SP + 32 * r + n) + 1];
    const int ha = (n >> 2) & 1, ra = (n & 3) + 4 * (n >> 3);
    const int rowA = (2 * sub + ha) * T_P + ra;
    const bf16_t* ua = Z1 + ((size_t)g * M + rowA) * SC + 8 * hh;
    const int wrre = (32 * r + n) * 72 + 8 * hh, wrim = (64 + 32 * r + n) * 72 + 8 * hh, wru = (128 + n) * 72 + 8 * hh;
    volatile LAS unsigned* fmine = flags + r; volatile LAS unsigned long long* fcons = (volatile LAS unsigned long long*)(flags + 2);
    float hr = 0.f, hi = 0.f;
    constexpr int NGRP = T_P / 64;
#define S5P_STEP(UB, SIDX, J) do { \
        LAS unsigned char* buf = img + (J) * S5_IMG; \
        f32x16 Tr, Ti, Tu; \
        _Pragma("unroll") for (int q = 0; q < 16; ++q) { Tr[q] = 0.f; Ti[q] = 0.f; Tu[q] = 0.f; } \
        Tr = __builtin_amdgcn_mfma_f32_32x32x16_bf16(UB, bre, Tr, 0, 0, 0); Ti = __builtin_amdgcn_mfma_f32_32x32x16_bf16(UB, bim, Ti, 0, 0, 0); \
        if constexpr (r == 0) Tu = __builtin_amdgcn_mfma_f32_32x32x16_bf16(UB, ifrag, Tu, 0, 0, 0); \
        if (((J) & 1) == 0 && (SIDX) >= S5_NBUF) { const unsigned need = (unsigned)((SIDX) - 2);        \
            for (;;) { const unsigned long long fc = *fcons; if ((unsigned)fc >= need && (unsigned)(fc >> 32) >= need) break; __builtin_amdgcn_s_sleep(0); } \
            asm volatile("" ::: "memory"); } \
        _Pragma("unroll") for (int q = 0; q < 16; ++q) { \
            const float nr = fmaf(lbr, hr, fmaf(-lbi, hi, Tr[q])), ni = fmaf(lbr, hi, fmaf(lbi, hr, Ti[q])); hr = nr; hi = ni; \
            asm volatile("" : "+v"(hr)); asm volatile("" : "+v"(hi));         \
            Tr[q] = hr; Ti[q] = hi; } \
        if ((SIDX) > 0) { LDS_WAIT(); *fmine = (unsigned)(SIDX); }                                     \
        _Pragma("unroll") for (int gq = 0; gq < 4; ++gq) { u32x2 w; w.x = cvtpk(Tr[4 * gq], Tr[4 * gq + 1]); w.y = cvtpk(Tr[4 * gq + 2], Tr[4 * gq + 3]); *(LAS u32x2*)(buf + wrre + 16 * gq) = w; \
            w.x = cvtpk(Ti[4 * gq], Ti[4 * gq + 1]); w.y = cvtpk(Ti[4 * gq + 2], Ti[4 * gq + 3]); *(LAS u32x2*)(buf + wrim + 16 * gq) = w; } \
        if constexpr (r == 0) { _Pragma("unroll") for (int gq = 0; gq < 4; ++gq) { u32x2 w; w.x = cvtpk(Tu[4 * gq], Tu[4 * gq + 1]); w.y = cvtpk(Tu[4 * gq + 2], Tu[4 * gq + 3]); *(LAS u32x2*)(buf + wru + 16 * gq) = w; } } \
    } while (0)
#define S5P_LOAD4(U, GI) do { _Pragma("unroll") for (int q4 = 0; q4 < 4; ++q4) U[q4] = __builtin_nontemporal_load((const bf16x8*)(ua + (size_t)((GI) * 4 + q4) * 16 * SC)); } while (0)
#define S5P_GROUP(UC, UN, GI) do { \
        { const int gn = ((GI) + 3 < NGRP) ? (GI) + 3 : NGRP - 1; S5P_LOAD4(UN, gn); } \
        __builtin_amdgcn_sched_barrier(0); \
        S5P_STEP(UC[0], (GI) * 4 + 0, 0); S5P_STEP(UC[1], (GI) * 4 + 1, 1); S5P_STEP(UC[2], (GI) * 4 + 2, 2); S5P_STEP(UC[3], (GI) * 4 + 3, 3); \
    } while (0)
    bf16x8 uA[4], uB[4], uC[4], uD[4];
    S5P_LOAD4(uA, 0); S5P_LOAD4(uB, 1); S5P_LOAD4(uC, 2);
#pragma unroll 1
    for (int gi = 0; gi < NGRP; gi += 4) { S5P_GROUP(uA, uD, gi); S5P_GROUP(uB, uA, gi + 1); S5P_GROUP(uC, uB, gi + 2); S5P_GROUP(uD, uC, gi + 3); }
#undef S5P_GROUP
#undef S5P_LOAD4
#undef S5P_STEP
    LDS_WAIT(); *fmine = (unsigned)(NGRP * 4);
    { const size_t o = ((size_t)(2 * sub + hh) * SG + g) * SP + 32 * r; hout_re[o + n] = hr; hout_im[o + n] = hi; }
}
DI void s5_cons(const bf16_t* ctt, const float* dvec, bf16_t* YGp, LAS unsigned char* img, volatile LAS unsigned* flags, const int item, const int c, const int lane_in) {
    int lane_o = lane_in; asm volatile("" : "+v"(lane_o)); const int lane = lane_o;
    const int i16 = lane & 15, G4 = lane >> 4;
    const int g = item >> 2, sub = item & 3;
    bf16x8 cfrag[4];
#pragma unroll
    for (int j = 0; j < 4; ++j) cfrag[j] = *(const bf16x8*)(ctt + ((size_t)g * SC + i16) * 128 + 32 * j + 8 * G4);
    bf16x8 dfrag; { const float dv = dvec[g * SC + i16];
#pragma unroll
        for (int e = 0; e < 8; ++e) dfrag[e] = (8 * G4 + e == i16) ? (short)f2bf(dv) : (short)0; }
    const int rho = 16 * c + i16, he = (rho >> 2) & 1, re = (rho & 3) + 4 * (rho >> 3);
    const int rowE = (2 * sub + he) * T_P + re;
    bf16_t* yo = YGp + ((size_t)g * M + rowE) * SC + 4 * G4;
    const int trofs = (8 * G4 + (i16 >> 2)) * 72 + 8 * (i16 & 3) + c * 32;
    volatile LAS unsigned* fmine = flags + 2 + c; volatile LAS unsigned long long* fprod = (volatile LAS unsigned long long*)flags;
    constexpr int NGRP = T_P / 64;
#define S5C_BODY(YA, J) do { \
        const LAS unsigned char* buf = img + (J) * S5_IMG; \
        YA = (f32x4){0.f, 0.f, 0.f, 0.f}; \
        _Pragma("unroll") for (int kq = 0; kq < 5; ++kq) { const s16x4 lo = tr_read16(buf + trofs + kq * 2304), hi2 = tr_read16(buf + trofs + kq * 2304 + 288); \
            const bf16x8 hb = __builtin_shufflevector(lo, hi2, 0, 1, 2, 3, 4, 5, 6, 7); \
            YA = __builtin_amdgcn_mfma_f32_16x16x32_bf16(kq < 4 ? cfrag[kq] : dfrag, hb, YA, 0, 0, 0); } \
    } while (0)
#define S5C_GELU(YO, YA) do { const float y0 = gelu_tanh(YA[0]), y1 = gelu_tanh(YA[1]), y2 = gelu_tanh(YA[2]), y3 = gelu_tanh(YA[3]); YO.x = cvtpk(y0, y1); YO.y = cvtpk(y2, y3); } while (0)
#define S5C_PAIR(YO0, YO1, SIDX, J) do { \
        { const unsigned need = (unsigned)((SIDX) + 2); for (;;) { const unsigned long long fp = *fprod; if ((unsigned)fp >= need && (unsigned)(fp >> 32) >= need) break; __builtin_amdgcn_s_sleep(0); } \
          asm volatile("" ::: "memory"); } \
        f32x4 ya0, ya1; S5C_BODY(ya0, J); S5C_BODY(ya1, (J) + 1); \
        LDS_WAIT(); \
        *fmine = (unsigned)((SIDX) + 2); \
        S5C_GELU(YO0, ya0); S5C_GELU(YO1, ya1); \
    } while (0)
#define S5C_STORE4(Y, GI) do { _Pragma("unroll") for (int q4 = 0; q4 < 4; ++q4) *(u32x2*)(yo + (size_t)((GI) * 4 + q4) * 16 * SC) = Y[q4]; } while (0)
    u32x2 yA[4];
#pragma unroll 1
    for (int gi = 0; gi < NGRP; ++gi) {
        S5C_PAIR(yA[0], yA[1], gi * 4, 0); S5C_PAIR(yA[2], yA[3], gi * 4 + 2, 2);
        S5C_STORE4(yA, gi);
    }
#undef S5C_PAIR
#undef S5C_GELU
#undef S5C_BODY
#undef S5C_STORE4
}
DI void spatial_stage_w(const float* wg, LAS unsigned char* wimg, const int tid) {
#pragma unroll
    for (int i = 0; i < 4; ++i) { const int cid = tid + NTHR * i, t = cid >> 4, c = cid & 15;
        const f32x4 a = *(const f32x4*)(wg + t * CH + 8 * c), b = *(const f32x4*)(wg + t * CH + 8 * c + 4); const int s0 = 8 * c;
        u32x4 w; w.x = cvtpk(s0 + 0 <= t ? a.x : 0.f, s0 + 1 <= t ? a.y : 0.f); w.y = cvtpk(s0 + 2 <= t ? a.z : 0.f, s0 + 3 <= t ? a.w : 0.f);
        w.z = cvtpk(s0 + 4 <= t ? b.x : 0.f, s0 + 5 <= t ? b.y : 0.f); w.w = cvtpk(s0 + 6 <= t ? b.z : 0.f, s0 + 7 <= t ? b.w : 0.f);
        *(LAS u32x4*)(wimg + t * 256 + ((c ^ (t & 15)) << 4)) = w; }
}
DI void spatial_phase(const bf16_t* Zb, const float* vstat, const float* lng, const float* lnb, const float* wsp, const float* bsp, bf16_t* MIXp, LAS unsigned char* lds,
                      const int vcu, const int G, const int tid_in, const int wave, const int lane_in) {
    int tid_o = tid_in, lane_o = lane_in; asm volatile("" : "+v"(tid_o), "+v"(lane_o)); const int tid = tid_o, lane = lane_o;
    LAS unsigned char* wimg = lds; LAS unsigned char* vimg = lds + 32768; LAS unsigned char* oimg = vimg;
    constexpr int NITEM = (MP / CH) * AG;
    const bool act = tid < 504; const int cc = tid % 24, r0 = tid / 24;
    const int a = wave & 3, hf = wave >> 2, n = lane & 31, hh = lane >> 5, i16 = lane & 15, blk = (lane >> 4) & 1;
    const LAS unsigned char* trb = vimg + (8 * hh + (i16 >> 2)) * 448 + 32 * blk + 8 * (i16 & 3);
    u32x4 vw[7]; f32x2 st[7];
    int item = vcu, last_g = -1;
    if (item < NITEM && act) { const int g = item & 7, c = item >> 3;
#pragma unroll
        for (int i = 0; i < 7; ++i) { const int sr = r0 + 21 * i; if (sr < CH) { const int row = c * CH + sr; vw[i] = __builtin_nontemporal_load((const u32x4*)(Zb + (size_t)row * ZA + BR + g * AD + 8 * cc)); st[i] = *(const f32x2*)(vstat + 2 * row); } } }
    for (; item < NITEM; item += G) {
        const int g = item & 7, c = item >> 3;
        __syncthreads();
        if (g != last_g) { spatial_stage_w(wsp + (size_t)g * CH * CH, wimg, tid); last_g = g; }
        if (act) { const int vcol = g * AD + 8 * cc;
            const f32x4 g0 = *(const f32x4*)(lng + vcol), g1 = *(const f32x4*)(lng + vcol + 4), b0 = *(const f32x4*)(lnb + vcol), b1 = *(const f32x4*)(lnb + vcol + 4);
            const float gg[8] = {g0[0], g0[1], g0[2], g0[3], g1[0], g1[1], g1[2], g1[3]}, bv[8] = {b0[0], b0[1], b0[2], b0[3], b1[0], b1[1], b1[2], b1[3]};
#pragma unroll
            for (int i = 0; i < 7; ++i) { const int sr = r0 + 21 * i;
                if (sr < CH) { const float mean = st[i].x * (1.f / BR), var = st[i].y * (1.f / BR) - mean * mean; const float rstd = 1.0f / sqrtf(var + EPS), mr = -mean * rstd;
                    float o[8];
#pragma unroll
                    for (int e = 0; e < 4; ++e) { const float x0 = __uint_as_float(vw[i][e] << 16), x1 = __uint_as_float(vw[i][e] & 0xffff0000u);
                        o[2 * e] = (x0 * rstd + mr) * gg[2 * e] + bv[2 * e]; o[2 * e + 1] = (x1 * rstd + mr) * gg[2 * e + 1] + bv[2 * e + 1]; }
                    u32x4 w; w.x = cvtpk(o[0], o[1]); w.y = cvtpk(o[2], o[3]); w.z = cvtpk(o[4], o[5]); w.w = cvtpk(o[6], o[7]);
                    *(LAS u32x4*)(vimg + sr * 448 + cc * 16) = w; } } }
        __syncthreads();
        u32x4 uq[7];
        if (act) { const int nit = item + G;
            if (nit < NITEM) { const int g2 = nit & 7, c2 = nit >> 3;
#pragma unroll
                for (int i = 0; i < 7; ++i) { const int sr = r0 + 21 * i; if (sr < CH) { const int row = c2 * CH + sr; vw[i] = __builtin_nontemporal_load((const u32x4*)(Zb + (size_t)row * ZA + BR + g2 * AD + 8 * cc)); st[i] = *(const f32x2*)(vstat + 2 * row); } } }
#pragma unroll
            for (int i = 0; i < 7; ++i) { const int sr = r0 + 21 * i; if (sr < CH) { const bf16_t* zr = Zb + (size_t)(c * CH + sr) * ZA + g * AD + 8 * cc; uq[i] = __builtin_nontemporal_load((const u32x4*)zr); } } }
        f32x16 acc[3];
#pragma unroll
        for (int k = 0; k < 3; ++k) {
            const int tt = hf == 0 ? (k < 2 ? a : 3 - a) : (k < 1 ? a : 3 - a);
            const int dt = hf == 0 ? (k < 2 ? k : 3) : (k < 1 ? 2 : 3 + k);
            const int t = 32 * tt + n;
#pragma unroll
            for (int r = 0; r < 16; ++r) acc[k][r] = 0.f;
            const LAS unsigned char* wb = wimg + t * 256; const int tx = t & 15;
            const int nks = 2 * (tt + 1);
#pragma unroll 2
            for (int ks = 0; ks < nks; ++ks) {
                const s16x4 lo = tr_read16(trb + ks * 16 * 448 + dt * 64), hi = tr_read16(trb + ks * 16 * 448 + dt * 64 + 4 * 448);
                const bf16x8 af = __builtin_shufflevector(lo, hi, 0, 1, 2, 3, 4, 5, 6, 7);
                const bf16x8 bfr = *(const LAS bf16x8*)(wb + (((2 * ks + hh) ^ tx) << 4));
                acc[k] = __builtin_amdgcn_mfma_f32_32x32x16_bf16(af, bfr, acc[k], 0, 0, 0);
            }
        }
        __syncthreads();
#pragma unroll
        for (int k = 0; k < 3; ++k) {
            const int tt = hf == 0 ? (k < 2 ? a : 3 - a) : (k < 1 ? a : 3 - a);
            const int dt = hf == 0 ? (k < 2 ? k : 3) : (k < 1 ? 2 : 3 + k);
            const int t = 32 * tt + n; const float bs = bsp[g * CH + t];
#pragma unroll
            for (int q4 = 0; q4 < 4; ++q4) { u32x2 w; w.x = cvtpk(acc[k][4 * q4] + bs, acc[k][4 * q4 + 1] + bs); w.y = cvtpk(acc[k][4 * q4 + 2] + bs, acc[k][4 * q4 + 3] + bs);
                *(LAS u32x2*)(oimg + t * 400 + (32 * dt + 8 * q4 + 4 * hh) * 2) = w; }
        }
        __syncthreads();
        if (act) {
#pragma unroll
            for (int i = 0; i < 7; ++i) { const int sr = r0 + 21 * i;
                if (sr < CH) { const u32x4 mw = *(const LAS u32x4*)(oimg + sr * 400 + cc * 16); u32x4 w;
#pragma unroll
                    for (int e = 0; e < 4; ++e) { const float o0 = __uint_as_float(uq[i][e] << 16) * __uint_as_float(mw[e] << 16);
                        const float o1 = __uint_as_float(uq[i][e] & 0xffff0000u) * __uint_as_float(mw[e] & 0xffff0000u); w[e] = cvtpk(o0, o1); }
                    *(u32x4*)(MIXp + (size_t)(c * CH + sr) * MW + g * AD + 8 * cc) = w; } } }
    }
}

DI float selv(bool c, float a, float b) { asm volatile("" : "+v"(a), "+v"(b)); return c ? a : b; }
DI void attn_sample_seq(const bf16_t* Zb, const int ldz, const int qoff, const int goff, const float* ck, const float* cv, bf16_t* MIXp, LAS unsigned char* lds, const int item, const int wave, const int lane_in) {
    int lane_o = lane_in; asm volatile("" : "+v"(lane_o)); const int lane = lane_o;
    const int b = item >> 1, hb = wave & 1, h = 2 * (item & 1) + hb, kq = wave >> 1, hf = lane >> 5, dl = lane & 31;
    LAS float* sc = (LAS float*)(lds + wave * 1024);
    LAS float* xch = (LAS float*)(lds + 8192 + (hb * 3 + (kq - 1)) * 2176);
    const float L2E = 1.4426950408889634f;
    float q[4][4];
#pragma unroll
    for (int t = 0; t < 4; ++t) { const u32x2 w = *(const u32x2*)(Zb + (size_t)(MP + b * T_S + t) * ldz + qoff + h * HD + 4 * dl);
        q[t][0] = __uint_as_float(w.x << 16); q[t][1] = __uint_as_float(w.x & 0xffff0000u); q[t][2] = __uint_as_float(w.y << 16); q[t][3] = __uint_as_float(w.y & 0xffff0000u); }
    const size_t kvo = ((size_t)(b * NMEM + 64 * kq + hf)) * XA + h * HD + 4 * dl;
    const float* kbase = ck + kvo; const float* vbase = cv + kvo;
    const int t_l = ((lane >> 4) & 1) * 2 + ((lane >> 3) & 1);
    f32x4 kv[32];
#pragma unroll
    for (int mp = 0; mp < 32; ++mp) kv[mp] = __builtin_nontemporal_load((const f32x4*)(kbase + (size_t)mp * 2 * XA));
    f32x4 vv[16];
#pragma unroll
    for (int mp = 0; mp < 16; ++mp) vv[mp] = __builtin_nontemporal_load((const f32x4*)(vbase + (size_t)mp * 2 * XA));
    __builtin_amdgcn_sched_barrier(0);
#pragma unroll
    for (int mp = 0; mp < 32; ++mp) {
        const f32x4 k4 = kv[mp];
        const float s0 = q[0][0] * k4.x + q[0][1] * k4.y + q[0][2] * k4.z + q[0][3] * k4.w, s1 = q[1][0] * k4.x + q[1][1] * k4.y + q[1][2] * k4.z + q[1][3] * k4.w;
        const float s2 = q[2][0] * k4.x + q[2][1] * k4.y + q[2][2] * k4.z + q[2][3] * k4.w, s3 = q[3][0] * k4.x + q[3][1] * k4.y + q[3][2] * k4.z + q[3][3] * k4.w;
        const bool u16 = (lane & 16) != 0, u8 = (lane & 8) != 0;
        const float a = (u16 ? s2 : s0) + __shfl_xor(u16 ? s0 : s2, 16), c = (u16 ? s3 : s1) + __shfl_xor(u16 ? s1 : s3, 16);
        float v = (u8 ? c : a) + __shfl_xor(u8 ? a : c, 8);
        v += __shfl_xor(v, 4); v += __shfl_xor(v, 2); v += __shfl_xor(v, 1);
        if ((lane & 7) == 0) sc[(2 * mp + hf) * 4 + t_l] = v;
    }
    LDS_WAIT();
    float mx[4], l[4];
#pragma unroll
    for (int t = 0; t < 4; ++t) { const float x0 = sc[lane * 4 + t]; mx[t] = wave_max(x0);
        const float p0 = __builtin_amdgcn_exp2f((x0 - mx[t]) * L2E); l[t] = wave_sum(p0); sc[lane * 4 + t] = p0; }
    LDS_WAIT();
    f32x4 o[4];
#pragma unroll
    for (int t = 0; t < 4; ++t) o[t] = (f32x4){0.f, 0.f, 0.f, 0.f};
#pragma unroll
    for (int mp = 0; mp < 16; ++mp) { const f32x4 pv = *(const LAS f32x4*)(sc + (2 * mp + hf) * 4); o[0] += vv[mp] * pv.x; o[1] += vv[mp] * pv.y; o[2] += vv[mp] * pv.z; o[3] += vv[mp] * pv.w; }
#pragma unroll
    for (int mp = 0; mp < 16; ++mp) vv[mp] = __builtin_nontemporal_load((const f32x4*)(vbase + (size_t)(16 + mp) * 2 * XA));
#pragma unroll
    for (int mp = 0; mp < 16; ++mp) { const f32x4 pv = *(const LAS f32x4*)(sc + (2 * (16 + mp) + hf) * 4); o[0] += vv[mp] * pv.x; o[1] += vv[mp] * pv.y; o[2] += vv[mp] * pv.z; o[3] += vv[mp] * pv.w; }
#pragma unroll
    for (int t = 0; t < 4; ++t)
#pragma unroll
        for (int e = 0; e < 4; ++e) o[t][e] += __shfl_xor(o[t][e], 32);
    if (kq != 0) {
        if (lane < 32) {
#pragma unroll
            for (int t = 0; t < 4; ++t) *(LAS f32x4*)(xch + 8 + t * 128 + 4 * dl) = o[t]; }
        if (lane == 0) { *(LAS f32x4*)xch = (f32x4){mx[0], mx[1], mx[2], mx[3]}; *(LAS f32x4*)(xch + 4) = (f32x4){l[0], l[1], l[2], l[3]}; }
    }
    __syncthreads();
    if (kq == 0) {
        const LAS float* x1 = (const LAS float*)(lds + 8192 + (hb * 3 + 0) * 2176); const LAS float* x2 = x1 + 544; const LAS float* x3 = x2 + 544;
        const f32x4 m1 = *(const LAS f32x4*)x1, l1 = *(const LAS f32x4*)(x1 + 4), m2 = *(const LAS f32x4*)x2, l2 = *(const LAS f32x4*)(x2 + 4), m3 = *(const LAS f32x4*)x3, l3 = *(const LAS f32x4*)(x3 + 4);
#pragma unroll
        for (int j = 0; j < 2; ++j) {
            const int t = 2 * hf + j; const bool up = hf != 0;
            const float m0s = selv(up, mx[2 + j], mx[j]), l0s = selv(up, l[2 + j], l[j]), m1s = selv(up, m1[2 + j], m1[j]), l1s = selv(up, l1[2 + j], l1[j]);
            const float m2s = selv(up, m2[2 + j], m2[j]), l2s = selv(up, l2[2 + j], l2[j]), m3s = selv(up, m3[2 + j], m3[j]), l3s = selv(up, l3[2 + j], l3[j]);
            f32x4 o0; o0.x = selv(up, o[2 + j].x, o[j].x); o0.y = selv(up, o[2 + j].y, o[j].y); o0.z = selv(up, o[2 + j].z, o[j].z); o0.w = selv(up, o[2 + j].w, o[j].w);
            const f32x4 o1 = *(const LAS f32x4*)(x1 + 8 + t * 128 + 4 * dl), o2 = *(const LAS f32x4*)(x2 + 8 + t * 128 + 4 * dl), o3 = *(const LAS f32x4*)(x3 + 8 + t * 128 + 4 * dl);
            const float Mx = fmaxf(fmaxf(m0s, m1s), fmaxf(m2s, m3s));
            const float a0 = __builtin_amdgcn_exp2f((m0s - Mx) * L2E), a1 = __builtin_amdgcn_exp2f((m1s - Mx) * L2E), a2 = __builtin_amdgcn_exp2f((m2s - Mx) * L2E), a3 = __builtin_amdgcn_exp2f((m3s - Mx) * L2E);
            const float inv = 1.0f / (l0s * a0 + l1s * a1 + l2s * a2 + l3s * a3);
            const size_t row = (size_t)(MP + b * T_S + t);
            const u32x2 gw2 = *(const u32x2*)(Zb + row * ldz + goff + h * HD + 4 * dl);
            const f32x4 os = (o0 * a0 + o1 * a1 + o2 * a2 + o3 * a3) * inv;
            const float r0 = os.x * __uint_as_float(gw2.x << 16), r1 = os.y * __uint_as_float(gw2.x & 0xffff0000u), r2 = os.z * __uint_as_float(gw2.y << 16), r3 = os.w * __uint_as_float(gw2.y & 0xffff0000u);
            u32x2 w; w.x = cvtpk(r0, r1); w.y = cvtpk(r2, r3);
            *(u32x2*)(MIXp + row * MW + BR + h * HD + 4 * dl) = w;
        }
    }
    __syncthreads();
}

DI void attn_prompt_tile(const bf16_t* Zb, const int ldz, const int qoff, const int goff, const bf16_t* Kpl, const bf16_t* VTl, bf16_t* MIXp, const int tile, const int lane_in) {
    int lane_o = lane_in; asm volatile("" : "+v"(lane_o)); const int lane = lane_o;
    const int unit = tile >> 3, wt = tile & 7, b = unit >> 5, h = (unit >> 3) & 3, qb = unit & 7;
    const int qi = lane & 31, hh = lane >> 5;
    const int row = b * T_P + qb * 256 + wt * 32 + qi;
    const bf16_t* zr = Zb + (size_t)row * ldz;
    bf16x8 qf[8];
#pragma unroll
    for (int ks = 0; ks < 8; ++ks) qf[ks] = *(const bf16x8*)(zr + qoff + h * HD + 16 * ks + 8 * hh);
    const int pi = (qi & ~12) | ((qi & 4) << 1) | ((qi & 8) >> 1);
    const bf16_t* kg = Kpl + (size_t)(b * NMEM + pi) * XA + h * HD + 8 * hh;
    const bf16_t* vg = VTl + (size_t)((b * NH + h) * HD + qi) * NMEM + 8 * hh;
    f32x16 sacc[8];
#pragma unroll
    for (int T = 0; T < 8; ++T) {
#pragma unroll
        for (int r = 0; r < 16; ++r) sacc[T][r] = 0.f;
        bf16x8 kf[8];
#pragma unroll
        for (int ks = 0; ks < 8; ++ks) kf[ks] = *(const bf16x8*)(kg + (size_t)(32 * T) * XA + 16 * ks);
#pragma unroll
        for (int ks = 0; ks < 8; ++ks) sacc[T] = __builtin_amdgcn_mfma_f32_32x32x16_bf16(kf[ks], qf[ks], sacc[T], 0, 0, 0);
    }
    float mx = -3.0e38f;
#pragma unroll
    for (int T = 0; T < 8; ++T)
#pragma unroll
        for (int r = 0; r < 16; ++r) mx = fmaxf(mx, sacc[T][r]);
    mx = fmaxf(mx, __shfl_xor(mx, 32));
    float sum = 0.f;
#pragma unroll
    for (int T = 0; T < 8; ++T)
#pragma unroll
        for (int r = 0; r < 16; ++r) { const float p = __builtin_amdgcn_exp2f((sacc[T][r] - mx) * 1.4426950408889634f); sacc[T][r] = p; sum += p; }
    sum += __shfl_xor(sum, 32);
    const float inv = 1.0f / sum;
    f32x16 oacc[4];
#pragma unroll
    for (int dt = 0; dt < 4; ++dt)
#pragma unroll
        for (int r = 0; r < 16; ++r) oacc[dt][r] = 0.f;
#pragma unroll
    for (int T = 0; T < 8; ++T) {
#pragma unroll
        for (int s2 = 0; s2 < 2; ++s2) {
            bf16x8 vf[2][4];
#pragma unroll
            for (int dt = 0; dt < 4; ++dt) vf[s2][dt] = *(const bf16x8*)(vg + (size_t)(32 * dt) * NMEM + 32 * T + 16 * s2);
            u32x4 pw; pw.x = cvtpk(sacc[T][8 * s2 + 0], sacc[T][8 * s2 + 1]); pw.y = cvtpk(sacc[T][8 * s2 + 2], sacc[T][8 * s2 + 3]);
            pw.z = cvtpk(sacc[T][8 * s2 + 4], sacc[T][8 * s2 + 5]); pw.w = cvtpk(sacc[T][8 * s2 + 6], sacc[T][8 * s2 + 7]);
            const bf16x8 pf = __builtin_bit_cast(bf16x8, pw);
#pragma unroll
            for (int dt = 0; dt < 4; ++dt) oacc[dt] = __builtin_amdgcn_mfma_f32_32x32x16_bf16(vf[s2][dt], pf, oacc[dt], 0, 0, 0);
        }
    }
    bf16_t* mr = MIXp + (size_t)row * MW + BR + h * HD;
#pragma unroll
    for (int dt = 0; dt < 4; ++dt)
#pragma unroll
        for (int g4 = 0; g4 < 4; ++g4) { const int d0 = 32 * dt + 8 * g4 + 4 * hh;
            const u32x2 gw2 = *(const u32x2*)(zr + goff + h * HD + d0);
            const float o0 = oacc[dt][4 * g4 + 0] * inv * __uint_as_float(gw2.x << 16), o1 = oacc[dt][4 * g4 + 1] * inv * __uint_as_float(gw2.x & 0xffff0000u);
            const float o2 = oacc[dt][4 * g4 + 2] * inv * __uint_as_float(gw2.y << 16), o3 = oacc[dt][4 * g4 + 3] * inv * __uint_as_float(gw2.y & 0xffff0000u);
            u32x2 w; w.x = cvtpk(o0, o1); w.y = cvtpk(o2, o3);
            *(u32x2*)(mr + d0) = w; }
}
DI void attn_sample_item(const bf16_t* Zb, const int ldz, const int qoff, const int goff, const float* ck, const float* cv, bf16_t* MIXp, LAS float* sc, const int item, const int lane_in) {
    int lane_o = lane_in; asm volatile("" : "+v"(lane_o)); const int lane = lane_o;
    const int b = item >> 2, h = item & 3, hf = lane >> 5, dl = lane & 31;
    const float L2E = 1.4426950408889634f;
    float q[4][4];
#pragma unroll
    for (int t = 0; t < 4; ++t) { const u32x2 w = *(const u32x2*)(Zb + (size_t)(MP + b * T_S + t) * ldz + qoff + h * HD + 4 * dl);
        q[t][0] = __uint_as_float(w.x << 16); q[t][1] = __uint_as_float(w.x & 0xffff0000u); q[t][2] = __uint_as_float(w.y << 16); q[t][3] = __uint_as_float(w.y & 0xffff0000u); }
    const size_t kvo = ((size_t)(b * NMEM + hf)) * XA + h * HD + 4 * dl;
    const float* kbase = ck + kvo; const float* vbase = cv + kvo;
    const int t_l = ((lane >> 4) & 1) * 2 + ((lane >> 3) & 1);
    constexpr int NBT = 16;
#define SA_KLOAD(KV, BT) do { _Pragma("unroll") for (int mp = 0; mp < 8; ++mp) KV[mp] = __builtin_nontemporal_load((const f32x4*)(kbase + (size_t)((BT) * 8 + mp) * 2 * XA)); } while (0)
#define SA_KRED(KV, BT) do { _Pragma("unroll") for (int mp = 0; mp < 8; ++mp) { \
            const f32x4 k4 = KV[mp]; \
            const float s0 = q[0][0] * k4.x + q[0][1] * k4.y + q[0][2] * k4.z + q[0][3] * k4.w, s1 = q[1][0] * k4.x + q[1][1] * k4.y + q[1][2] * k4.z + q[1][3] * k4.w; \
            const float s2 = q[2][0] * k4.x + q[2][1] * k4.y + q[2][2] * k4.z + q[2][3] * k4.w, s3 = q[3][0] * k4.x + q[3][1] * k4.y + q[3][2] * k4.z + q[3][3] * k4.w; \
            const bool u16 = (lane & 16) != 0, u8 = (lane & 8) != 0; \
            const float a = (u16 ? s2 : s0) + __shfl_xor(u16 ? s0 : s2, 16), c = (u16 ? s3 : s1) + __shfl_xor(u16 ? s1 : s3, 16); \
            float v = (u8 ? c : a) + __shfl_xor(u8 ? a : c, 8); \
            v += __shfl_xor(v, 4); v += __shfl_xor(v, 2); v += __shfl_xor(v, 1); \
            if ((lane & 7) == 0) sc[(2 * ((BT) * 8 + mp) + hf) * 4 + t_l] = v; } } while (0)
    {
        f32x4 kvA[8], kvB[8], kvC[8];
        SA_KLOAD(kvA, 0); SA_KLOAD(kvB, 1);
#pragma unroll 1
        for (int bt = 0; bt < NBT - 1; bt += 3) {
            SA_KLOAD(kvC, bt + 2); __builtin_amdgcn_sched_barrier(0); SA_KRED(kvA, bt);
            SA_KLOAD(kvA, bt + 3); __builtin_amdgcn_sched_barrier(0); SA_KRED(kvB, bt + 1);
            { const int bn = (bt + 4 < NBT) ? bt + 4 : NBT - 1; SA_KLOAD(kvB, bn); } __builtin_amdgcn_sched_barrier(0); SA_KRED(kvC, bt + 2);
        }
        SA_KRED(kvA, NBT - 1);
    }
#undef SA_KRED
#undef SA_KLOAD
    LDS_WAIT();
    float inv[4];
#pragma unroll
    for (int t = 0; t < 4; ++t) { float x[4]; float m = -3.0e38f;
#pragma unroll
        for (int j = 0; j < 4; ++j) { x[j] = sc[(lane + 64 * j) * 4 + t]; m = fmaxf(m, x[j]); }
        m = wave_max(m); float l = 0.f;
#pragma unroll
        for (int j = 0; j < 4; ++j) { const float p = __builtin_amdgcn_exp2f((x[j] - m) * L2E); l += p; sc[(lane + 64 * j) * 4 + t] = p; }
        inv[t] = 1.0f / wave_sum(l); }
    LDS_WAIT();
    f32x4 o[4];
#pragma unroll
    for (int t = 0; t < 4; ++t) o[t] = (f32x4){0.f, 0.f, 0.f, 0.f};
#define SA_VLOAD(VV, BT) do { _Pragma("unroll") for (int mp = 0; mp < 8; ++mp) VV[mp] = __builtin_nontemporal_load((const f32x4*)(vbase + (size_t)((BT) * 8 + mp) * 2 * XA)); } while (0)
#define SA_VACC(VV, BT) do { _Pragma("unroll") for (int mp = 0; mp < 8; ++mp) { const f32x4 pv = *(const LAS f32x4*)(sc + (2 * ((BT) * 8 + mp) + hf) * 4); \
            o[0] += VV[mp] * pv.x; o[1] += VV[mp] * pv.y; o[2] += VV[mp] * pv.z; o[3] += VV[mp] * pv.w; } } while (0)
    {
        f32x4 vvA[8], vvB[8], vvC[8];
        SA_VLOAD(vvA, 0); SA_VLOAD(vvB, 1);
#pragma unroll 1
        for (int bt = 0; bt < NBT - 1; bt += 3) {
            SA_VLOAD(vvC, bt + 2); __builtin_amdgcn_sched_barrier(0); SA_VACC(vvA, bt);
            SA_VLOAD(vvA, bt + 3); __builtin_amdgcn_sched_barrier(0); SA_VACC(vvB, bt + 1);
            { const int bn = (bt + 4 < NBT) ? bt + 4 : NBT - 1; SA_VLOAD(vvB, bn); } __builtin_amdgcn_sched_barrier(0); SA_VACC(vvC, bt + 2);
        }
        SA_VACC(vvA, NBT - 1);
    }
#undef SA_VACC
#undef SA_VLOAD
#pragma unroll
    for (int t = 0; t < 4; ++t)
#pragma unroll
        for (int e = 0; e < 4; ++e) o[t][e] += __shfl_xor(o[t][e], 32);
#pragma unroll
    for (int j = 0; j < 2; ++j) {
        const int t = 2 * hf + j; const bool up = hf != 0;
        const float iv = selv(up, inv[2 + j], inv[j]);
        f32x4 o0; o0.x = selv(up, o[2 + j].x, o[j].x); o0.y = selv(up, o[2 + j].y, o[j].y); o0.z = selv(up, o[2 + j].z, o[j].z); o0.w = selv(up, o[2 + j].w, o[j].w);
        const size_t row = (size_t)(MP + b * T_S + t);
        const u32x2 gw2 = *(const u32x2*)(Zb + row * ldz + goff + h * HD + 4 * dl);
        const float r0 = o0.x * iv * __uint_as_float(gw2.x << 16), r1 = o0.y * iv * __uint_as_float(gw2.x & 0xffff0000u), r2 = o0.z * iv * __uint_as_float(gw2.y << 16), r3 = o0.w * iv * __uint_as_float(gw2.y & 0xffff0000u);
        u32x2 w; w.x = cvtpk(r0, r1); w.y = cvtpk(r2, r3);
        *(u32x2*)(MIXp + row * MW + BR + h * HD + 4 * dl) = w;
    }
    LDS_WAIT();
}

DI void attn_sample_half(const bf16_t* Zb, const int ldz, const int qoff, const float* ck, const float* cv, LAS float* sc, LAS float* part, const int item, const int half, const int lane_in) {
    int lane_o = lane_in; asm volatile("" : "+v"(lane_o)); const int lane = lane_o;
    const int b = item >> 2, h = item & 3, hf = lane >> 5, dl = lane & 31;
    const float L2E = 1.4426950408889634f;
    float q[4][4];
#pragma unroll
    for (int t = 0; t < 4; ++t) { const u32x2 w = *(const u32x2*)(Zb + (size_t)(MP + b * T_S + t) * ldz + qoff + h * HD + 4 * dl);
        q[t][0] = __uint_as_float(w.x << 16); q[t][1] = __uint_as_float(w.x & 0xffff0000u); q[t][2] = __uint_as_float(w.y << 16); q[t][3] = __uint_as_float(w.y & 0xffff0000u); }
    const size_t kvo = ((size_t)(b * NMEM + 128 * half + hf)) * XA + h * HD + 4 * dl;
    const float* kbase = ck + kvo; const float* vbase = cv + kvo;
    const int t_l = ((lane >> 4) & 1) * 2 + ((lane >> 3) & 1);
#pragma unroll 1
    for (int bt = 0; bt < 2; ++bt) {
        f32x4 kv[32];
#pragma unroll
        for (int mp = 0; mp < 32; ++mp) kv[mp] = __builtin_nontemporal_load((const f32x4*)(kbase + (size_t)(bt * 32 + mp) * 2 * XA));
#pragma unroll
        for (int mp = 0; mp < 32; ++mp) {
            const f32x4 k4 = kv[mp];
            const float s0 = q[0][0] * k4.x + q[0][1] * k4.y + q[0][2] * k4.z + q[0][3] * k4.w, s1 = q[1][0] * k4.x + q[1][1] * k4.y + q[1][2] * k4.z + q[1][3] * k4.w;
            const float s2 = q[2][0] * k4.x + q[2][1] * k4.y + q[2][2] * k4.z + q[2][3] * k4.w, s3 = q[3][0] * k4.x + q[3][1] * k4.y + q[3][2] * k4.z + q[3][3] * k4.w;
            const bool u16 = (lane & 16) != 0, u8 = (lane & 8) != 0;
            const float a = (u16 ? s2 : s0) + __shfl_xor(u16 ? s0 : s2, 16), c = (u16 ? s3 : s1) + __shfl_xor(u16 ? s1 : s3, 16);
            float v = (u8 ? c : a) + __shfl_xor(u8 ? a : c, 8);
            v += __shfl_xor(v, 4); v += __shfl_xor(v, 2); v += __shfl_xor(v, 1);
            if ((lane & 7) == 0) sc[(2 * (bt * 32 + mp) + hf) * 4 + t_l] = v;
        }
    }
    LDS_WAIT();
    float mx[4], l[4];
#pragma unroll
    for (int t = 0; t < 4; ++t) { const float x0 = sc[lane * 4 + t], x1 = sc[(lane + 64) * 4 + t]; mx[t] = wave_max(fmaxf(x0, x1));
        const float p0 = __builtin_amdgcn_exp2f((x0 - mx[t]) * L2E), p1 = __builtin_amdgcn_exp2f((x1 - mx[t]) * L2E); l[t] = wave_sum(p0 + p1);
        sc[lane * 4 + t] = p0; sc[(lane + 64) * 4 + t] = p1; }
    LDS_WAIT();
    f32x4 o[4];
#pragma unroll
    for (int t = 0; t < 4; ++t) o[t] = (f32x4){0.f, 0.f, 0.f, 0.f};
#pragma unroll 1
    for (int bt = 0; bt < 2; ++bt) {
        f32x4 vv[32];
#pragma unroll
        for (int mp = 0; mp < 32; ++mp) vv[mp] = __builtin_nontemporal_load((const f32x4*)(vbase + (size_t)(bt * 32 + mp) * 2 * XA));
#pragma unroll
        for (int mp = 0; mp < 32; ++mp) { const f32x4 pv = *(const LAS f32x4*)(sc + (2 * (bt * 32 + mp) + hf) * 4); o[0] += vv[mp] * pv.x; o[1] += vv[mp] * pv.y; o[2] += vv[mp] * pv.z; o[3] += vv[mp] * pv.w; }
    }
#pragma unroll
    for (int t = 0; t < 4; ++t)
#pragma unroll
        for (int e = 0; e < 4; ++e) o[t][e] += __shfl_xor(o[t][e], 32);
    if (lane < 32) {
#pragma unroll
        for (int t = 0; t < 4; ++t) *(LAS f32x4*)(part + 8 + t * 128 + 4 * dl) = o[t]; }
    if (lane == 0) { *(LAS f32x4*)part = (f32x4){mx[0], mx[1], mx[2], mx[3]}; *(LAS f32x4*)(part + 4) = (f32x4){l[0], l[1], l[2], l[3]}; }
    LDS_WAIT();
}
DI void attn_sample_merge(const bf16_t* Zb, const int ldz, const int goff, bf16_t* MIXp, const LAS float* p0, const LAS float* p1, const int item, const int lane) {
    const int b = item >> 2, h = item & 3, hf = lane >> 5, dl = lane & 31; const float L2E = 1.4426950408889634f;
#pragma unroll
    for (int j = 0; j < 2; ++j) {
        const int t = 2 * hf + j;
        const float m0 = p0[t], l0 = p0[4 + t], m1 = p1[t], l1 = p1[4 + t];
        const f32x4 o0 = *(const LAS f32x4*)(p0 + 8 + t * 128 + 4 * dl), o1 = *(const LAS f32x4*)(p1 + 8 + t * 128 + 4 * dl);
        const float Mx = fmaxf(m0, m1), a0 = __builtin_amdgcn_exp2f((m0 - Mx) * L2E), a1 = __builtin_amdgcn_exp2f((m1 - Mx) * L2E);
        const float inv = 1.0f / (l0 * a0 + l1 * a1);
        const f32x4 os = (o0 * a0 + o1 * a1) * inv;
        const size_t row = (size_t)(MP + b * T_S + t);
        const u32x2 gw2 = *(const u32x2*)(Zb + row * ldz + goff + h * HD + 4 * dl);
        const float r0 = os.x * __uint_as_float(gw2.x << 16), r1 = os.y * __uint_as_float(gw2.x & 0xffff0000u), r2 = os.z * __uint_as_float(gw2.y << 16), r3 = os.w * __uint_as_float(gw2.y & 0xffff0000u);
        u32x2 w; w.x = cvtpk(r0, r1); w.y = cvtpk(r2, r3);
        *(u32x2*)(MIXp + row * MW + BR + h * HD + 4 * dl) = w;
    }
}
template <int LO, int HI> __global__ void __launch_bounds__(NTHR, 2) mega(Args args) {
    extern __shared__ __attribute__((aligned(16))) unsigned char lds_raw[];
    LAS unsigned char* lds = (LAS unsigned char*)lds_raw;
    const int tid = threadIdx.x, lane = tid & 63, wave = __builtin_amdgcn_readfirstlane(tid >> 6);
    const int G = gridDim.x, bx = blockIdx.x;
    const int vcu = (G % 8 == 0) ? (bx % 8) * (G / 8) + bx / 8 : bx;
    const int gw = vcu * NWAVES + wave, NGW = G * NWAVES;
    unsigned char* ws = args.ws;
    unsigned* ctl = (unsigned*)(ws + WS_CTL);
    volatile LAS unsigned* MISC = (volatile LAS unsigned*)(lds + MISC_OFF);
    for (int u = tid; u < (LDS_BYTES - RING_BYTES) / 4; u += NTHR) ((LAS unsigned*)(lds + RING_BYTES))[u] = 0u;
    __syncthreads();
    XcdBarrier bar; bar.bar = ctl + CW_BAR; bar.x = 0; bar.st = nullptr;
    if constexpr (HI - LO > 1) bar = xcd_barrier_post(ctl + CW_BAR, MISC + 8);
#define IN(k) (LO <= (k) && (k) < HI)
#define SEAM(k) do { if constexpr (IN(k) && IN((k) + 1)) xcd_barrier(bar); } while (0)

#define x_prompt (args.in[0])
#define x_sample (args.in[1])
#define cache_k (args.in[2])
#define cache_v (args.in[3])
#define st_re (args.in[4])
#define st_im (args.in[5])
#define mem_prompt (args.in[6])
#define w_in_a (args.in[7])
#define ln_v_g (args.in[8])
#define ln_v_b (args.in[9])
#define w_spatial (args.in[10])
#define b_spatial (args.in[11])
#define w_in_b (args.in[12])
#define lam_re (args.in[13])
#define lam_im (args.in[14])
#define log_dt (args.in[15])
#define sb_re (args.in[16])
#define sb_im (args.in[17])
#define sc_re (args.in[18])
#define sc_im (args.in[19])
#define ssm_d (args.in[20])
#define w_glu (args.in[21])
#define b_glu (args.in[22])
#define mem_norm_g (args.in[23])
#define w_mem_k (args.in[24])
#define w_mem_v (args.in[25])
#define w_out (args.in[26])
#define pre_g (args.in[27])
#define post_g (args.in[28])
#define out (args.out)
#define WinA ((bf16_t*)(ws + WS_WINA))
#define WinB ((bf16_t*)(ws + WS_WINB))
#define Wglu ((bf16_t*)(ws + WS_WGLU))
#define Wout0 ((bf16_t*)(ws + WS_WOUT0))
#define Wout1 ((bf16_t*)(ws + WS_WOUT1))
#define Wmem ((bf16_t*)(ws + WS_WMEM))
#define MEMN ((bf16_t*)(ws + WS_MEMN))
#define KVBF ((bf16_t*)(ws + WS_KVBF))
#define VTB ((bf16_t*)(ws + WS_VT))
#define SMALL ((float*)(ws + WS_SMALL))
#define XN ((bf16_t*)(ws + WS_XN))
#define Z ((bf16_t*)(ws + WS_Z))
#define YG ((bf16_t*)(ws + WS_YG))
#define MIX ((bf16_t*)(ws + WS_MIX))
#define OUT ((bf16_t*)(ws + WS_OUT))
#define PART ((float*)(ws + WS_PART))
#define UGI ((bf16_t*)(ws + WS_UG))
#define Y1 ((bf16_t*)(ws + WS_Y1))
#define VSTAT (SMALL + SM_VSTAT)
#define SS0 (SMALL + SM_SS0)
#define SS1 (SMALL + SM_SS1)
#define SS2 (SMALL + SM_SS2)
#define LB (SMALL + SM_LB)
#define BB (SMALL + SM_BB)
#define BBT ((bf16_t*)(SMALL + SM_BBT))
#define CTT ((bf16_t*)(SMALL + SM_CT))

    if constexpr (IN(0)) {
        LAS float* scr = (LAS float*)(lds + wave * 16384);
        constexpr int I_A = (D / 64) * (NA / 32), I_B = (D / 64) * (NBW / 32), I_G = (BR / 64) * (BR / 32), I_O = (MW / 64) * (D / 32), I_M = (D / 64) * (XA / 32);
        constexpr int NITEMS = I_A + I_B + I_O + 4 * I_M;
        for (int it = gw; it < NITEMS; it += NGW) {
            int r = it;
            if (r < I_A) { const int nb = r % (NA / 32), n_src = 32 * nb;
                const int n_dst = (n_src < BR) ? (n_src >> 7) * 256 + (n_src & 127)
                                : (n_src < 2 * BR) ? 2 * BR + (n_src - BR)
                                : (n_src < 2 * BR + XA) ? 3 * BR + (n_src - 2 * BR)
                                : (n_src < 3 * BR + XA) ? ((n_src - 2 * BR - XA) >> 7) * 256 + 128 + ((n_src - 2 * BR - XA) & 127)
                                : n_src;
                p0_transpose_item(w_in_a, pre_g, D, NA, WinA, n_dst - n_src, scr, r, lane); continue; } r -= I_A;
            if (r < I_B) { p0_transpose_item(w_in_b, pre_g + D, D, NBW, WinB, 0, scr, r, lane); continue; } r -= I_B;
            if (r < I_O) { p0_transpose_item(w_out, nullptr, MW, D, Wout0, 0, scr, r, lane); continue; } r -= I_O;
            const int which = r / I_M; r -= which * I_M;
            const int layer = which >> 1; const float* wsrc = ((which & 1) ? w_mem_v : w_mem_k) + (size_t)layer * D * XA;
            p0_transpose_item(wsrc, mem_norm_g + layer * D, D, XA, Wmem, which * XA, scr, r, lane);
        }
        for (int m0 = gw; m0 < M + MMEM; m0 += 2 * NGW) {
            const float* src[2]; bf16_t* dst[2]; f32x4 v[2][4]; float ss[2];
#pragma unroll
            for (int q = 0; q < 2; ++q) { int m = m0 + q * NGW; if (m >= M + MMEM) m = m0;
                src[q] = (m < MP) ? x_prompt + (size_t)m * D : (m < M) ? x_sample + (size_t)(m - MP) * D : mem_prompt + (size_t)(m - M) * D;
                dst[q] = (m < M) ? XN + (size_t)m * D : MEMN + (size_t)(m - M) * D; }
#pragma unroll
            for (int q = 0; q < 2; ++q)
#pragma unroll
                for (int j = 0; j < 4; ++j) v[q][j] = __builtin_nontemporal_load((const f32x4*)src[q] + lane + 64 * j);
#pragma unroll
            for (int q = 0; q < 2; ++q) { float s2 = 0.f;
#pragma unroll
                for (int j = 0; j < 4; ++j) s2 += (v[q][j].x * v[q][j].x + v[q][j].y * v[q][j].y) + (v[q][j].z * v[q][j].z + v[q][j].w * v[q][j].w);
                ss[q] = 1.0f / sqrtf(wave_sum(s2) * (1.f / D) + EPS); }
#pragma unroll
            for (int q = 0; q < 2; ++q) { unsigned long long* o8 = (unsigned long long*)dst[q] + lane;
#pragma unroll
                for (int j = 0; j < 4; ++j) o8[64 * j] = (unsigned long long)pk2(v[q][j].x * ss[q], v[q][j].y * ss[q]) | ((unsigned long long)pk2(v[q][j].z * ss[q], v[q][j].w * ss[q]) << 32); }
        }
        for (size_t i = (size_t)bx * NTHR + tid; i < SM_ZERO_END; i += (size_t)G * NTHR) SMALL[i] = 0.f;
        for (int e = bx * NTHR + tid; e < SG * SP * SC; e += G * NTHR) {
            const int i = e / SC, c = e % SC, g = i / SP, p = i % SP; const float dt = expf(log_dt[g]); const float lr = lam_re[i], li = lam_im[i];
            const float ar = lr * dt, ai = li * dt; const float ex = expf(ar), cs = cosf(ai), sn = sinf(ai);
            const float lbr = ex * cs, lbi = ex * sn; if (c == 0) { LB[2 * i] = lbr; LB[2 * i + 1] = lbi; }
            const float sh = sinf(0.5f * ai); const float nr = expm1f(ar) * cs - 2.0f * sh * sh, ni = lbi;
            const float den = lr * lr + li * li; const float qr = (nr * lr + ni * li) / den, qi = (ni * lr - nr * li) / den;
            const float br = sb_re[(size_t)i * SC + c], bi = sb_im[(size_t)i * SC + c];
            const float xr = qr * br - qi * bi, xi = qr * bi + qi * br;
            BB[((size_t)i * SC + c) * 2] = xr; BB[((size_t)i * SC + c) * 2 + 1] = xi;
            BBT[((size_t)g * 128 + p) * SC + c] = (bf16_t)f2bf(xr); BBT[((size_t)g * 128 + 64 + p) * SC + c] = (bf16_t)f2bf(xi);
            CTT[((size_t)g * SC + c) * 128 + p] = (bf16_t)f2bf(sc_re[((size_t)g * SC + c) * SP + p]); CTT[((size_t)g * SC + c) * 128 + 64 + p] = (bf16_t)f2bf(-sc_im[((size_t)g * SC + c) * SP + p]);
        }
    }
    SEAM(0);

    if constexpr (IN(1)) {
        pg8::MultiOrder S; S.init(XN, WinA, M, NA, MEMN, Wmem, MMEM, 2 * 2 * XA, D, G, bx);
        EpiInProj E{Z, ZA, VSTAT, 12, 18, 20, 0, 0.08838834764831845f, out + O_MK, out + O_MV, KVBF, VTB, 1, nullptr};
        pg8::gemm_phase<EpiInProj, pg8::MultiOrder, PG8_ALIGN, PG8_SP2>(lds, D, S, E);
    }
    SEAM(1);

    if constexpr (IN(2)) {
        spatial_phase(Z, VSTAT, ln_v_g, ln_v_b, w_spatial, b_spatial, MIX, lds, vcu, G, tid, wave, lane);
        __syncthreads();
        for (int i = bx * NTHR + tid; i < NB_S * BR; i += G * NTHR) {
            const int b = i / BR, col = i % BR, g = col / AD; float vn[4];
#pragma unroll
            for (int t = 0; t < 4; ++t) { const int row = MP + b * 4 + t; const float v = bf2f(Z[(size_t)row * ZA + BR + col]); const float mean = VSTAT[2 * row] * (1.f / BR); const float var = VSTAT[2 * row + 1] * (1.f / BR) - mean * mean;
                vn[t] = (v - mean) * (1.0f / sqrtf(var + EPS)) * ln_v_g[col] + ln_v_b[col]; out[O_CV + (size_t)(b * 4 + t) * BR + col] = vn[t]; }
#pragma unroll
            for (int t = 0; t < 4; ++t) { float mx = b_spatial[g * CH + t];
#pragma unroll
                for (int s = 0; s < 4; ++s) if (s <= t) mx += w_spatial[(size_t)g * CH * CH + t * CH + s] * vn[s];
                const int row = MP + b * 4 + t; const bf16_t* zr = Z + (size_t)row * ZA;
                MIX[(size_t)row * MW + col] = (bf16_t)f2bf(bf2f(zr[col]) * mx); }
        }
        __syncthreads();
        {
            LAS float* parts = (LAS float*)(lds + RING_BYTES + 4096);
            if (wave < 4) { const int item = 2 * vcu + (wave >> 1); if (item < NB_S * NH) attn_sample_half(Z, ZA, 2 * BR, cache_k, cache_v, parts + wave * 576, parts + wave * 576, item, wave & 1, lane); }
            else { unsigned ep = 0; for (int u = vcu; u < NB_P * NH * 8; u += G, ++ep)
                       attn_prompt_unit4(Z, ZA, 2 * BR, 2 * BR + XA, KVBF, VTB, MIX, lds, (volatile LAS unsigned*)(lds + RING_BYTES + 2048 + 256), ep, u, tid - 256, wave - 4, lane); }
            __syncthreads();
            if (wave < 2) { const int item = 2 * vcu + wave; if (item < NB_S * NH) attn_sample_merge(Z, ZA, 2 * BR + XA, MIX, parts + (2 * wave) * 576, parts + (2 * wave + 1) * 576, item, lane); }
        }
    }
    SEAM(2);

    if constexpr (IN(3)) {
        pg8::MultiOrder S; S.init(MIX, Wout0, MP, D, MIX + (size_t)MP * MW, Wout0, MS, D, MW, G, bx, KSPLIT);
        EpiOutFused2 E{x_prompt, post_g, Y1, XN, SS0, SS2, ctl + CW_PANEL + 4096, ctl + CW_PANEL + 8192, PART, ctl + CW_SUB};
        pg8::gemm_phase<EpiOutFused2, pg8::MultiOrder, PG8_ALIGN, PG8_SP2>(lds, MW, S, E);
    }
    const bool fastseam = (G == 256);
    if constexpr (IN(3) && IN(4)) { if (!fastseam) xcd_barrier(bar); else if (bx < 64) { publish_wg(ctl + CW_SUB + 64 * (bx >> 5)); wait_subunits(ctl + CW_SUB + 64 * (bx >> 5), (D / 256) * KSPLIT); } } else SEAM(3);

    if constexpr (IN(4)) {
        constexpr int NR = 1;
        const int m_first = fastseam ? ((bx < 64) ? MP + (bx >> 5) * 256 + (bx & 31) * 8 + wave : M) : MP + gw, m_step = fastseam ? M : NR * NGW;
        for (int m0 = m_first; m0 < M; m0 += m_step) {
            f32x4 ov[NR][4], xv[NR][4]; float so[NR]; int mm[NR];
#pragma unroll
            for (int q = 0; q < NR; ++q) { const int m = m0 + q * NGW; mm[q] = m;
                if (m >= M) {
#pragma unroll
                    for (int j = 0; j < 4; ++j) { xv[q][j] = (f32x4){0.f, 0.f, 0.f, 0.f}; ov[q][j] = xv[q][j]; }
                    continue; }
                const float* xr = (m < MP) ? x_prompt + (size_t)m * D : x_sample + (size_t)(m - MP) * D;
#pragma unroll
                for (int j = 0; j < 4; ++j) { xv[q][j] = ((const f32x4*)xr)[lane + 64 * j];
                    if (m < MP) { const u32x2 w = ((const u32x2*)(OUT + (size_t)m * D))[lane + 64 * j]; ov[q][j] = (f32x4){__uint_as_float(w.x << 16), __uint_as_float(w.x & 0xffff0000u), __uint_as_float(w.y << 16), __uint_as_float(w.y & 0xffff0000u)}; }
                    else { ov[q][j] = (f32x4){0.f, 0.f, 0.f, 0.f};
#pragma unroll
                        for (int ks = 0; ks < KSPLIT; ++ks) ov[q][j] += ((const f32x4*)(PART + ((size_t)ks * MS + (m - MP)) * D))[lane + 64 * j]; } } }
#pragma unroll
            for (int q = 0; q < NR; ++q) { float a = 0.f;
#pragma unroll
                for (int j = 0; j < 4; ++j) a += (ov[q][j].x * ov[q][j].x + ov[q][j].y * ov[q][j].y) + (ov[q][j].z * ov[q][j].z + ov[q][j].w * ov[q][j].w);
                so[q] = a; }
#pragma unroll
            for (int q = 0; q < NR; ++q) so[q] = wave_sum(so[q]);
            float s1[NR];
#pragma unroll
            for (int q = 0; q < NR; ++q) { const float rs = 1.0f / sqrtf(so[q] * (1.f / D) + EPS); float a = 0.f;
#pragma unroll
                for (int j = 0; j < 4; ++j) { const f32x4 gv = ((const f32x4*)post_g)[lane + 64 * j]; const f32x4 v = xv[q][j] + ov[q][j] * rs * gv; xv[q][j] = v;
                    u32x2 w; w.x = pk2(v.x, v.y); w.y = pk2(v.z, v.w); if (mm[q] < M) ((u32x2*)(Y1 + (size_t)mm[q] * D))[lane + 64 * j] = w;
                    a += (v.x * v.x + v.y * v.y) + (v.z * v.z + v.w * v.w); }
                s1[q] = a; }
#pragma unroll
            for (int q = 0; q < NR; ++q) s1[q] = wave_sum(s1[q]);
#pragma unroll
            for (int q = 0; q < NR; ++q) { if (mm[q] >= M) continue; const float rs1 = 1.0f / sqrtf(s1[q] * (1.f / D) + EPS); unsigned long long* o8 = (unsigned long long*)(XN + (size_t)mm[q] * D) + lane;
#pragma unroll
                for (int j = 0; j < 4; ++j) o8[64 * j] = (unsigned long long)pk2(xv[q][j].x * rs1, xv[q][j].y * rs1) | ((unsigned long long)pk2(xv[q][j].z * rs1, xv[q][j].w * rs1) << 32); }
        }
    }
    SEAM(4);

    if constexpr (IN(5)) {
        pg8::MultiOrder S; S.init(XN, WinB, M, NBW, XN, WinB, 0, 0, D, G, bx);
        EpiInProj E{Z, NBW, VSTAT, BR / 256, BR / 256, (BR + XA) / 256, 1, 0.08838834764831845f, out + O_MK, out + O_MV, KVBF, VTB, 0, UGI};
        pg8::gemm_phase<EpiInProj, pg8::MultiOrder, PG8_ALIGN, PG8_SP2>(lds, D, S, E);
    }
    SEAM(5);

    if constexpr (IN(6)) {
        constexpr int NCA = SG * 4 - 256, NCB = 256 - NCA;
        const int slot = wave >> 2, pitem = vcu + 256 * slot, role = (slot == 0) ? (wave & 3) : ((wave + 2) & 3);
        LAS unsigned char* half = lds + slot * 65536;
        LAS unsigned char* wl = half + (wave & 3) * ((slot == 0) ? S5_IMG : 16384);
        volatile LAS unsigned* fl = (volatile LAS unsigned*)(lds + RING_BYTES + 2048 + slot * 64);
        if (pitem < SG * 4) {
            if (role == 0) { __builtin_amdgcn_s_setprio(3); s5_prod<0>(UGI, BBT, LB, out + O_HPR, out + O_HPI, half, fl, pitem, lane); }
            else if (role == 1) { __builtin_amdgcn_s_setprio(3); s5_prod<1>(UGI, BBT, LB, out + O_HPR, out + O_HPI, half, fl, pitem, lane); }
            else { __builtin_amdgcn_s_setprio(0); s5_cons(CTT, ssm_d, YG, half, fl, pitem, role - 2, lane); }
            __builtin_amdgcn_s_setprio(0);
        } else {
            for (int it = (vcu - NCA) + NCB * (wave - 4); it < NB_S * NH; it += 4 * NCB)
                attn_sample_item(Z, NBW, BR, BR + XA + BR, cache_k + (size_t)NB_S * NMEM * XA, cache_v + (size_t)NB_S * NMEM * XA, MIX, (LAS float*)wl, it, lane);
        }
        team_sync(fl + 8, 4u, lane);
        attn_prompt_unit_kv(Z, NBW, BR, BR + XA + BR, KVBF + 2ull * MMEM * XA, VTB + (size_t)NB_P * NH * HD * NMEM, MIX, half, fl + 9, 0u, vcu + 256 * slot, tid & 255, wave & 3, lane);
        {
            constexpr int N_SS = SG * 16 / 2, N_TG = (BR / 64) * (BR / 32) / 4, N_TO = (MW / 64) * (D / 32) / 4;
            LAS unsigned* wq = (LAS unsigned*)(lds + RING_BYTES + 2048 + 128);
            for (;;) {
                unsigned tk = 0; if (lane == 0) tk = __hip_atomic_fetch_add(wq, 1u, __ATOMIC_RELAXED, __HIP_MEMORY_SCOPE_WORKGROUP);
                const int it = __builtin_amdgcn_readfirstlane((int)tk) * 256 + vcu;
                if (it >= N_SS + N_TG + N_TO) break;
                if (it < N_SS) {
#pragma unroll 1
                    for (int q = 0; q < 2; ++q) s5_item<true>(UGI, BBT, CTT, LB, ssm_d, st_re, st_im, out + O_HSR, out + O_HSI, YG, wl, 2 * it + q, lane); }
                else if (it < N_SS + N_TG) {
#pragma unroll 1
                    for (int q = 0; q < 4; ++q) p0_transpose_item(w_glu, nullptr, BR, BR, Wglu, 0, (LAS float*)wl, 4 * (it - N_SS) + q, lane); }
                else {
#pragma unroll 1
                    for (int q = 0; q < 4; ++q) p0_transpose_item(w_out + (size_t)MW * D, nullptr, MW, D, Wout1, 0, (LAS float*)wl, 4 * (it - N_SS - N_TG) + q, lane); }
            }
        }
    }
    SEAM(6);

    if constexpr (IN(8)) {
        pg8::MultiOrder S; S.init(YG, Wglu, M, BR, YG, Wglu, 0, 0, BR, G, bx); S.tstepA = (size_t)256 * 32;
        EpiGlu E{YG, Z, b_glu, MIX};
        pg8::gemm_phase<EpiGlu, pg8::MultiOrder, PG8_ALIGN, PG8_SP2, M>(lds, BR, S, E);
    }
    SEAM(8);

    if constexpr (IN(9)) {
        pg8::MultiOrder S; S.init(MIX, Wout1, MP, D, MIX + (size_t)MP * MW, Wout1, MS, D, MW, G, bx, KSPLIT);
        EpiOutFused E{Y1, post_g + D, out + O_Y, SS1, ctl + CW_PANEL, PART, ctl + CW_SUB + 128};
        pg8::gemm_phase<EpiOutFused, pg8::MultiOrder, PG8_ALIGN, PG8_SP2>(lds, MW, S, E);
    }
    if constexpr (IN(9) && IN(10)) { if (!fastseam) xcd_barrier(bar); else if (bx < 64) { publish_wg(ctl + CW_SUB + 128 + 64 * (bx >> 5)); wait_subunits(ctl + CW_SUB + 128 + 64 * (bx >> 5), (D / 256) * KSPLIT); } } else SEAM(9);

    if constexpr (IN(10)) {
        constexpr int NR = 1;
        const int m_first = fastseam ? ((bx < 64) ? MP + (bx >> 5) * 256 + (bx & 31) * 8 + wave : M) : MP + gw, m_step = fastseam ? M : NR * NGW;
        for (int m0 = m_first; m0 < M; m0 += m_step) {
            f32x4 ov[NR][4]; u32x2 yw[NR][4]; float so[NR]; int mm[NR];
#pragma unroll
            for (int q = 0; q < NR; ++q) { const int m = m0 + q * NGW; mm[q] = m;
                if (m >= M) {
#pragma unroll
                    for (int j = 0; j < 4; ++j) { ov[q][j] = (f32x4){0.f, 0.f, 0.f, 0.f}; yw[q][j] = (u32x2){0u, 0u}; }
                    continue; }
#pragma unroll
                for (int j = 0; j < 4; ++j) { yw[q][j] = ((const u32x2*)(Y1 + (size_t)m * D))[lane + 64 * j];
                    if (m < MP) { const u32x2 w = ((const u32x2*)(OUT + (size_t)m * D))[lane + 64 * j]; ov[q][j] = (f32x4){__uint_as_float(w.x << 16), __uint_as_float(w.x & 0xffff0000u), __uint_as_float(w.y << 16), __uint_as_float(w.y & 0xffff0000u)}; }
                    else { ov[q][j] = (f32x4){0.f, 0.f, 0.f, 0.f};
#pragma unroll
                        for (int ks = 0; ks < KSPLIT; ++ks) ov[q][j] += ((const f32x4*)(PART + ((size_t)ks * MS + (m - MP)) * D))[lane + 64 * j]; } } }
#pragma unroll
            for (int q = 0; q < NR; ++q) { float a = 0.f;
#pragma unroll
                for (int j = 0; j < 4; ++j) a += (ov[q][j].x * ov[q][j].x + ov[q][j].y * ov[q][j].y) + (ov[q][j].z * ov[q][j].z + ov[q][j].w * ov[q][j].w);
                so[q] = a; }
#pragma unroll
            for (int q = 0; q < NR; ++q) so[q] = wave_sum(so[q]);
#pragma unroll
            for (int q = 0; q < NR; ++q) { if (mm[q] >= M) continue; const float rs = 1.0f / sqrtf(so[q] * (1.f / D) + EPS);
#pragma unroll
                for (int j = 0; j < 4; ++j) { const f32x4 yv = {__uint_as_float(yw[q][j].x << 16), __uint_as_float(yw[q][j].x & 0xffff0000u), __uint_as_float(yw[q][j].y << 16), __uint_as_float(yw[q][j].y & 0xffff0000u)}, gv = ((const f32x4*)(post_g + D))[lane + 64 * j];
                    ((f32x4*)(out + O_Y + (size_t)mm[q] * D))[lane + 64 * j] = yv + ov[q][j] * rs * gv; } }
        }
    }
#undef IN
#undef SEAM
}
#undef x_prompt
#undef x_sample
#undef cache_k
#undef cache_v
#undef st_re
#undef st_im
#undef mem_prompt
#undef w_in_a
#undef ln_v_g
#undef ln_v_b
#undef w_spatial
#undef b_spatial
#undef w_in_b
#undef lam_re
#undef lam_im
#undef log_dt
#undef sb_re
#undef sb_im
#undef sc_re
#undef sc_im
#undef ssm_d
#undef w_glu
#undef b_glu
#undef mem_norm_g
#undef w_mem_k
#undef w_mem_v
#undef w_out
#undef pre_g
#undef post_g
#undef out
#undef WinA
#undef WinB
#undef Wglu
#undef Wout0
#undef Wout1
#undef Wmem
#undef MEMN
#undef KVBF
#undef VTB
#undef SMALL
#undef XN
#undef Z
#undef YG
#undef MIX
#undef OUT
#undef PART
#undef UGI
#undef Y1
#undef VSTAT
#undef SS0
#undef SS1
#undef SS2
#undef LB
#undef BB
#undef BBT
#undef CTT

template <int LO, int HI> static bool prep_kernel() {
    return hipFuncSetAttribute((const void*)mega<LO, HI>, hipFuncAttributeMaxDynamicSharedMemorySize, LDS_BYTES) == hipSuccess;
}
template <int LO, int HI> static void launch_ph(int grid, hipStream_t stream, const Args& a) { hipLaunchKernelGGL((mega<LO, HI>), dim3(grid), dim3(NTHR), LDS_BYTES, stream, a); }
extern "C" void kernel_launch(void* const* d_in, const int* in_sizes, int n_in, void* d_out, int out_size, void* d_ws, size_t ws_size, hipStream_t stream) {
    static int grid = 0;
    if (grid == 0) {
        if (n_in != 29 || (size_t)out_size != O_END || ws_size < WS_END) { fprintf(stderr, "kernel_launch: unexpected shapes (n_in %d out %d ws %zu)\n", n_in, out_size, ws_size); grid = -1; return; }
        int dev = 0, cus = 0;
        if (hipGetDevice(&dev) != hipSuccess || hipDeviceGetAttribute(&cus, hipDeviceAttributeMultiprocessorCount, dev) != hipSuccess) { grid = -1; return; }
        bool ok = true;
#if MK_N_LAUNCHES == 1
        ok = prep_kernel<0, 11>();
        int per_cu = 0;
        if (hipOccupancyMaxActiveBlocksPerMultiprocessor(&per_cu, (const void*)mega<0, 11>, NTHR, LDS_BYTES) != hipSuccess || per_cu < 1) { fprintf(stderr, "kernel_launch: occupancy query says %d blocks per CU\n", per_cu); }
#else
        ok = prep_kernel<0, 1>() && prep_kernel<1, 2>() && prep_kernel<2, 3>() && prep_kernel<3, 4>() && prep_kernel<4, 5>() && prep_kernel<5, 6>() && prep_kernel<6, 7>() && prep_kernel<7, 8>() && prep_kernel<8, 9>() && prep_kernel<9, 10>() && prep_kernel<10, 11>();
#endif
        if (!ok) { fprintf(stderr, "kernel_launch: hipFuncSetAttribute failed\n"); grid = -1; return; }
        (void)hipGetLastError();
        grid = cus;
    }
    if (grid < 0) return;
    (void)hipMemsetAsync((char*)d_ws + WS_CTL, 0, CTL_ZERO_BYTES, stream);
    Args a{};
    for (int i = 0; i < 29; ++i) a.in[i] = (const float*)d_in[i];
    a.out = (float*)d_out; a.ws = (unsigned char*)d_ws;
#if MK_N_LAUNCHES == 1
    launch_ph<0, 11>(grid, stream, a);
#else
    launch_ph<0, 1>(grid, stream, a); launch_ph<1, 2>(grid, stream, a); launch_ph<2, 3>(grid, stream, a); launch_ph<3, 4>(grid, stream, a); launch_ph<4, 5>(grid, stream, a);
    launch_ph<5, 6>(grid, stream, a); launch_ph<6, 7>(grid, stream, a); launch_ph<7, 8>(grid, stream, a); launch_ph<8, 9>(grid, stream, a); launch_ph<9, 10>(grid, stream, a); launch_ph<10, 11>(grid, stream, a);
#endif
}
```
